# Optimizing an MI355X kernel written in HIP

```python
import math
import jax
import jax.numpy as jnp
from jax import lax
import numpy as np

D_MODEL = 1024
BATCH = 2
SEQ = 16384
DEPTH = 2

GRID_W = 64
CTX_LEN = 256
N_MOD = 9
D_FF = 2816
RMS_EPS = 1e-6
LN_EPS = 1e-5
F32 = jnp.float32
NEG_INF = -1e30

GLA_HEADS = 4
GLA_DK = 32
GLA_DV = 64
GLA_RANK = 16
GLA_GATE_TAU = 16.0
GLA_CHUNK = 64

NA_HEADS = 4
NA_DIM = 64
NA_ROWS = 8
NA_COLS = 16

DIFF_HEADS = 4
DIFF_DK = 32
DIFF_DV = 64
Q_BLOCK = 128
ROPE_BASE = 10000.0

CONV_CH = 256
CONV_K = 31

D_MIX = GLA_HEADS * GLA_DV + NA_HEADS * NA_DIM + DIFF_HEADS * DIFF_DV + CONV_CH
PROJ_SIZES = (GLA_HEADS * GLA_DK, GLA_HEADS * GLA_DK, GLA_HEADS * GLA_DV, GLA_HEADS * GLA_DV, GLA_RANK, GLA_RANK,
              NA_HEADS * NA_DIM, NA_HEADS * NA_DIM, NA_HEADS * NA_DIM,
              DIFF_HEADS * 2 * DIFF_DK, DIFF_HEADS * 2 * DIFF_DK, DIFF_HEADS * DIFF_DV,
              2 * CONV_CH)
D_PROJ = sum(PROJ_SIZES)

kernel_name = 'hymba_style_hybrid_dit_trunk'


def rms_norm(x, w):
    xf = x.astype(F32)
    y = xf * lax.rsqrt(jnp.mean(xf * xf, axis=-1, keepdims=True) + RMS_EPS)
    return (y * w.astype(F32)).astype(x.dtype)


def layer_norm(x, g, b):
    xf = x.astype(F32)
    mu = jnp.mean(xf, axis=-1, keepdims=True)
    xc = xf - mu
    var = jnp.mean(xc * xc, axis=-1, keepdims=True)
    return (xc * lax.rsqrt(var + LN_EPS) * g.astype(F32) + b.astype(F32)).astype(x.dtype)


def modulate(x, shift, scale):
    return x * (1.0 + scale) + shift


def swiglu(h, w13, w2):
    a, u = jnp.split(h @ w13, 2, axis=-1)
    return (jax.nn.silu(a) * u) @ w2


def split_projection(z):
    offsets, acc = [], 0
    for s in PROJ_SIZES[:-1]:
        acc += s
        offsets.append(acc)
    return jnp.split(z, offsets, axis=-1)


def axial_rope_tables(seq, dim):
    t = jnp.arange(seq)
    row = (t // GRID_W).astype(F32)
    col = (t % GRID_W).astype(F32)
    half = dim // 2
    inv = 1.0 / (ROPE_BASE ** (jnp.arange(0, half, 2, dtype=F32) / half))
    ang_r = row[:, None] * inv
    ang_c = col[:, None] * inv
    ang = jnp.concatenate([ang_r, ang_r, ang_c, ang_c], axis=-1)
    return jnp.cos(ang), jnp.sin(ang)


def apply_rope(x, cos, sin):
    half = x.shape[-1] // 2

    def rot(u):
        u1, u2 = jnp.split(u, 2, axis=-1)
        return jnp.concatenate([-u2, u1], axis=-1)

    rotated = jnp.concatenate([rot(x[..., :half]), rot(x[..., half:])], axis=-1)
    cos = cos[None, :, None, :].astype(x.dtype)
    sin = sin[None, :, None, :].astype(x.dtype)
    return x * cos + rotated * sin


def softmax_attention(q, k, v):
    s = jnp.einsum('bqhd,bkhd->bhqk', q, k).astype(F32) * (q.shape[-1] ** -0.5)
    p = jax.nn.softmax(s, axis=-1).astype(v.dtype)
    return jnp.einsum('bhqk,bkhd->bqhd', p, v)


def gla_chunked(q, k, v, lg, s0):
    b_, l_, h_, dk = q.shape
    dv = v.shape[-1]
    n = l_ // GLA_CHUNK
    q, k, lg = [t.reshape(b_, n, GLA_CHUNK, h_, dk) for t in (q, k, lg)]
    v = v.reshape(b_, n, GLA_CHUNK, h_, dv)
    bcum = jnp.cumsum(lg, axis=2)
    blast = bcum[:, :, -1]
    q_in = q * jnp.exp(bcum)
    k_in = k * jnp.exp(-bcum)
    causal = jnp.tril(jnp.ones((GLA_CHUNK, GLA_CHUNK), dtype=bool))
    a = jnp.where(causal, jnp.einsum('bnihd,bnjhd->bnhij', q_in, k_in), 0.0)
    o_intra = jnp.einsum('bnhij,bnjhv->bnihv', a, v)
    k_out = k * jnp.exp(blast[:, :, None] - bcum)
    u = jnp.einsum('bnjhd,bnjhv->bnhdv', k_out, v)
    decay = jnp.exp(blast)

    def step(s, inp):
        dc, uc = inp
        return dc[..., None] * s + uc, s

    s_fin, s_prev = lax.scan(step, s0, (jnp.moveaxis(decay, 1, 0), jnp.moveaxis(u, 1, 0)))
    s_prev = jnp.moveaxis(s_prev, 0, 1)
    o_inter = jnp.einsum('bnihd,bnhdv->bnihv', q_in, s_prev)
    return (o_intra + o_inter).reshape(b_, l_, h_, dv), s_fin


def gla_final_state(k, v, lg):
    bcum = jnp.cumsum(lg, axis=1)
    kk = k * jnp.exp(bcum[:, -1:] - bcum)
    return jnp.einsum('blhd,blhv->bhdv', kk, v)


def gla_output(o, g, norm_w):
    b_, l_ = o.shape[:2]
    return rms_norm(o, norm_w).reshape(b_, l_, GLA_HEADS * GLA_DV) * jax.nn.silu(g)


def gla_group(px, pc, wa_f, ba_f, wa_b, ba_b, norm_w, ctx_out):
    def prep(p):
        q, k, v, g, a_f, a_b = p
        b_, l_ = q.shape[:2]
        q = q.reshape(b_, l_, GLA_HEADS, GLA_DK) * (GLA_DK ** -0.5)
        k = k.reshape(b_, l_, GLA_HEADS, GLA_DK)
        v = v.reshape(b_, l_, GLA_HEADS, GLA_DV)
        lg_f = (jax.nn.log_sigmoid(a_f @ wa_f + ba_f) / GLA_GATE_TAU).reshape(b_, l_, GLA_HEADS, GLA_DK)
        lg_b = (jax.nn.log_sigmoid(a_b @ wa_b + ba_b) / GLA_GATE_TAU).reshape(b_, l_, GLA_HEADS, GLA_DK)
        return q, k, v, g, lg_f, lg_b

    def flip(t):
        return jnp.flip(t, axis=1)

    qx, kx, vx, gx, fx, bx = prep(px)
    qc, kc, vc, gc, fc, bc = prep(pc)
    if ctx_out:
        zero = jnp.zeros((qc.shape[0], GLA_HEADS, GLA_DK, GLA_DV), qc.dtype)
        oc_f, sc_f = gla_chunked(qc, kc, vc, fc, zero)
        oc_b, sc_b = gla_chunked(flip(qc), flip(kc), flip(vc), flip(bc), zero)
        oc = gla_output(oc_f + flip(oc_b), gc, norm_w)
    else:
        sc_f = gla_final_state(kc, vc, fc)
        sc_b = gla_final_state(flip(kc), flip(vc), flip(bc))
        oc = None
    ox_f, _ = gla_chunked(qx, kx, vx, fx, sc_f)
    ox_b, _ = gla_chunked(flip(qx), flip(kx), flip(vx), flip(bx), sc_b)
    return gla_output(ox_f + flip(ox_b), gx, norm_w), oc


def neighborhood_attention(q, k, v, kc, vc, rpb, rows):
    b_, l_, h_, d = q.shape
    wr = min(NA_ROWS, rows)
    r = jnp.arange(rows)
    row_start = jnp.clip(r - wr // 2, 0, rows - wr)
    row_idx = row_start[:, None] + jnp.arange(wr)
    qg = q.reshape(b_, rows, GRID_W, h_, d) * (d ** -0.5)
    kg = k.reshape(b_, rows, GRID_W, h_, d)[:, row_idx]
    vg = v.reshape(b_, rows, GRID_W, h_, d)[:, row_idx]
    col = jnp.arange(GRID_W)
    col_start = jnp.clip(col - NA_COLS // 2, 0, GRID_W - NA_COLS)
    in_win = (col[None, :] >= col_start[:, None]) & (col[None, :] < col_start[:, None] + NA_COLS)
    row_off = row_idx - r[:, None] + (NA_ROWS - 1)
    col_off = jnp.clip(col[None, :] - col[:, None] + (NA_COLS - 1), 0, 2 * NA_COLS - 2)
    bias = rpb[:, row_off][..., col_off]
    bias = jnp.transpose(bias, (1, 0, 3, 2, 4)).astype(F32)
    s_win = jnp.einsum('brqhd,brikhd->brhqik', qg, kg).astype(F32) + bias
    s_win = jnp.where(in_win[:, None, :], s_win, NEG_INF)
    s_ctx = jnp.einsum('brqhd,bchd->brhqc', qg, kc).astype(F32)
    nwin = wr * GRID_W
    s = jnp.concatenate([s_win.reshape(b_, rows, h_, GRID_W, nwin), s_ctx], axis=-1)
    p = jax.nn.softmax(s, axis=-1).astype(v.dtype)
    p_win = p[..., :nwin].reshape(b_, rows, h_, GRID_W, wr, GRID_W)
    out = (jnp.einsum('brhqik,brikhd->brqhd', p_win, vg)
           + jnp.einsum('brhqc,bchd->brqhd', p[..., nwin:], vc))
    return out.reshape(b_, l_, h_ * d)


def na_group(px, pc, rpb, rows, ctx_out):
    def heads(p):
        b_, l_ = p[0].shape[:2]
        return [t.reshape(b_, l_, NA_HEADS, NA_DIM) for t in p]

    q, k, v = heads(px)
    qc, kc, vc = heads(pc)
    ox = neighborhood_attention(q, k, v, kc, vc, rpb, rows)
    if not ctx_out:
        return ox, None
    oc = softmax_attention(qc, kc, vc)
    return ox, oc.reshape(oc.shape[0], oc.shape[1], NA_HEADS * NA_DIM)


def diff_softmax_pair(q1, q2, k1, k2, v, lam):
    scale = DIFF_DK ** -0.5
    s1 = jnp.einsum('bqhd,bkhd->bhqk', q1, k1).astype(F32) * scale
    s2 = jnp.einsum('bqhd,bkhd->bhqk', q2, k2).astype(F32) * scale
    p = jax.nn.softmax(s1, axis=-1) - lam * jax.nn.softmax(s2, axis=-1)
    return jnp.einsum('bhqk,bkhd->bqhd', p.astype(v.dtype), v)


def diff_output(o, norm_w, lambda_init):
    b_, l_ = o.shape[:2]
    return (rms_norm(o, norm_w) * (1.0 - lambda_init)).reshape(b_, l_, DIFF_HEADS * DIFF_DV)


def diff_group(px, pc, lq1, lk1, lq2, lk2, norm_w, lambda_init, cos, sin, ctx_out):
    def heads(p):
        q, k, v = p
        b_, l_ = q.shape[:2]
        q = q.reshape(b_, l_, DIFF_HEADS, 2, DIFF_DK)
        k = k.reshape(b_, l_, DIFF_HEADS, 2, DIFF_DK)
        return q[..., 0, :], q[..., 1, :], k[..., 0, :], k[..., 1, :], v.reshape(b_, l_, DIFF_HEADS, DIFF_DV)

    q1, q2, k1, k2, v = heads(px)
    q1, q2, k1, k2 = [apply_rope(t, cos, sin) for t in (q1, q2, k1, k2)]
    q1c, q2c, k1c, k2c, vc = heads(pc)
    lam = (jnp.exp(jnp.sum(lq1.astype(F32) * lk1.astype(F32)))
           - jnp.exp(jnp.sum(lq2.astype(F32) * lk2.astype(F32))) + lambda_init)
    k1a = jnp.concatenate([k1c, k1], axis=1)
    k2a = jnp.concatenate([k2c, k2], axis=1)
    va = jnp.concatenate([vc, v], axis=1)
    b_, l_ = q1.shape[:2]
    nb = l_ // Q_BLOCK

    def blocks(t):
        return jnp.swapaxes(t.reshape(b_, nb, Q_BLOCK, DIFF_HEADS, DIFF_DK), 0, 1)

    o = lax.map(lambda qs: diff_softmax_pair(qs[0], qs[1], k1a, k2a, va, lam), (blocks(q1), blocks(q2)))
    o = jnp.swapaxes(o, 0, 1).reshape(b_, l_, DIFF_HEADS, DIFF_DV)
    ox = diff_output(o, norm_w, lambda_init)
    if not ctx_out:
        return ox, None
    return ox, diff_output(diff_softmax_pair(q1c, q2c, k1c, k2c, vc, lam), norm_w, lambda_init)


def conformer_conv(z, dw, dw_b, ln_g, ln_b, pw, pw_b):
    a, gte = jnp.split(z, 2, axis=-1)
    u = a * jax.nn.sigmoid(gte)
    u = lax.conv_general_dilated(u, dw[:, None, :], window_strides=(1,),
                                 padding=[(CONV_K // 2, CONV_K // 2)],
                                 dimension_numbers=('NWC', 'WIO', 'NWC'),
                                 feature_group_count=CONV_CH) + dw_b
    u = jax.nn.silu(layer_norm(u, ln_g, ln_b))
    return u @ pw + pw_b


def token_mixing(hx, hc, w_in, w_out, gla_wa_f, gla_ba_f, gla_wa_b, gla_ba_b, gla_norm, na_rpb,
                 diff_lq1, diff_lk1, diff_lq2, diff_lk2, diff_norm, conv_dw, conv_dw_b, conv_ln_g,
                 conv_ln_b, conv_pw, conv_pw_b, lambda_init, cos, sin, rows, ctx_out):
    px = split_projection(hx @ w_in)
    pc = split_projection(hc @ w_in)
    gx, gc = gla_group(px[0:6], pc[0:6], gla_wa_f, gla_ba_f, gla_wa_b, gla_ba_b, gla_norm, ctx_out)
    nx, nc = na_group(px[6:9], pc[6:9], na_rpb, rows, ctx_out)
    dx, dc = diff_group(px[9:12], pc[9:12], diff_lq1, diff_lk1, diff_lq2, diff_lk2, diff_norm,
                        lambda_init, cos, sin, ctx_out)
    cx = conformer_conv(px[12], conv_dw, conv_dw_b, conv_ln_g, conv_ln_b, conv_pw, conv_pw_b)
    out_x = jnp.concatenate([gx, nx, dx, cx], axis=-1) @ w_out
    if not ctx_out:
        return out_x, None
    cc = conformer_conv(pc[12], conv_dw, conv_dw_b, conv_ln_g, conv_ln_b, conv_pw, conv_pw_b)
    out_c = jnp.concatenate([gc, nc, dc, cc], axis=-1) @ w_out
    return out_x, out_c


def setup_inputs(seed: int = 0) -> dict:
    key = jax.random.key(seed)
    ks = iter(jax.random.split(key, 40))

    def nrm(shape, s):
        return jax.random.normal(next(ks), shape, F32) * s

    L, D = DEPTH, D_MODEL
    return {
        'x': nrm((BATCH, SEQ, D), 1.0),
        'c': nrm((BATCH, D), 1.0),
        'ctx': nrm((BATCH, CTX_LEN, D), 1.0),
        'c_ctx': nrm((D,), 1.0),
        'ada_w': nrm((L, D, N_MOD * D), 0.5 * D ** -0.5),
        'ada_b': nrm((L, N_MOD * D), 0.02),
        'norm_ffn1': 1.0 + nrm((L, D), 0.02),
        'ffn1_w13': nrm((L, D, 2 * D_FF), D ** -0.5),
        'ffn1_w2': nrm((L, D_FF, D), D_FF ** -0.5),
        'norm_mix': 1.0 + nrm((L, D), 0.02),
        'w_in': nrm((L, D, D_PROJ), D ** -0.5),
        'gla_wa_f': nrm((L, GLA_RANK, GLA_HEADS * GLA_DK), GLA_RANK ** -0.5),
        'gla_ba_f': nrm((L, GLA_HEADS * GLA_DK), 0.1),
        'gla_wa_b': nrm((L, GLA_RANK, GLA_HEADS * GLA_DK), GLA_RANK ** -0.5),
        'gla_ba_b': nrm((L, GLA_HEADS * GLA_DK), 0.1),
        'gla_norm': 1.0 + nrm((L, GLA_DV), 0.02),
        'na_rpb': nrm((L, NA_HEADS, 2 * NA_ROWS - 1, 2 * NA_COLS - 1), 0.02),
        'diff_lq1': nrm((L, DIFF_DK), 0.1),
        'diff_lk1': nrm((L, DIFF_DK), 0.1),
        'diff_lq2': nrm((L, DIFF_DK), 0.1),
        'diff_lk2': nrm((L, DIFF_DK), 0.1),
        'diff_norm': 1.0 + nrm((L, DIFF_DV), 0.02),
        'conv_dw': nrm((L, CONV_K, CONV_CH), CONV_K ** -0.5),
        'conv_dw_b': nrm((L, CONV_CH), 0.02),
        'conv_ln_g': 1.0 + nrm((L, CONV_CH), 0.02),
        'conv_ln_b': nrm((L, CONV_CH), 0.02),
        'conv_pw': nrm((L, CONV_CH, CONV_CH), CONV_CH ** -0.5),
        'conv_pw_b': nrm((L, CONV_CH), 0.02),
        'w_out': nrm((L, D_MIX, D), D_MIX ** -0.5),
        'norm_ffn2': 1.0 + nrm((L, D), 0.02),
        'ffn2_w13': nrm((L, D, 2 * D_FF), D ** -0.5),
        'ffn2_w2': nrm((L, D_FF, D), D_FF ** -0.5),
        'final_norm': 1.0 + nrm((D,), 0.02),
    }


def reference(x, c, ctx, c_ctx, ada_w, ada_b, norm_ffn1, ffn1_w13, ffn1_w2, norm_mix, w_in,
              gla_wa_f, gla_ba_f, gla_wa_b, gla_ba_b, gla_norm, na_rpb, diff_lq1, diff_lk1,
              diff_lq2, diff_lk2, diff_norm, conv_dw, conv_dw_b, conv_ln_g, conv_ln_b, conv_pw,
              conv_pw_b, w_out, norm_ffn2, ffn2_w13, ffn2_w2, final_norm):
    seq = x.shape[1]
    rows = seq // GRID_W
    cos, sin = axial_rope_tables(seq, DIFF_DK)
    h, hc = x, ctx
    for i in range(DEPTH):
        last = i == DEPTH - 1
        lambda_init = 0.8 - 0.6 * math.exp(-0.3 * i)
        mx = jnp.split((jax.nn.silu(c) @ ada_w[i] + ada_b[i])[:, None, :], N_MOD, axis=-1)
        mc = jnp.split(jax.nn.silu(c_ctx) @ ada_w[i] + ada_b[i], N_MOD, axis=-1)
        h = h + 0.5 * mx[2] * swiglu(modulate(rms_norm(h, norm_ffn1[i]), mx[0], mx[1]), ffn1_w13[i], ffn1_w2[i])
        hc = hc + 0.5 * mc[2] * swiglu(modulate(rms_norm(hc, norm_ffn1[i]), mc[0], mc[1]), ffn1_w13[i], ffn1_w2[i])
        ox, oc = token_mixing(modulate(rms_norm(h, norm_mix[i]), mx[3], mx[4]),
                              modulate(rms_norm(hc, norm_mix[i]), mc[3], mc[4]),
                              w_in[i], w_out[i], gla_wa_f[i], gla_ba_f[i], gla_wa_b[i], gla_ba_b[i],
                              gla_norm[i], na_rpb[i], diff_lq1[i], diff_lk1[i], diff_lq2[i], diff_lk2[i],
                              diff_norm[i], conv_dw[i], conv_dw_b[i], conv_ln_g[i], conv_ln_b[i],
                              conv_pw[i], conv_pw_b[i], lambda_init, cos, sin, rows, not last)
        h = h + mx[5] * ox
        if not last:
            hc = hc + mc[5] * oc
            hc = hc + 0.5 * mc[8] * swiglu(modulate(rms_norm(hc, norm_ffn2[i]), mc[6], mc[7]), ffn2_w13[i], ffn2_w2[i])
        h = h + 0.5 * mx[8] * swiglu(modulate(rms_norm(h, norm_ffn2[i]), mx[6], mx[7]), ffn2_w13[i], ffn2_w2[i])
    return rms_norm(h, final_norm)
```

```cpp
#include <hip/hip_runtime.h>
#include <hip/hip_cooperative_groups.h>
#include <cstdio>
#include <cstdint>
namespace cg = cooperative_groups;
#define MK_PER_PHASE 0
namespace pg8 {
#define PG8_LAS __attribute__((address_space(3)))
typedef unsigned short bf16_t;
typedef short bf16x8 __attribute__((ext_vector_type(8)));
typedef float f32x4 __attribute__((ext_vector_type(4)));
typedef unsigned u32x4 __attribute__((ext_vector_type(4)));
constexpr int BM = 256, BK = 64, HALF = 128, HTB = HALF * BK * 2  , STAGE_BYTES = 8 * HTB, NXCD = 8, WGM = 8;

__host__ __device__ __forceinline__ int lds_byte(int r, int c) { const int st = (r >> 4) * 2 + (c >> 5), rr = r & 15, cc = c & 31, ob = rr * 64 + cc * 2; return st * 1024 + (ob ^ (((ob >> 9) & 1) << 5)); }
__host__ __device__ __forceinline__ void stage_rc(int b, int& R, int& C) { const int st = b / 1024, sb = b % 1024, swz = sb ^ (((sb >> 9) & 1) << 5); R = (st >> 1) * 16 + swz / 64; C = (st & 1) * 32 + (swz % 64) / 2; }
__host__ __device__ __forceinline__ int perm32(int rho) { const int n = rho >> 4, i = rho & 15; return 8 * (i >> 2) + 4 * n + (i & 3); }

struct Unit { int pm, pn; };
struct Gemm { const bf16_t* A; const bf16_t* Bt; int M, N, K; };

struct StaticOrder {
    int nM, nN, nwg, G, c;
    __host__ __device__ void init(int M, int N, int G_, int c_) { nM = M / BM; nN = N / BM; nwg = nM * nN; G = G_; c = c_; }
    __host__ __device__ bool next(int i, Unit& u) const {
        const long L = (long)i * G + c; if (L >= nwg) return false;
        int wgid = (int)L; { const int q = nwg / NXCD, r = nwg % NXCD, xcd = wgid % NXCD, off = wgid / NXCD; wgid = (xcd < r ? xcd * (q + 1) : r * (q + 1) + (xcd - r) * q) + off; }
        const int nig = WGM * nN, gid = wgid / nig, fm = gid * WGM, gsz = (nM - fm) < WGM ? (nM - fm) : WGM;
        u.pm = fm + ((wgid % nig) % gsz); u.pn = (wgid % nig) / gsz; return true;
    }
    __device__ __forceinline__ void a_ready(const Unit&) const {}
    __device__ __forceinline__ void done(const Unit&) const {}
};

__device__ __forceinline__ unsigned cvt_pk_bf16(float lo, float hi) { unsigned r; asm volatile("v_cvt_pk_bf16_f32 %0, %1, %2" : "=v"(r) : "v"(lo), "v"(hi)); return r; }
template <class Epi, class Sched, bool ALIGN_EPI = false, bool SP2 = false>
__device__ __forceinline__ void gemm_phase(PG8_LAS unsigned char* lds, const Gemm g, const Sched& S, const Epi& E) {
    int tid_l = threadIdx.x; asm volatile("" : "+v"(tid_l)); const int tid = tid_l, wid = __builtin_amdgcn_readfirstlane(tid >> 6), lane = tid & 63, wr = wid >> 2, wc = wid & 3, fr = lane & 15, fq = lane >> 4;
    const int K = g.K, nt = K / BK;
    unsigned voffA[2], voffB[2];
#pragma unroll
    for (int i = 0; i < 2; ++i) { int R, C; stage_rc(tid * 16 + i * 8192, R, C); const int Rb = Epi::PERM ? ((R & ~31) + perm32(R & 31)) : R;
        voffA[i] = (unsigned)(R * K + C) * 2u; voffB[i] = (unsigned)(Rb * K + C) * 2u; }
    const size_t kstep = (size_t)(BK * 2);
    const size_t hstep = (size_t)HALF * K * 2;
    const size_t tstep = 2 * hstep;
    const unsigned ldsw = (unsigned)wid * 1024u;
    const int aoff = lds_byte(wr * 64 + fr, fq * 8), boff = lds_byte(wc * 32 + fr, fq * 8);
#define PG8_SA(b, h) (((b) * 2 + (h)) * HTB)
#define PG8_SB(b, h) ((4 + (b) * 2 + (h)) * HTB)
#define PG8_STAGE(bufoff, gbase, voff) do { _Pragma("unroll") for (int _i = 0; _i < 2; ++_i) \
        __builtin_amdgcn_global_load_lds((const unsigned*)((const char*)(gbase) + (voff)[_i]), (PG8_LAS unsigned*)(lds + (bufoff) + ldsw + _i * 8192), 16, 0, 0); } while (0)
#define PG8_LDA(dst, b, h) do { _Pragma("unroll") for (int m = 0; m < 4; ++m) _Pragma("unroll") for (int k = 0; k < 2; ++k) dst[m][k] = *(const PG8_LAS bf16x8*)(lds + PG8_SA(b, h) + aoff + m * 2048 + k * 1024); } while (0)
#define PG8_LDB(dst, b, h) do { _Pragma("unroll") for (int n = 0; n < 2; ++n) _Pragma("unroll") for (int k = 0; k < 2; ++k) dst[n][k] = *(const PG8_LAS bf16x8*)(lds + PG8_SB(b, h) + boff + n * 2048 + k * 1024); } while (0)
#define PG8_MMA(ai, bj, At, Bt) do { __builtin_amdgcn_s_setprio(1); _Pragma("unroll") for (int m = 0; m < 4; ++m) _Pragma("unroll") for (int n = 0; n < 2; ++n) _Pragma("unroll") for (int k = 0; k < 2; ++k) \
        acc[ai][bj][m][n] = __builtin_amdgcn_mfma_f32_16x16x32_bf16(Bt[n][k], At[m][k], acc[ai][bj][m][n], 0, 0, 0); __builtin_amdgcn_s_setprio(0); } while (0)
#define PG8_WAIT_V(n) asm volatile("s_waitcnt vmcnt(" #n ")" ::: "memory")
#define PG8_WAIT_L(n) asm volatile("s_waitcnt lgkmcnt(" #n ")" ::: "memory")
#define PG8_BAR __builtin_amdgcn_s_barrier()
#define PG8_SCHED __builtin_amdgcn_sched_barrier(0)
    Unit cur, nxt; int ui = 0;
    if (!S.next(0, cur)) return;
    f32x4 acc[2][2][4][2];
#pragma unroll
    for (int a = 0; a < 2; ++a)
#pragma unroll
        for (int b = 0; b < 2; ++b)
#pragma unroll
            for (int m = 0; m < 4; ++m)
#pragma unroll
                for (int n = 0; n < 2; ++n) acc[a][b][m][n] = (f32x4){0.f, 0.f, 0.f, 0.f};
    bf16x8 At[4][2], B0[2][2], B1[2][2];
    const char* cA = (const char*)g.A + (size_t)cur.pm * tstep; const char* cB = (const char*)g.Bt + (size_t)cur.pn * tstep;
    S.a_ready(cur);
    if constexpr (SP2) {
        PG8_STAGE(PG8_SB(0, 0), cB, voffB); PG8_STAGE(PG8_SB(0, 1), cB + hstep, voffB); PG8_STAGE(PG8_SA(0, 0), cA, voffA); PG8_STAGE(PG8_SA(0, 1), cA + hstep, voffA);
        if (wr == 1) PG8_BAR;
        PG8_WAIT_V(2); PG8_BAR;
        PG8_STAGE(PG8_SB(1, 0), cB + kstep, voffB); PG8_STAGE(PG8_SA(1, 0), cA + kstep, voffA); PG8_STAGE(PG8_SB(1, 1), cB + hstep + kstep, voffB);
        PG8_WAIT_V(6); PG8_BAR;
    } else {
        PG8_STAGE(PG8_SB(0, 0), cB, voffB); PG8_STAGE(PG8_SA(0, 0), cA, voffA); PG8_STAGE(PG8_SB(0, 1), cB + hstep, voffB); PG8_STAGE(PG8_SA(0, 1), cA + hstep, voffA);
        if (wr == 1) PG8_BAR;
        PG8_WAIT_V(4); PG8_BAR;
        PG8_STAGE(PG8_SB(1, 0), cB + kstep, voffB); PG8_STAGE(PG8_SA(1, 0), cA + kstep, voffA); PG8_STAGE(PG8_SB(1, 1), cB + hstep + kstep, voffB);
        PG8_WAIT_V(6); PG8_BAR;
    }
    for (;;) {
        const bool has_next = S.next(ui + 1, nxt);
        const char* nA = has_next ? (const char*)g.A + (size_t)nxt.pm * tstep : cA; const char* nB = has_next ? (const char*)g.Bt + (size_t)nxt.pn * tstep : cB;
        for (int t = 0; t < nt; t += 2) {
            const bool last = (t == nt - 2);
            const char* a1 = cA + (size_t)(t + 1) * kstep;
            const char* a2 = last ? nA : cA + (size_t)(t + 2) * kstep; const char* b2 = last ? nB : cB + (size_t)(t + 2) * kstep;
            const char* a3 = a2 + kstep; const char* b3 = b2 + kstep;
            if (last && has_next) S.a_ready(nxt);
            if constexpr (SP2) {
            PG8_LDB(B0, 0, 0); PG8_LDB(B1, 0, 1); PG8_SCHED; PG8_LDA(At, 0, 0); PG8_STAGE(PG8_SA(1, 1), a1 + hstep, voffA);
            PG8_WAIT_V(8); PG8_WAIT_L(0); PG8_BAR; PG8_MMA(0, 0, At, B0); PG8_MMA(0, 1, At, B1); PG8_BAR; PG8_SCHED;
            PG8_LDA(At, 0, 1); PG8_STAGE(PG8_SB(0, 0), b2, voffB); PG8_STAGE(PG8_SB(0, 1), b2 + hstep, voffB); PG8_STAGE(PG8_SA(0, 0), a2, voffA);
            PG8_WAIT_V(8); PG8_WAIT_L(0); PG8_BAR; PG8_MMA(1, 0, At, B0); PG8_MMA(1, 1, At, B1); PG8_BAR; PG8_SCHED;
            PG8_LDB(B0, 1, 0); PG8_LDB(B1, 1, 1); PG8_SCHED; PG8_LDA(At, 1, 0); PG8_STAGE(PG8_SA(0, 1), a2 + hstep, voffA);
            PG8_WAIT_V(8); PG8_WAIT_L(0); PG8_BAR; PG8_MMA(0, 0, At, B0); PG8_MMA(0, 1, At, B1); PG8_BAR; PG8_SCHED;
            PG8_LDA(At, 1, 1); PG8_STAGE(PG8_SB(1, 0), b3, voffB); PG8_STAGE(PG8_SB(1, 1), b3 + hstep, voffB); PG8_STAGE(PG8_SA(1, 0), a3, voffA);
            PG8_WAIT_V(8); PG8_WAIT_L(0); PG8_BAR; PG8_MMA(1, 0, At, B0); PG8_MMA(1, 1, At, B1); PG8_BAR; PG8_SCHED;
            } else {
            PG8_LDB(B0, 0, 0); PG8_SCHED; PG8_LDA(At, 0, 0); PG8_STAGE(PG8_SA(1, 1), a1 + hstep, voffA);
            PG8_WAIT_L(8); PG8_BAR; PG8_WAIT_L(0); PG8_MMA(0, 0, At, B0); PG8_BAR; PG8_SCHED;
            PG8_LDB(B1, 0, 1); PG8_STAGE(PG8_SB(0, 0), b2, voffB);
            PG8_BAR; PG8_WAIT_L(0); PG8_MMA(0, 1, At, B1); PG8_BAR;
            PG8_LDA(At, 0, 1); PG8_STAGE(PG8_SA(0, 0), a2, voffA);
            PG8_BAR; PG8_WAIT_L(0); PG8_MMA(1, 0, At, B0); PG8_BAR; PG8_SCHED;
            PG8_STAGE(PG8_SB(0, 1), b2 + hstep, voffB);
            PG8_WAIT_V(6); PG8_BAR; PG8_MMA(1, 1, At, B1); PG8_BAR;
            PG8_LDB(B0, 1, 0); PG8_SCHED; PG8_LDA(At, 1, 0); PG8_STAGE(PG8_SA(0, 1), a2 + hstep, voffA);
            PG8_WAIT_L(8); PG8_BAR; PG8_WAIT_L(0); PG8_MMA(0, 0, At, B0); PG8_BAR; PG8_SCHED;
            PG8_LDB(B1, 1, 1); PG8_STAGE(PG8_SB(1, 0), b3, voffB);
            PG8_BAR; PG8_WAIT_L(0); PG8_MMA(0, 1, At, B1); PG8_BAR;
            PG8_LDA(At, 1, 1); PG8_STAGE(PG8_SA(1, 0), a3, voffA);
            PG8_BAR; PG8_WAIT_L(0); PG8_MMA(1, 0, At, B0); PG8_BAR; PG8_SCHED;
            PG8_STAGE(PG8_SB(1, 1), b3 + hstep, voffB);
            PG8_WAIT_V(6); PG8_BAR; PG8_MMA(1, 1, At, B1); PG8_BAR;
            }
        }
        if constexpr (ALIGN_EPI) { if (wr == 0) PG8_BAR; }
        if constexpr (!Epi::AFTER_DRAIN) { E(acc, cur, wr, wc, fr, fq); S.done(cur); }
        if (!has_next) break;
#pragma unroll
        for (int a = 0; a < 2; ++a)
#pragma unroll
            for (int b = 0; b < 2; ++b)
#pragma unroll
                for (int m = 0; m < 4; ++m)
#pragma unroll
                    for (int n = 0; n < 2; ++n) acc[a][b][m][n] = (f32x4){0.f, 0.f, 0.f, 0.f};
        cur = nxt; cA = nA; cB = nB; ++ui;
        if constexpr (ALIGN_EPI) { if (wr == 1) PG8_BAR; }
    }
    PG8_WAIT_V(0);
    if constexpr (!ALIGN_EPI) { if (wr == 0) PG8_BAR; }
    PG8_BAR;
    if constexpr (Epi::AFTER_DRAIN) { E.fused(acc, cur, wr, wc, fr, fq, lds, wid, lane); S.done(cur); }
#undef PG8_SA
#undef PG8_SB
#undef PG8_STAGE
#undef PG8_LDA
#undef PG8_LDB
#undef PG8_MMA
#undef PG8_WAIT_V
#undef PG8_WAIT_L
#undef PG8_BAR
#undef PG8_SCHED
}
}

#define LAS __attribute__((address_space(3)))
typedef unsigned short u16;
typedef unsigned char uchar;
typedef short bf16x8 __attribute__((ext_vector_type(8)));
typedef short s16x4 __attribute__((ext_vector_type(4)));
typedef float f32x4 __attribute__((ext_vector_type(4)));
typedef unsigned u32x4 __attribute__((ext_vector_type(4)));
typedef unsigned u32x2 __attribute__((ext_vector_type(2)));

constexpr int D = 1024, SEQ = 16384, CTXL = 256, DFF = 2816, DPROJ = 2848, NPROJ = 3072;
constexpr int MX = 2 * SEQ, MC = 2 * CTXL, MT = MX + MC;
constexpr int NKEY = CTXL + SEQ, NCH = NKEY / 64;
constexpr int C_GQ = 0, C_GK = 128, C_GV = 256, C_GG = 512, C_AF = 768, C_NQ = 800, C_NK = 1056, C_NV = 1312, C_DQ = 1568, C_DK = 1824, C_DV = 2080, C_CA = 2336, C_CG = 2592;
constexpr float LOG2E = 1.4426950408889634f;

constexpr size_t MiB = 1u << 20;
constexpr size_t WS_CTL = 0, WS_MOD = 1 * MiB, WS_MISC = 1 * MiB + 512 * 1024, WS_HC = 2 * MiB, WS_PWT = 4 * MiB, WS_W13 = 8 * MiB, WS_W2 = 52 * MiB, WS_WIN = 74 * MiB,
                 WS_WOUT = 86 * MiB, WS_A = 90 * MiB, WS_X = 155 * MiB, WS_VTD = 336 * MiB, WS_VTN = 353 * MiB, WS_U = 370 * MiB, WS_DEC = 403 * MiB, WS_BC = 404 * MiB, WS_END = 437 * MiB;
constexpr int LDS_BYTES = 131072;
constexpr int NPHASE = 26;

struct Args { const float* in[33]; float* out; unsigned char* ws; int ph_lo, ph_hi; };

enum { I_X = 0, I_C, I_CTX, I_CCTX, I_ADAW, I_ADAB, I_NF1, I_F1W13, I_F1W2, I_NMIX, I_WIN, I_WAF, I_BAF, I_WAB, I_BAB, I_GNORM, I_RPB, I_LQ1, I_LK1, I_LQ2, I_LK2, I_DNORM,
       I_CDW, I_CDWB, I_CLNG, I_CLNB, I_CPW, I_CPWB, I_WOUT, I_NF2, I_F2W13, I_F2W2, I_FNORM };

__device__ __forceinline__ float bf2f(unsigned short h) { return __uint_as_float(((unsigned)h) << 16); }
__device__ __forceinline__ unsigned short f2bf(float f) { unsigned u = __float_as_uint(f); return (unsigned short)((u + 0x7fffu + ((u >> 16) & 1u)) >> 16); }
__device__ __forceinline__ unsigned pk2(float lo, float hi) { return (unsigned)f2bf(lo) | ((unsigned)f2bf(hi) << 16); }
__device__ __forceinline__ float wave_sum(float v) {
#pragma unroll
    for (int o = 1; o < 64; o <<= 1) v += __shfl_xor(v, o);
    return v;
}
__device__ __forceinline__ float silu_f(float x) { return x / (1.0f + __expf(-x)); }
#define WAVE_SYNC() do { asm volatile("s_waitcnt lgkmcnt(0)" ::: "memory"); __builtin_amdgcn_wave_barrier(); } while (0)
__device__ __forceinline__ int row_of(int b, int c, int tk) { return (c < 4) ? (MX + b * CTXL + c * 64 + tk) : (b * SEQ + (c - 4) * 64 + tk); }
__device__ __forceinline__ float* hrow(const Args& a, int row) { return (row < MX) ? (a.out + (size_t)row * D) : ((float*)(a.ws + WS_HC) + (size_t)(row - MX) * D); }
__device__ __forceinline__ const float* modp(const Args& a, int layer, int g, int j) { return (const float*)(a.ws + WS_MOD) + ((size_t)(layer * 3 + g) * 9 + j) * D; }

struct EpiSwiglu {
    static constexpr bool PERM = true, AFTER_DRAIN = false;
    u16* O;
    __device__ __forceinline__ void operator()(const f32x4 (&acc)[2][2][4][2], const pg8::Unit& u, int wr, int wc, int fr, int fq) const {
        const int row0 = u.pm * 256 + wr * 64 + fr, col0 = u.pn * 128 + wc * 32 + 8 * fq;
#pragma unroll
        for (int ai = 0; ai < 2; ++ai)
#pragma unroll
            for (int m = 0; m < 4; ++m) {
                u16* rowp = O + (size_t)(row0 + ai * 128 + m * 16) * DFF + col0;
                const f32x4 a0 = acc[ai][0][m][0], a1 = acc[ai][0][m][1], u0 = acc[ai][1][m][0], u1 = acc[ai][1][m][1];
                float h[8];
#pragma unroll
                for (int e = 0; e < 4; ++e) { h[e] = silu_f(a0[e]) * u0[e]; h[4 + e] = silu_f(a1[e]) * u1[e]; }
                u32x4 w; w.x = pg8::cvt_pk_bf16(h[0], h[1]); w.y = pg8::cvt_pk_bf16(h[2], h[3]); w.z = pg8::cvt_pk_bf16(h[4], h[5]); w.w = pg8::cvt_pk_bf16(h[6], h[7]);
                *(u32x4*)rowp = w;
            }
    }
};
struct EpiResid {
    static constexpr bool PERM = false, AFTER_DRAIN = false;
    float* hx; float* hc; const float* gate0;
    float coef;
    __device__ __forceinline__ void operator()(const f32x4 (&acc)[2][2][4][2], const pg8::Unit& u, int wr, int wc, int fr, int fq) const {
        const int g = u.pm < 64 ? 0 : (u.pm < 128 ? 1 : 2);
        float* base = (u.pm < 128) ? (hx + (size_t)u.pm * 256 * D) : (hc + (size_t)(u.pm - 128) * 256 * D);
        const int row0 = wr * 64 + fr, col0 = u.pn * 256 + wc * 32 + 4 * fq;
        const float* gate = gate0 + (size_t)g * 9 * D;
        f32x4 gv[2][2];
#pragma unroll
        for (int bj = 0; bj < 2; ++bj)
#pragma unroll
            for (int n = 0; n < 2; ++n) gv[bj][n] = *(const f32x4*)(gate + col0 + bj * 128 + n * 16) * coef;
#pragma unroll
        for (int ai = 0; ai < 2; ++ai)
#pragma unroll
            for (int m = 0; m < 4; ++m) {
                float* rowp = base + (size_t)(row0 + ai * 128 + m * 16) * D + col0;
#pragma unroll
                for (int bj = 0; bj < 2; ++bj)
#pragma unroll
                    for (int n = 0; n < 2; ++n) { f32x4* p = (f32x4*)(rowp + bj * 128 + n * 16); *p = *p + gv[bj][n] * acc[ai][bj][m][n]; }
            }
    }
};
struct EpiProj {
    static constexpr bool PERM = true, AFTER_DRAIN = false;
    u16* O;
    __device__ __forceinline__ void operator()(const f32x4 (&acc)[2][2][4][2], const pg8::Unit& u, int wr, int wc, int fr, int fq) const {
        const int row0 = u.pm * 256 + wr * 64 + fr, col0 = u.pn * 256 + wc * 32 + 8 * fq;
#pragma unroll
        for (int ai = 0; ai < 2; ++ai)
#pragma unroll
            for (int m = 0; m < 4; ++m) {
                u16* rowp = O + (size_t)(row0 + ai * 128 + m * 16) * DPROJ;
#pragma unroll
                for (int bj = 0; bj < 2; ++bj) {
                    const int col = col0 + bj * 128;
                    if (col < DPROJ) {
                        const f32x4 v0 = acc[ai][bj][m][0], v1 = acc[ai][bj][m][1];
                        u32x4 w; w.x = pg8::cvt_pk_bf16(v0[0], v0[1]); w.y = pg8::cvt_pk_bf16(v0[2], v0[3]); w.z = pg8::cvt_pk_bf16(v1[0], v1[1]); w.w = pg8::cvt_pk_bf16(v1[2], v1[3]);
                        *(u32x4*)(rowp + col) = w;
                    }
                }
            }
    }
};

__device__ __forceinline__ void transpose_item(const float* W, int N, u16* WT, int K, int k0, int n0, int drow0, float* scr, int lane) {
#pragma unroll 8
    for (int i = 0; i < 32; ++i) { const int kk = 2 * i + (lane >> 5); scr[kk * 33 + (lane & 31)] = W[(size_t)(k0 + kk) * N + n0 + (lane & 31)]; }
    WAVE_SYNC();
    const int c = lane & 7;
#pragma unroll
    for (int j = 0; j < 4; ++j) {
        const int n = (lane >> 3) + 8 * j; const float* s = scr + (8 * c) * 33 + n;
        u32x4 o; o.x = pk2(s[0 * 33], s[1 * 33]); o.y = pk2(s[2 * 33], s[3 * 33]); o.z = pk2(s[4 * 33], s[5 * 33]); o.w = pk2(s[6 * 33], s[7 * 33]);
        *(u32x4*)(WT + (size_t)(drow0 + n) * K + k0 + 8 * c) = o;
    }
    WAVE_SYNC();
}

__device__ __forceinline__ void phase_prep(const Args& a, uchar* lds) {
    int tid = threadIdx.x; asm volatile("" : "+v"(tid)); const int lane = tid & 63, wave = tid >> 6, G = gridDim.x, bid = blockIdx.x;
    {
        float* sc = (float*)lds;
        float* red = sc + 3 * D;
        float* mod = (float*)(a.ws + WS_MOD);
        for (int i = tid; i < 3 * D; i += 512) { const int g = i >> 10, k = i & 1023; const float v = (g < 2) ? a.in[I_C][g * D + k] : a.in[I_CCTX][k]; sc[i] = silu_f(v); }
        __syncthreads();
        for (int u = bid; u < 2 * 144; u += G) {
            const int l = u / 144, cgp = u % 144, kc = tid >> 6, col = tid & 63;
            const float* w = a.in[I_ADAW] + ((size_t)l * D + kc * 128) * 9216 + cgp * 64 + col;
            float a0 = 0.f, a1 = 0.f, a2 = 0.f;
#pragma unroll 8
            for (int kk = 0; kk < 128; ++kk) { const float wv = w[(size_t)kk * 9216]; const int k = kc * 128 + kk; a0 += sc[k] * wv; a1 += sc[D + k] * wv; a2 += sc[2 * D + k] * wv; }
            red[(kc * 3 + 0) * 64 + col] = a0; red[(kc * 3 + 1) * 64 + col] = a1; red[(kc * 3 + 2) * 64 + col] = a2;
            __syncthreads();
            if (tid < 192) {
                const int g = tid >> 6, cc = tid & 63; float s = a.in[I_ADAB][l * 9216 + cgp * 64 + cc];
#pragma unroll
                for (int k8 = 0; k8 < 8; ++k8) s += red[(k8 * 3 + g) * 64 + cc];
                mod[(size_t)(l * 3 + g) * 9216 + cgp * 64 + cc] = s;
            }
            __syncthreads();
        }
        __syncthreads();
    }
    if (bid == 0) {
        float* tr = (float*)(a.ws + WS_MISC);
        for (int i = tid; i < 2560; i += 512) {
            const int j = i & 7; const int pos = (i < 2048) ? (i >> 3) : ((i - 2048) >> 3);
            const double inv = ((j & 1) ? 0.31622776601683794 : 1.0) * ((j >> 1) == 0 ? 1.0 : ((j >> 1) == 1 ? 0.1 : ((j >> 1) == 2 ? 0.01 : 0.001))), ang = (double)pos * inv;
            float* dst = (i < 2048) ? (tr + (size_t)i * 2) : (tr + 4096 + (size_t)(i - 2048) * 2);
            dst[0] = (float)cos(ang); dst[1] = (float)sin(ang);
        }
    }
    if (bid == (1 % G) && wave < 2) {
        const float* rpb = a.in[I_RPB] + wave * 4 * 15 * 31; float m = 0.f;
        for (int i = lane; i < 4 * 15 * 31; i += 64) m = fmaxf(m, fabsf(rpb[i]));
#pragma unroll
        for (int o = 1; o < 64; o <<= 1) m = fmaxf(m, __shfl_xor(m, o));
        if (lane == 0) ((float*)(a.ws + WS_MISC))[8192 + wave] = m;
    }
    {
        const size_t gt = (size_t)bid * 512 + tid, GT = (size_t)G * 512;
        for (int l = 0; l < 2; ++l) { u32x4* z = (u32x4*)((u16*)(a.ws + WS_WIN) + ((size_t)l * NPROJ + DPROJ) * D);
            for (size_t i = gt; i < (size_t)(NPROJ - DPROJ) * D / 8; i += GT) z[i] = (u32x4){0u, 0u, 0u, 0u}; }
    }
    {
        float* scr = (float*)lds + wave * (64 * 33);
        const int gw = bid * 8 + wave, NGW = G * 8;
        constexpr int I13 = 16 * 176, I2 = 44 * 32, IIN = 16 * 89, IOUT = 16 * 32, IPW = 4 * 8;
        constexpr int NIT = 4 * I13 + 4 * I2 + 2 * IIN + 2 * IOUT + 2 * IPW;
        for (int it = gw; it < NIT; it += NGW) {
            int r = it;
            if (r < 4 * I13) { const int mi = r / I13; r -= mi * I13; const int l = mi >> 1, f = mi & 1, kb = r / 176, nb = r % 176, n0 = nb * 32;
                const int j = (n0 < DFF) ? n0 : n0 - DFF; const int drow0 = 256 * (j >> 7) + (j & 127) + ((n0 < DFF) ? 0 : 128);
                transpose_item(a.in[f ? I_F2W13 : I_F1W13] + (size_t)l * D * 2 * DFF, 2 * DFF, (u16*)(a.ws + WS_W13) + (size_t)mi * 2 * DFF * D, D, kb * 64, n0, drow0, scr, lane); continue; }
            r -= 4 * I13;
            if (r < 4 * I2) { const int mi = r / I2; r -= mi * I2; const int l = mi >> 1, f = mi & 1, kb = r / 32, nb = r % 32;
                transpose_item(a.in[f ? I_F2W2 : I_F1W2] + (size_t)l * DFF * D, D, (u16*)(a.ws + WS_W2) + (size_t)mi * D * DFF, DFF, kb * 64, nb * 32, nb * 32, scr, lane); continue; }
            r -= 4 * I2;
            if (r < 2 * IIN) { const int l = r / IIN; r -= l * IIN; const int kb = r / 89, nb = r % 89;
                transpose_item(a.in[I_WIN] + (size_t)l * D * DPROJ, DPROJ, (u16*)(a.ws + WS_WIN) + (size_t)l * NPROJ * D, D, kb * 64, nb * 32, nb * 32, scr, lane); continue; }
            r -= 2 * IIN;
            if (r < 2 * IOUT) { const int l = r / IOUT; r -= l * IOUT; const int kb = r / 32, nb = r % 32;
                transpose_item(a.in[I_WOUT] + (size_t)l * D * D, D, (u16*)(a.ws + WS_WOUT) + (size_t)l * D * D, D, kb * 64, nb * 32, nb * 32, scr, lane); continue; }
            r -= 2 * IOUT;
            { const int l = r / IPW; r -= l * IPW; const int kb = r / 8, nb = r % 8;
                transpose_item(a.in[I_CPW] + (size_t)l * 256 * 256, 256, (u16*)(a.ws + WS_PWT) + (size_t)l * 256 * 256, 256, kb * 64, nb * 32, nb * 32, scr, lane); }
        }
    }
}

__device__ __forceinline__ void phase_norm(const Args& a, int layer, int which, int M, bool first) {
    int tid = threadIdx.x; asm volatile("" : "+v"(tid)); const int lane = tid & 63, wave = tid >> 6;
    const float* nw = a.in[which == 0 ? I_NF1 : (which == 1 ? I_NMIX : I_NF2)] + (size_t)layer * D;
    u16* A = (u16*)(a.ws + WS_A);
    for (int row = blockIdx.x * 8 + wave; row < M; row += gridDim.x * 8) {
        const float* src = first ? ((row < MX) ? a.in[I_X] + (size_t)row * D : a.in[I_CTX] + (size_t)(row - MX) * D) : hrow(a, row);
        const int g = row < SEQ ? 0 : (row < MX ? 1 : 2);
        const float* sh = modp(a, layer, g, 3 * which), * scl = modp(a, layer, g, 3 * which + 1);
        f32x4 v[4]; float ss = 0.f;
#pragma unroll
        for (int j = 0; j < 4; ++j) { v[j] = ((const f32x4*)src)[lane + 64 * j]; ss += (v[j].x * v[j].x + v[j].y * v[j].y) + (v[j].z * v[j].z + v[j].w * v[j].w); }
        if (first) { f32x4* hd = (f32x4*)hrow(a, row);
#pragma unroll
            for (int j = 0; j < 4; ++j) hd[lane + 64 * j] = v[j]; }
        const float rstd = rsqrtf(wave_sum(ss) * (1.0f / D) + 1e-6f);
        u32x2* o = (u32x2*)(A + (size_t)row * D);
#pragma unroll
        for (int j = 0; j < 4; ++j) {
            const f32x4 w4 = ((const f32x4*)nw)[lane + 64 * j], s4 = ((const f32x4*)scl)[lane + 64 * j], b4 = ((const f32x4*)sh)[lane + 64 * j];
            const f32x4 y = (v[j] * rstd) * w4 * (s4 + 1.0f) + b4;
            u32x2 p; p.x = pk2(y.x, y.y); p.y = pk2(y.z, y.w); o[lane + 64 * j] = p;
        }
    }
}
__device__ __forceinline__ void phase_final(const Args& a) {
    int tid = threadIdx.x; asm volatile("" : "+v"(tid)); const int lane = tid & 63, wave = tid >> 6;
    const float* nw = a.in[I_FNORM];
    for (int row = blockIdx.x * 8 + wave; row < MX; row += gridDim.x * 8) {
        f32x4* p = (f32x4*)(a.out + (size_t)row * D);
        f32x4 v[4]; float ss = 0.f;
#pragma unroll
        for (int j = 0; j < 4; ++j) { v[j] = p[lane + 64 * j]; ss += (v[j].x * v[j].x + v[j].y * v[j].y) + (v[j].z * v[j].z + v[j].w * v[j].w); }
        const float rstd = rsqrtf(wave_sum(ss) * (1.0f / D) + 1e-6f);
#pragma unroll
        for (int j = 0; j < 4; ++j) p[lane + 64 * j] = (v[j] * rstd) * ((const f32x4*)nw)[lane + 64 * j];
    }
}

__device__ __forceinline__ void prep_unit(const Args& a, int layer, int unit, uchar* lds) {
    int tid = threadIdx.x; asm volatile("" : "+v"(tid)); const int b = unit / NCH, c = unit % NCH;
    u16* P = (u16*)(a.ws + WS_X);
    unsigned* ctl = (unsigned*)(a.ws + WS_CTL) + layer * 64;
    unsigned* lmax = (unsigned*)lds;
    u16* T = (u16*)(lds + 256);
    if (tid < 12) lmax[tid] = 0u;
    __syncthreads();
    const float* tr = (const float*)(a.ws + WS_MISC);
    {
        const int tk = tid >> 3, row = row_of(b, c, tk);
        const int t = (c - 4) * 64 + tk, gr = t >> 6, gc = t & 63;
#pragma unroll
        for (int e = 0; e < 2; ++e) {
            const int id = (tid & 7) * 2 + e, isk = id >> 3, h = (id >> 1) & 3, s = id & 1;
            u16* p = P + (size_t)row * DPROJ + C_DQ + isk * 256 + h * 64 + s * 32;
            bf16x8 raw[4];
#pragma unroll
            for (int q = 0; q < 4; ++q) raw[q] = ((const bf16x8*)p)[q];
            float x[32];
#pragma unroll
            for (int q = 0; q < 4; ++q)
#pragma unroll
                for (int i = 0; i < 8; ++i) x[q * 8 + i] = bf2f((u16)raw[q][i]);
            if (c >= 4) {
#pragma unroll
                for (int j = 0; j < 8; ++j) {
                    const float cr = tr[(gr * 8 + j) * 2], sr = tr[(gr * 8 + j) * 2 + 1], cc = tr[4096 + (gc * 8 + j) * 2], sc = tr[4096 + (gc * 8 + j) * 2 + 1];
                    const float x0 = x[j], x1 = x[j + 8], y0 = x[16 + j], y1 = x[24 + j];
                    x[j] = x0 * cr - x1 * sr; x[j + 8] = x1 * cr + x0 * sr;
                    x[16 + j] = y0 * cc - y1 * sc; x[24 + j] = y1 * cc + y0 * sc;
                }
                u32x4 o[4];
#pragma unroll
                for (int q = 0; q < 4; ++q) { o[q].x = pk2(x[q * 8], x[q * 8 + 1]); o[q].y = pk2(x[q * 8 + 2], x[q * 8 + 3]); o[q].z = pk2(x[q * 8 + 4], x[q * 8 + 5]); o[q].w = pk2(x[q * 8 + 6], x[q * 8 + 7]); }
#pragma unroll
                for (int q = 0; q < 4; ++q) ((u32x4*)p)[q] = o[q];
            }
            if (isk) {
                float n2 = 0.f;
#pragma unroll
                for (int i = 0; i < 32; ++i) { const float r = bf2f(f2bf(x[i])); n2 += r * r; }
                atomicMax(&lmax[h * 2 + s], __float_as_uint(n2));
            }
        }
    }
    {
        const int tk = tid >> 3, h = (tid & 7) >> 1, hf = tid & 1, row = row_of(b, c, tk);
        const u16* p = P + (size_t)row * DPROJ + C_NK + h * 64 + hf * 32;
        float n2 = 0.f;
#pragma unroll
        for (int q = 0; q < 4; ++q) { const bf16x8 r = ((const bf16x8*)p)[q];
#pragma unroll
            for (int i = 0; i < 8; ++i) { const float f = bf2f((u16)r[i]); n2 += f * f; } }
        n2 += __shfl_xor(n2, 1);
        if (hf == 0) atomicMax(&lmax[8 + h], __float_as_uint(n2));
    }
#pragma unroll 1
    for (int wh = 0; wh < 2; ++wh) {
        const int ccol = wh ? C_NV : C_DV;
        u16* VT = (u16*)(a.ws + (wh ? WS_VTN : WS_VTD));
        __syncthreads();
        for (int i = tid; i < 64 * 32; i += 512) { const int tk = i >> 5, pc = i & 31;
            *(bf16x8*)(T + tk * 264 + pc * 8) = *(const bf16x8*)(P + (size_t)row_of(b, c, tk) * DPROJ + ccol + pc * 8); }
        __syncthreads();
        {
            const int r = tid >> 1, hf = tid & 1, h = r >> 6, dv = r & 63;
            u16* dst = VT + ((size_t)(b * 4 + h) * 64 + dv) * NKEY + c * 64 + hf * 32;
#pragma unroll
            for (int q = 0; q < 4; ++q) {
                u32x4 o; unsigned w[4];
#pragma unroll
                for (int i = 0; i < 4; ++i) { const int t0 = hf * 32 + q * 8 + i * 2; w[i] = (unsigned)T[t0 * 264 + r] | ((unsigned)T[(t0 + 1) * 264 + r] << 16); }
                o.x = w[0]; o.y = w[1]; o.z = w[2]; o.w = w[3];
                ((u32x4*)dst)[q] = o;
            }
        }
    }
    __syncthreads();
    if (tid < 8) atomicMax(&ctl[(b * 4 + (tid >> 1)) * 2 + (tid & 1)], lmax[tid]);
    else if (tid < 12) atomicMax(&ctl[16 + b * 4 + (tid - 8)], lmax[tid]);
    __syncthreads();
}

__device__ __forceinline__ void gla_bcum(const Args& a, int layer, const u16* prow, int h, int dir, int lane, float (&bc)[32]) {
    int vz = 0; asm volatile("" : "+v"(vz));
    const float* wa = a.in[dir ? I_WAB : I_WAF] + (size_t)layer * 16 * 128 + h * 32 + vz;
    const float* ba = a.in[dir ? I_BAB : I_BAF] + (size_t)layer * 128 + h * 32 + vz;
    const bf16x8 r0 = *(const bf16x8*)(prow + C_AF + dir * 16), r1 = *(const bf16x8*)(prow + C_AF + dir * 16 + 8);
    float av[16];
#pragma unroll
    for (int i = 0; i < 8; ++i) { av[i] = bf2f((u16)r0[i]); av[8 + i] = bf2f((u16)r1[i]); }
#pragma unroll
    for (int d = 0; d < 32; ++d) {
        float z = ba[d];
#pragma unroll
        for (int r = 0; r < 16; ++r) z += av[r] * wa[r * 128 + d];
        const float ls = fminf(z, 0.f) - log1pf(expf(-fabsf(z)));
        bc[d] = ls * (1.0f / 16.0f);
        if ((d & 3) == 3) __builtin_amdgcn_sched_barrier(0);
    }
#pragma unroll
    for (int off = 1; off < 64; off <<= 1) {
#pragma unroll
        for (int d = 0; d < 32; ++d) {
            if (dir == 0) { const float t = __shfl_up(bc[d], off); if (lane >= off) bc[d] += t; }
            else { const float t = __shfl_down(bc[d], off); if (lane + off < 64) bc[d] += t; }
        }
    }
}
__device__ __forceinline__ int gla_scan_idx(int dir, int c) { return dir == 0 ? c : ((c < 4) ? 3 - c : 263 - c); }

__device__ __forceinline__ void gla_g1_wave(const Args& a, int layer, int wu, uchar* wlds, int lane) {
    asm volatile("" : "+v"(lane));
    const int h = __builtin_amdgcn_readfirstlane(wu & 3), bc_ = __builtin_amdgcn_readfirstlane(wu >> 2), b = bc_ / NCH, c = bc_ % NCH;
    const u16* P = (const u16*)(a.ws + WS_X);
    const u16* prow = P + (size_t)row_of(b, c, lane) * DPROJ;
    float* KO = (float*)wlds;
    u16* VS = (u16*)(wlds + 8192);
    float* U = (float*)(a.ws + WS_U); float* DEC = (float*)(a.ws + WS_DEC);
#pragma unroll
    for (int q = 0; q < 8; ++q) ((bf16x8*)(VS + lane * 64))[q] = ((const bf16x8*)(prow + C_GV + h * 64))[q];
#pragma unroll 1
    for (int dir = 0; dir < 2; ++dir) {
        float bc[32];
        gla_bcum(a, layer, prow, h, dir, lane, bc);
        const int n = gla_scan_idx(dir, c);
        const size_t sidx = ((size_t)((b * 2 + dir) * 4 + h) * NCH + n);
        {
            f32x4* bcp = (f32x4*)((float*)(a.ws + WS_BC) + ((((size_t)((b * 2 + dir) * 4 + h) * NCH + c) * 64 + lane) * 32));
#pragma unroll
            for (int q = 0; q < 8; ++q) bcp[q] = (f32x4){bc[q * 4], bc[q * 4 + 1], bc[q * 4 + 2], bc[q * 4 + 3]};
        }
        bf16x8 kr[4];
#pragma unroll
        for (int q = 0; q < 4; ++q) kr[q] = ((const bf16x8*)(prow + C_GK + h * 32))[q];
#pragma unroll
        for (int q = 0; q < 8; ++q) {
            f32x4 o;
#pragma unroll
            for (int e = 0; e < 4; ++e) { const int d = q * 4 + e; const float bl = __shfl(bc[d], dir ? 0 : 63); o[e] = bf2f((u16)kr[d >> 3][d & 7]) * expf(bl - bc[d]); }
            ((f32x4*)(KO + lane * 32))[q] = o;
        }
        if (lane == (dir ? 0 : 63)) {
#pragma unroll
            for (int q = 0; q < 8; ++q) { f32x4 o;
#pragma unroll
                for (int e = 0; e < 4; ++e) o[e] = expf(bc[q * 4 + e]);
                ((f32x4*)(DEC + sidx * 32))[q] = o; }
        }
        WAVE_SYNC();
        float acc[32];
#pragma unroll
        for (int d = 0; d < 32; ++d) acc[d] = 0.f;
#pragma unroll 1
        for (int tk = 0; tk < 64; ++tk) {
            const float vv = bf2f(VS[tk * 64 + lane]);
#pragma unroll
            for (int q = 0; q < 8; ++q) { const f32x4 k4 = ((const f32x4*)(KO + tk * 32))[q];
#pragma unroll
                for (int e = 0; e < 4; ++e) acc[q * 4 + e] += k4[e] * vv; }
        }
        float* ub = U + sidx * 2048;
#pragma unroll
        for (int d = 0; d < 32; ++d) ub[d * 64 + lane] = acc[d];
        WAVE_SYNC();
    }
}
__device__ __forceinline__ void gla_scan(const Args& a) {
    int tid = threadIdx.x; asm volatile("" : "+v"(tid));
    if (tid >= 128) return;
    float* U = (float*)(a.ws + WS_U); const float* DEC = (const float*)(a.ws + WS_DEC);
    for (int gidx = blockIdx.x * 128 + tid; gidx < 16 * 2048; gidx += gridDim.x * 128) {
        const int seq = gidx >> 11, e = gidx & 2047, d = e >> 6;
        float* u = U + (size_t)seq * NCH * 2048 + e; const float* dc = DEC + (size_t)seq * NCH * 32 + d;
        float s = 0.f;
#pragma unroll 4
        for (int n = 0; n < NCH; ++n) { const float un = u[(size_t)n * 2048], dn = dc[n * 32]; u[(size_t)n * 2048] = s; s = dn * s + un; }
    }
}
__device__ __forceinline__ void gla_g3_wave(const Args& a, int layer, int wu, uchar* wlds, int lane) {
    asm volatile("" : "+v"(lane));
    const int h = __builtin_amdgcn_readfirstlane(wu & 3), bc_ = __builtin_amdgcn_readfirstlane(wu >> 2), b = bc_ / NCH, c = bc_ % NCH;
    const int fr = lane & 15, fq = lane >> 4;
    const u16* P = (const u16*)(a.ws + WS_X);
    const int row_l = row_of(b, c, lane);
    const u16* prow = P + (size_t)row_l * DPROJ;
    u16* R0 = (u16*)wlds;
    u16* ST = (u16*)(wlds + 4096);
    u16* VT = (u16*)(wlds + 8192);
    const float* U = (const float*)(a.ws + WS_U);
    {
        bf16x8 vr[8];
#pragma unroll
        for (int q = 0; q < 8; ++q) vr[q] = ((const bf16x8*)(prow + C_GV + h * 64))[q];
#pragma unroll
        for (int q = 0; q < 8; ++q)
#pragma unroll
            for (int i = 0; i < 8; ++i) VT[(q * 8 + i) * 64 + lane] = (u16)vr[q][i];
    }
    f32x4 O[4][4];
#pragma unroll
    for (int qb = 0; qb < 4; ++qb)
#pragma unroll
        for (int dvb = 0; dvb < 4; ++dvb) O[qb][dvb] = (f32x4){0.f, 0.f, 0.f, 0.f};
#pragma unroll 1
    for (int dir = 0; dir < 2; ++dir) {
        const int n = gla_scan_idx(dir, c);
        const float* sp = U + ((size_t)((b * 2 + dir) * 4 + h) * NCH + n) * 2048;
        u32x4 qpk[4], kpk[4];
        {
            const f32x4* bcp = (const f32x4*)((const float*)(a.ws + WS_BC) + ((((size_t)((b * 2 + dir) * 4 + h) * NCH + c) * 64 + lane) * 32));
#pragma unroll
            for (int q = 0; q < 4; ++q) {
                const bf16x8 qr = ((const bf16x8*)(prow + C_GQ + h * 32))[q], kr = ((const bf16x8*)(prow + C_GK + h * 32))[q];
                const f32x4 b0 = bcp[2 * q], b1 = bcp[2 * q + 1];
                float e[8];
#pragma unroll
                for (int i = 0; i < 4; ++i) { e[i] = expf(b0[i]); e[4 + i] = expf(b1[i]); }
                unsigned wq[4], wk[4];
#pragma unroll
                for (int i = 0; i < 4; ++i) {
                    wq[i] = pk2(bf2f((u16)qr[2 * i]) * 0.17677669529663687f * e[2 * i], bf2f((u16)qr[2 * i + 1]) * 0.17677669529663687f * e[2 * i + 1]);
                    wk[i] = pk2(bf2f((u16)kr[2 * i]) / e[2 * i], bf2f((u16)kr[2 * i + 1]) / e[2 * i + 1]);
                }
                qpk[q] = (u32x4){wq[0], wq[1], wq[2], wq[3]}; kpk[q] = (u32x4){wk[0], wk[1], wk[2], wk[3]};
            }
        }
        WAVE_SYNC();
#pragma unroll
        for (int q = 0; q < 4; ++q) ((u32x4*)(R0 + lane * 32))[q] = qpk[q];
#pragma unroll
        for (int q = 0; q < 4; ++q) { u32x4 o; unsigned w[4];
#pragma unroll
            for (int i = 0; i < 4; ++i) { const int d = q * 8 + 2 * i; w[i] = pk2(sp[d * 64 + lane], sp[(d + 1) * 64 + lane]); }
            o.x = w[0]; o.y = w[1]; o.z = w[2]; o.w = w[3]; ((u32x4*)(ST + lane * 32))[q] = o; }
        WAVE_SYNC();
        bf16x8 qf[4];
#pragma unroll
        for (int qb = 0; qb < 4; ++qb) qf[qb] = *(const bf16x8*)(R0 + (qb * 16 + fr) * 32 + fq * 8);
        WAVE_SYNC();
#pragma unroll
        for (int q = 0; q < 4; ++q) ((u32x4*)(R0 + lane * 32))[q] = kpk[q];
        WAVE_SYNC();
#pragma unroll
        for (int dvb = 0; dvb < 4; ++dvb) {
            const bf16x8 sf = *(const bf16x8*)(ST + (dvb * 16 + fr) * 32 + fq * 8);
#pragma unroll
            for (int qb = 0; qb < 4; ++qb) O[qb][dvb] = __builtin_amdgcn_mfma_f32_16x16x32_bf16(sf, qf[qb], O[qb][dvb], 0, 0, 0);
        }
#pragma unroll
        for (int ip = 0; ip < 2; ++ip) {
            const bf16x8 kf0 = *(const bf16x8*)(R0 + ((2 * ip) * 16 + fr) * 32 + fq * 8), kf1 = *(const bf16x8*)(R0 + ((2 * ip + 1) * 16 + fr) * 32 + fq * 8);
            bf16x8 pf[4];
#pragma unroll
            for (int qb = 0; qb < 4; ++qb) {
                f32x4 a0 = (f32x4){0.f, 0.f, 0.f, 0.f}, a1 = a0;
                a0 = __builtin_amdgcn_mfma_f32_16x16x32_bf16(kf0, qf[qb], a0, 0, 0, 0);
                a1 = __builtin_amdgcn_mfma_f32_16x16x32_bf16(kf1, qf[qb], a1, 0, 0, 0);
                const int i = qb * 16 + fr;
                float p[8];
#pragma unroll
                for (int jj = 0; jj < 4; ++jj) {
                    const int j0 = (2 * ip) * 16 + fq * 4 + jj, j1 = j0 + 16;
                    p[jj] = (dir == 0 ? (j0 <= i) : (j0 >= i)) ? a0[jj] : 0.f;
                    p[4 + jj] = (dir == 0 ? (j1 <= i) : (j1 >= i)) ? a1[jj] : 0.f;
                }
                u32x4 w; w.x = pk2(p[0], p[1]); w.y = pk2(p[2], p[3]); w.z = pk2(p[4], p[5]); w.w = pk2(p[6], p[7]);
                pf[qb] = __builtin_bit_cast(bf16x8, w);
            }
#pragma unroll
            for (int dvb = 0; dvb < 4; ++dvb) {
                const u16* vp = VT + (dvb * 16 + fr) * 64 + (2 * ip) * 16 + fq * 4;
                const s16x4 lo = *(const s16x4*)vp, hi = *(const s16x4*)(vp + 16);
                const bf16x8 vf = __builtin_shufflevector(lo, hi, 0, 1, 2, 3, 4, 5, 6, 7);
#pragma unroll
                for (int qb = 0; qb < 4; ++qb) O[qb][dvb] = __builtin_amdgcn_mfma_f32_16x16x32_bf16(vf, pf[qb], O[qb][dvb], 0, 0, 0);
            }
        }
    }
    const float* gnw = a.in[I_GNORM] + layer * 64;
    u16* MIX = (u16*)(a.ws + WS_A);
#pragma unroll
    for (int qb = 0; qb < 4; ++qb) {
        float ss = 0.f;
#pragma unroll
        for (int dvb = 0; dvb < 4; ++dvb)
#pragma unroll
            for (int jj = 0; jj < 4; ++jj) ss += O[qb][dvb][jj] * O[qb][dvb][jj];
        ss += __shfl_xor(ss, 16); ss += __shfl_xor(ss, 32);
        const float r = rsqrtf(ss * (1.0f / 64.0f) + 1e-6f);
        const int row = row_of(b, c, qb * 16 + fr);
#pragma unroll
        for (int dvb = 0; dvb < 4; ++dvb) {
            const int v0 = dvb * 16 + fq * 4;
            const s16x4 g4 = *(const s16x4*)(P + (size_t)row * DPROJ + C_GG + h * 64 + v0);
            const f32x4 nw = *(const f32x4*)(gnw + v0);
            float o[4];
#pragma unroll
            for (int jj = 0; jj < 4; ++jj) o[jj] = O[qb][dvb][jj] * r * nw[jj] * silu_f(bf2f((u16)g4[jj]));
            u32x2 w; w.x = pk2(o[0], o[1]); w.y = pk2(o[2], o[3]);
            *(u32x2*)(MIX + (size_t)row * D + h * 64 + v0) = w;
        }
    }
    WAVE_SYNC();
}

__device__ __forceinline__ void conv_unit(const Args& a, int layer, int unit, uchar* lds) {
    int tid = threadIdx.x; asm volatile("" : "+v"(tid)); const int lane = tid & 63, wave = tid >> 6, fr = lane & 15, fq = lane >> 4;
    int t0, L, rowbase;
    if (unit < 1024) { const int b = unit >> 9; t0 = (unit & 511) * 32; L = SEQ; rowbase = b * SEQ; }
    else { const int uu = unit - 1024, b = uu >> 3; t0 = (uu & 7) * 32; L = CTXL; rowbase = MX + b * CTXL; }
    const u16* P = (const u16*)(a.ws + WS_X);
    float* Ub = (float*)lds;
    float* Y = (float*)(lds + 65536);
    u16* Z = (u16*)(lds + 98304);
    for (int i = tid; i < 62 * 64; i += 512) {
        const int p = i >> 6, c4 = (i & 63) * 4, t = t0 - 15 + p;
        f32x4 u = (f32x4){0.f, 0.f, 0.f, 0.f};
        if (t >= 0 && t < L) {
            const u16* pr = P + (size_t)(rowbase + t) * DPROJ;
            const s16x4 av = *(const s16x4*)(pr + C_CA + c4), gv = *(const s16x4*)(pr + C_CG + c4);
#pragma unroll
            for (int e = 0; e < 4; ++e) { const float g = bf2f((u16)gv[e]); u[e] = bf2f((u16)av[e]) / (1.0f + __expf(-g)); }
        }
        *(f32x4*)(Ub + p * 256 + c4) = u;
    }
    __syncthreads();
    {
        const int c = tid & 255, th = tid >> 8;
        const float* dw = a.in[I_CDW] + (size_t)layer * 31 * 256 + c;
        float w[31];
#pragma unroll
        for (int k = 0; k < 31; ++k) w[k] = dw[k * 256];
        const float bias = a.in[I_CDWB][layer * 256 + c];
#pragma unroll 1
        for (int tt = 0; tt < 16; ++tt) {
            const int t = th * 16 + tt; float acc = bias;
#pragma unroll
            for (int k = 0; k < 31; ++k) acc += w[k] * Ub[(t + k) * 256 + c];
            Y[t * 256 + c] = acc;
        }
    }
    __syncthreads();
    {
        const f32x4 g4 = *(const f32x4*)(a.in[I_CLNG] + layer * 256 + lane * 4), b4 = *(const f32x4*)(a.in[I_CLNB] + layer * 256 + lane * 4);
#pragma unroll
        for (int q = 0; q < 4; ++q) {
            const int t = wave * 4 + q;
            const f32x4 v = *(const f32x4*)(Y + t * 256 + lane * 4);
            const float mu = wave_sum((v.x + v.y) + (v.z + v.w)) * (1.0f / 256.0f);
            const f32x4 dlt = v - mu;
            const float var = wave_sum((dlt.x * dlt.x + dlt.y * dlt.y) + (dlt.z * dlt.z + dlt.w * dlt.w)) * (1.0f / 256.0f);
            const float rs = rsqrtf(var + 1e-5f);
            float z[4];
#pragma unroll
            for (int e = 0; e < 4; ++e) z[e] = silu_f(dlt[e] * rs * g4[e] + b4[e]);
            u32x2 w; w.x = pk2(z[0], z[1]); w.y = pk2(z[2], z[3]);
            *(u32x2*)(Z + t * 264 + lane * 4) = w;
        }
    }
    __syncthreads();
    {
        const u16* PWT = (const u16*)(a.ws + WS_PWT) + (size_t)layer * 256 * 256;
        f32x4 acc[2][2];
#pragma unroll
        for (int i = 0; i < 2; ++i)
#pragma unroll
            for (int j = 0; j < 2; ++j) acc[i][j] = (f32x4){0.f, 0.f, 0.f, 0.f};
#pragma unroll 2
        for (int ks = 0; ks < 8; ++ks) {
            bf16x8 zf[2], wf[2];
#pragma unroll
            for (int tb = 0; tb < 2; ++tb) zf[tb] = *(const bf16x8*)(Z + (tb * 16 + fr) * 264 + ks * 32 + fq * 8);
#pragma unroll
            for (int nbi = 0; nbi < 2; ++nbi) wf[nbi] = *(const bf16x8*)(PWT + (size_t)((wave * 2 + nbi) * 16 + fr) * 256 + ks * 32 + fq * 8);
#pragma unroll
            for (int nbi = 0; nbi < 2; ++nbi)
#pragma unroll
                for (int tb = 0; tb < 2; ++tb) acc[nbi][tb] = __builtin_amdgcn_mfma_f32_16x16x32_bf16(wf[nbi], zf[tb], acc[nbi][tb], 0, 0, 0);
        }
        u16* MIX = (u16*)(a.ws + WS_A);
#pragma unroll
        for (int nbi = 0; nbi < 2; ++nbi) {
            const int n0 = (wave * 2 + nbi) * 16 + fq * 4;
            const f32x4 pb = *(const f32x4*)(a.in[I_CPWB] + layer * 256 + n0);
#pragma unroll
            for (int tb = 0; tb < 2; ++tb) {
                const int row = rowbase + t0 + tb * 16 + fr;
                u32x2 w; w.x = pk2(acc[nbi][tb][0] + pb[0], acc[nbi][tb][1] + pb[1]); w.y = pk2(acc[nbi][tb][2] + pb[2], acc[nbi][tb][3] + pb[3]);
                *(u32x2*)(MIX + (size_t)row * D + 768 + n0) = w;
            }
        }
    }
    __syncthreads();
}

__device__ __forceinline__ bf16x8 pack8(const f32x4& p0, const f32x4& p1) {
    u32x4 w; w.x = pg8::cvt_pk_bf16(p0[0], p0[1]); w.y = pg8::cvt_pk_bf16(p0[2], p0[3]); w.z = pg8::cvt_pk_bf16(p1[0], p1[1]); w.w = pg8::cvt_pk_bf16(p1[2], p1[3]);
    return __builtin_bit_cast(bf16x8, w);
}
__device__ __forceinline__ bf16x8 load_scaled8(const u16* p, float sc, float& n2) {
    const bf16x8 raw = *(const bf16x8*)p; bf16x8 o;
#pragma unroll
    for (int i = 0; i < 8; ++i) { const u16 r = f2bf(bf2f((u16)raw[i]) * sc); const float f = bf2f(r); n2 += f * f; o[i] = (short)r; }
    return o;
}

__device__ __forceinline__ void diff_unit(const Args& a, int layer, int b, int h, int q0row, int ntiles, uchar* lds) {
    int tid = threadIdx.x; asm volatile("" : "+v"(tid)); const int lane = tid & 63, wave = tid >> 6, fr = lane & 15, fq = lane >> 4;
    const u16* P = (const u16*)(a.ws + WS_X);
    const u16* VTD = (const u16*)(a.ws + WS_VTD) + (size_t)(b * 4 + h) * 64 * NKEY;
    const unsigned* ctl = (const unsigned*)(a.ws + WS_CTL) + layer * 64;
    u16* Ks = (u16*)lds;
    u16* Vs = (u16*)(lds + 2 * 64 * 72 * 2);
    const float C2 = 0.17677669529663687f * LOG2E;
    bf16x8 qf[2][2]; float negb[2][2];
#pragma unroll
    for (int qb = 0; qb < 2; ++qb)
#pragma unroll
        for (int s = 0; s < 2; ++s) {
            const int row = q0row + wave * 32 + qb * 16 + fr; float n2 = 0.f;
            qf[qb][s] = load_scaled8(P + (size_t)row * DPROJ + C_DQ + h * 64 + s * 32 + fq * 8, C2, n2);
            n2 += __shfl_xor(n2, 16); n2 += __shfl_xor(n2, 32);
            const float km = __uint_as_float(ctl[(b * 4 + h) * 2 + s]);
            negb[qb][s] = -sqrtf(n2 * km);
        }
    f32x4 O[2][2][4]; float ls[2][2];
#pragma unroll
    for (int qb = 0; qb < 2; ++qb)
#pragma unroll
        for (int s = 0; s < 2; ++s) { ls[qb][s] = 0.f;
#pragma unroll
            for (int dvb = 0; dvb < 4; ++dvb) O[qb][s][dvb] = (f32x4){0.f, 0.f, 0.f, 0.f}; }
    const int sr = tid >> 3, pc = tid & 7;
    auto kaddr = [&](int t) -> const u16* { const int krow = (t < 4) ? (MX + b * CTXL + t * 64 + sr) : (b * SEQ + (t - 4) * 64 + sr); return P + (size_t)krow * DPROJ + C_DK + h * 64 + pc * 8; };
    bf16x8 kreg = *(const bf16x8*)kaddr(0), vreg = *(const bf16x8*)(VTD + (size_t)sr * NKEY + pc * 8);
    __syncthreads();
#pragma unroll 1
    for (int t = 0; t < ntiles; ++t) {
        u16* Kb = Ks + (t & 1) * 64 * 72; u16* Vb = Vs + (t & 1) * 64 * 72;
        *(bf16x8*)(Kb + sr * 72 + pc * 8) = kreg; *(bf16x8*)(Vb + sr * 72 + pc * 8) = vreg;
        __syncthreads();
        if (t + 1 < ntiles) { kreg = *(const bf16x8*)kaddr(t + 1); vreg = *(const bf16x8*)(VTD + (size_t)sr * NKEY + (t + 1) * 64 + pc * 8); }
#pragma unroll
        for (int i = 0; i < 2; ++i) {
            bf16x8 pf[2][2];
#pragma unroll
            for (int s = 0; s < 2; ++s) {
                const bf16x8 kf0 = *(const bf16x8*)(Kb + ((2 * i) * 16 + fr) * 72 + s * 32 + fq * 8), kf1 = *(const bf16x8*)(Kb + ((2 * i + 1) * 16 + fr) * 72 + s * 32 + fq * 8);
#pragma unroll
                for (int qb = 0; qb < 2; ++qb) {
                    const float nb = negb[qb][s];
                    f32x4 a0 = (f32x4){nb, nb, nb, nb}, a1 = a0;
                    a0 = __builtin_amdgcn_mfma_f32_16x16x32_bf16(kf0, qf[qb][s], a0, 0, 0, 0);
                    a1 = __builtin_amdgcn_mfma_f32_16x16x32_bf16(kf1, qf[qb][s], a1, 0, 0, 0);
#pragma unroll
                    for (int j = 0; j < 4; ++j) { a0[j] = __builtin_amdgcn_exp2f(a0[j]); a1[j] = __builtin_amdgcn_exp2f(a1[j]); }
                    ls[qb][s] += ((a0[0] + a0[1]) + (a0[2] + a0[3])) + ((a1[0] + a1[1]) + (a1[2] + a1[3]));
                    pf[qb][s] = pack8(a0, a1);
                }
            }
#pragma unroll
            for (int dvb = 0; dvb < 4; ++dvb) {
                const u16* vp = Vb + (dvb * 16 + fr) * 72 + (2 * i) * 16 + fq * 4;
                const s16x4 lo = *(const s16x4*)vp, hi = *(const s16x4*)(vp + 16);
                const bf16x8 vf = __builtin_shufflevector(lo, hi, 0, 1, 2, 3, 4, 5, 6, 7);
#pragma unroll
                for (int qb = 0; qb < 2; ++qb)
#pragma unroll
                    for (int s = 0; s < 2; ++s) O[qb][s][dvb] = __builtin_amdgcn_mfma_f32_16x16x32_bf16(vf, pf[qb][s], O[qb][s][dvb], 0, 0, 0);
            }
        }
    }
    const float lam_init = (layer == 0) ? 0.2f : (0.8f - 0.6f * 0.7408182206817179f);
    float d1 = 0.f, d2 = 0.f;
    if (lane < 32) { d1 = a.in[I_LQ1][layer * 32 + lane] * a.in[I_LK1][layer * 32 + lane]; d2 = a.in[I_LQ2][layer * 32 + lane] * a.in[I_LK2][layer * 32 + lane]; }
    const float lam = expf(wave_sum(d1)) - expf(wave_sum(d2)) + lam_init;
    const float* dnw = a.in[I_DNORM] + layer * 64;
    u16* MIX = (u16*)(a.ws + WS_A);
#pragma unroll
    for (int qb = 0; qb < 2; ++qb) {
        float l1 = ls[qb][0], l2 = ls[qb][1];
        l1 += __shfl_xor(l1, 16); l1 += __shfl_xor(l1, 32); l2 += __shfl_xor(l2, 16); l2 += __shfl_xor(l2, 32);
        const float i1 = 1.0f / l1, i2 = lam / l2;
        f32x4 o[4]; float ss = 0.f;
#pragma unroll
        for (int dvb = 0; dvb < 4; ++dvb) { o[dvb] = O[qb][0][dvb] * i1 - O[qb][1][dvb] * i2; ss += (o[dvb][0] * o[dvb][0] + o[dvb][1] * o[dvb][1]) + (o[dvb][2] * o[dvb][2] + o[dvb][3] * o[dvb][3]); }
        ss += __shfl_xor(ss, 16); ss += __shfl_xor(ss, 32);
        const float r = rsqrtf(ss * (1.0f / 64.0f) + 1e-6f) * (1.0f - lam_init);
        const int row = q0row + wave * 32 + qb * 16 + fr;
#pragma unroll
        for (int dvb = 0; dvb < 4; ++dvb) {
            const int v0 = dvb * 16 + fq * 4; const f32x4 nw = *(const f32x4*)(dnw + v0);
            u32x2 w; w.x = pk2(o[dvb][0] * r * nw[0], o[dvb][1] * r * nw[1]); w.y = pk2(o[dvb][2] * r * nw[2], o[dvb][3] * r * nw[3]);
            *(u32x2*)(MIX + (size_t)row * D + 512 + h * 64 + v0) = w;
        }
    }
}

__device__ __forceinline__ void na_wave(const Args& a, int layer, bool ctxq, int wu, int lane) {
    asm volatile("" : "+v"(lane));
    const int fr = lane & 15, fq = lane >> 4;
    const u16* P = (const u16*)(a.ws + WS_X);
    int b, h, r, qblk, qrow;
    if (!ctxq) { qblk = wu & 3; h = (wu >> 2) & 3; r = (wu >> 4) & 255; b = wu >> 12; qrow = b * SEQ + r * 64 + qblk * 16 + fr; }
    else { qblk = wu & 15; h = (wu >> 4) & 3; b = wu >> 6; r = 0; qrow = MX + b * CTXL + qblk * 16 + fr; }
    const int c = qblk * 16 + fr;
    const u16* VTN = (const u16*)(a.ws + WS_VTN) + (size_t)(b * 4 + h) * 64 * NKEY;
    const float C2 = 0.125f * LOG2E;
    bf16x8 qf[2]; float n2 = 0.f;
#pragma unroll
    for (int ks = 0; ks < 2; ++ks) qf[ks] = load_scaled8(P + (size_t)qrow * DPROJ + C_NQ + h * 64 + ks * 32 + fq * 8, C2, n2);
    n2 += __shfl_xor(n2, 16); n2 += __shfl_xor(n2, 32);
    const float km = __uint_as_float(((const unsigned*)(a.ws + WS_CTL))[layer * 64 + 16 + b * 4 + h]);
    const float bmax = ((const float*)(a.ws + WS_MISC))[8192 + layer];
    const float negb = -(sqrtf(n2 * km) + bmax * LOG2E);
    const float* rpb = a.in[I_RPB] + (size_t)(layer * 4 + h) * 15 * 31;
    const int rs = min(max(r - 4, 0), 248), cs = min(max(c - 8, 0), 48);
    f32x4 O[4]; float ls = 0.f;
#pragma unroll
    for (int dvb = 0; dvb < 4; ++dvb) O[dvb] = (f32x4){0.f, 0.f, 0.f, 0.f};
    const int ntile = ctxq ? 4 : 12;
#pragma unroll 1
    for (int t = 0; t < ntile; ++t) {
        const bool win = (!ctxq) && (t < 8);
        const int tc = ctxq ? t : t - 8;
        const int kr = rs + t;
        const int krow0 = win ? (b * SEQ + kr * 64) : (MX + b * CTXL + tc * 64);
        const int key0 = win ? (CTXL + kr * 64) : (tc * 64);
#pragma unroll 1
        for (int i = 0; i < 2; ++i) {
            if (win && ((qblk == 0 && i == 1) || (qblk == 3 && i == 0))) continue;
            f32x4 acc[2];
#pragma unroll
            for (int kbb = 0; kbb < 2; ++kbb) {
                const int kb = 2 * i + kbb;
#pragma unroll
                for (int j = 0; j < 4; ++j) {
                    float iv = negb;
                    if (win) { const int kc = kb * 16 + fq * 4 + j; const bool inw = (kc >= cs) && (kc < cs + 16);
                        const int co = min(max(kc - c + 15, 0), 30);
                        const float bias = rpb[(kr - r + 7) * 31 + co];
                        iv = inw ? (bias * LOG2E + negb) : -1e30f; }
                    acc[kbb][j] = iv;
                }
#pragma unroll
                for (int ks = 0; ks < 2; ++ks) {
                    const bf16x8 kf = *(const bf16x8*)(P + (size_t)(krow0 + kb * 16 + fr) * DPROJ + C_NK + h * 64 + ks * 32 + fq * 8);
                    acc[kbb] = __builtin_amdgcn_mfma_f32_16x16x32_bf16(kf, qf[ks], acc[kbb], 0, 0, 0);
                }
#pragma unroll
                for (int j = 0; j < 4; ++j) acc[kbb][j] = __builtin_amdgcn_exp2f(acc[kbb][j]);
                ls += (acc[kbb][0] + acc[kbb][1]) + (acc[kbb][2] + acc[kbb][3]);
            }
            const bf16x8 pf = pack8(acc[0], acc[1]);
#pragma unroll
            for (int dvb = 0; dvb < 4; ++dvb) {
                const u16* vp = VTN + (size_t)(dvb * 16 + fr) * NKEY + key0 + (2 * i) * 16 + fq * 4;
                const s16x4 lo = *(const s16x4*)vp, hi = *(const s16x4*)(vp + 16);
                const bf16x8 vf = __builtin_shufflevector(lo, hi, 0, 1, 2, 3, 4, 5, 6, 7);
                O[dvb] = __builtin_amdgcn_mfma_f32_16x16x32_bf16(vf, pf, O[dvb], 0, 0, 0);
            }
        }
    }
    ls += __shfl_xor(ls, 16); ls += __shfl_xor(ls, 32);
    const float il = 1.0f / ls;
    u16* MIX = (u16*)(a.ws + WS_A);
#pragma unroll
    for (int dvb = 0; dvb < 4; ++dvb) {
        u32x2 w; w.x = pk2(O[dvb][0] * il, O[dvb][1] * il); w.y = pk2(O[dvb][2] * il, O[dvb][3] * il);
        *(u32x2*)(MIX + (size_t)qrow * D + 256 + h * 64 + dvb * 16 + fq * 4) = w;
    }
}


template <int PHMASK, int PH> __device__ __forceinline__ void phase_body(unsigned char* lds) {
#if defined(__HIP_DEVICE_COMPILE__)
    const __attribute__((address_space(4))) Args* kp = (const __attribute__((address_space(4))) Args*)__builtin_amdgcn_kernarg_segment_ptr();
    asm volatile("" : "+s"(kp));
    Args a; __builtin_memcpy(&a, (const void*)kp, sizeof(Args));
#else
    Args a{};
#endif
    int tid = threadIdx.x; asm volatile("" : "+v"(tid)); const int lane = tid & 63, wave = __builtin_amdgcn_readfirstlane(tid >> 6), G = gridDim.x, bid = blockIdx.x;
    u16* const Abuf = (u16*)(a.ws + WS_A);
    u16* const Xbuf = (u16*)(a.ws + WS_X);
    if constexpr (PH == 0) { if constexpr ((PHMASK & 1) != 0) phase_prep(a, lds); }
    else if constexpr (PH == NPHASE - 1) { if constexpr ((PHMASK & 2) != 0) phase_final(a); }
    else {
        constexpr int layer = (PH - 1) / 12, sp = (PH - 1) % 12;
        constexpr bool last = (layer == 1);
        constexpr int Mpost = last ? MX : MT;
        if constexpr (sp == 0) { if constexpr ((PHMASK & 2) != 0) phase_norm(a, layer, 0, MT, layer == 0); }
        if constexpr (sp == 3) { if constexpr ((PHMASK & 2) != 0) phase_norm(a, layer, 1, MT, false); }
        if constexpr (sp == 9) { if constexpr ((PHMASK & 2) != 0) phase_norm(a, layer, 2, Mpost, false); }
        if constexpr ((sp == 1 || sp == 10) && (PHMASK & 4)) {
            const int M = (sp == 1) ? MT : Mpost;
            pg8::Gemm g{Abuf, (const u16*)(a.ws + WS_W13) + (size_t)(layer * 2 + (sp == 1 ? 0 : 1)) * 2 * DFF * D, M, 2 * DFF, D};
            pg8::StaticOrder S; S.init(M, 2 * DFF, G, bid);
            EpiSwiglu E{Xbuf};
            pg8::gemm_phase<EpiSwiglu, pg8::StaticOrder, true, true>((LAS unsigned char*)lds, g, S, E);
        }
        if constexpr ((sp == 2 || sp == 11) && (PHMASK & 4)) {
            const int M = (sp == 2) ? MT : Mpost;
            pg8::Gemm g{Xbuf, (const u16*)(a.ws + WS_W2) + (size_t)(layer * 2 + (sp == 2 ? 0 : 1)) * D * DFF, M, D, DFF};
            pg8::StaticOrder S; S.init(M, D, G, bid);
            EpiResid E{a.out, (float*)(a.ws + WS_HC), modp(a, layer, 0, sp == 2 ? 2 : 8), 0.5f};
            pg8::gemm_phase<EpiResid, pg8::StaticOrder, true, true>((LAS unsigned char*)lds, g, S, E);
        }
        if constexpr (sp == 4 && (PHMASK & 4)) {
            pg8::Gemm g{Abuf, (const u16*)(a.ws + WS_WIN) + (size_t)layer * NPROJ * D, MT, NPROJ, D};
            pg8::StaticOrder S; S.init(MT, NPROJ, G, bid);
            EpiProj E{Xbuf};
            pg8::gemm_phase<EpiProj, pg8::StaticOrder, true, true>((LAS unsigned char*)lds, g, S, E);
        }
        if constexpr (sp == 5) {
            if constexpr ((PHMASK & 8) != 0) for (int u = bid; u < 2 * NCH; u += G) prep_unit(a, layer, u, lds);
            __syncthreads();
            if constexpr ((PHMASK & 16) != 0) for (int wu = bid * 8 + wave; wu < 2 * NCH * 4; wu += G * 8) gla_g1_wave(a, layer, wu, lds + wave * 16384, lane);
            __syncthreads();
            const int ncu = last ? 1024 : 1040;
            if constexpr ((PHMASK & 32) != 0) for (int u = bid; u < ncu; u += G) conv_unit(a, layer, u, lds);
        }
        if constexpr (sp == 6) {
            if constexpr ((PHMASK & 64) != 0) gla_scan(a);
            if constexpr ((PHMASK & 128) != 0) for (int wu = bid * 8 + wave; wu < 2 * 256 * 16; wu += G * 8) na_wave(a, layer, false, wu, lane);
            if constexpr ((PHMASK & 128) != 0 && !last) for (int wu = bid * 8 + wave; wu < 2 * 4 * 16; wu += G * 8) na_wave(a, layer, true, wu, lane);
            if constexpr ((PHMASK & 256) != 0) for (int u = bid; u < 512; u += G) { const int b = u >> 8, h = (u >> 6) & 3, qb = u & 63; diff_unit(a, layer, b, h, b * SEQ + qb * 256, NCH, lds); }
            if constexpr ((PHMASK & 256) != 0 && !last) for (int u = bid; u < 8; u += G) { const int b = u >> 2, h = u & 3; diff_unit(a, layer, b, h, MX + b * CTXL, 4, lds); }
        }
        if constexpr (sp == 7) {
            __syncthreads();
            if constexpr ((PHMASK & 512) != 0) for (int wu = bid * 8 + wave; wu < 2 * NCH * 4; wu += G * 8) { const int c = (wu >> 2) % NCH; if (last && c < 4) continue; gla_g3_wave(a, layer, wu, lds + wave * 16384, lane); }
        }
        if constexpr (sp == 8 && (PHMASK & 4)) {
            pg8::Gemm g{Abuf, (const u16*)(a.ws + WS_WOUT) + (size_t)layer * D * D, Mpost, D, D};
            pg8::StaticOrder S; S.init(Mpost, D, G, bid);
            EpiResid E{a.out, (float*)(a.ws + WS_HC), modp(a, layer, 0, 5), 1.0f};
            pg8::gemm_phase<EpiResid, pg8::StaticOrder, true, true>((LAS unsigned char*)lds, g, S, E);
        }
    }
}
template <int PHMASK, int PH> __device__ __forceinline__ void run_phase(int lo, int hi, unsigned char* lds, cg::grid_group& grid) {
    if (lo <= PH && PH < hi) { if (PH > lo) grid.sync(); phase_body<PHMASK, PH>(lds); }
}
template <int PHMASK> __device__ __forceinline__ void run_phases(const Args& a, unsigned char* lds) {
    cg::grid_group grid = cg::this_grid();
    const int lo = a.ph_lo, hi = a.ph_hi;
#define RP(k) run_phase<PHMASK, k>(lo, hi, lds, grid);
    RP(0) RP(1) RP(2) RP(3) RP(4) RP(5) RP(6) RP(7) RP(8) RP(9) RP(10) RP(11) RP(12) RP(13) RP(14) RP(15) RP(16) RP(17) RP(18) RP(19) RP(20) RP(21) RP(22) RP(23) RP(24) RP(25)
#undef RP
}
extern __shared__ __attribute__((aligned(16))) unsigned char dyn_lds[];
template <int PM> __global__ void __launch_bounds__(512, 2) part_fwd(Args a) { run_phases<PM>(a, dyn_lds); }
#ifndef MK_PER_PHASE
#define MK_PER_PHASE 0
#endif
#if !MK_PER_PHASE
__global__ void __launch_bounds__(512, 2) mega_fwd(Args a) { run_phases<0xFFFF>(a, dyn_lds); }
#define MAIN_KERNEL mega_fwd
#else
#define MAIN_KERNEL part_fwd<4>
#endif
#ifndef MK_PER_PHASE
#define MK_PER_PHASE 0
#endif
extern "C" void kernel_launch(void* const* d_in, const int* in_sizes, int n_in, void* d_out, int out_size, void* d_ws, size_t ws_size, hipStream_t stream) {
    static int grid = 0;
    if (grid == 0) {
        if (n_in != 33 || ws_size < WS_END) { fprintf(stderr, "kernel_launch: unexpected n_in %d / ws_size %zu (need %zu)\n", n_in, ws_size, (size_t)WS_END); grid = -1; return; }
        int dev = 0, cus = 0, per_cu = 0;
        hipGetDevice(&dev); hipDeviceGetAttribute(&cus, hipDeviceAttributeMultiprocessorCount, dev);
        if (hipFuncSetAttribute((const void*)MAIN_KERNEL, hipFuncAttributeMaxDynamicSharedMemorySize, LDS_BYTES) != hipSuccess) { fprintf(stderr, "kernel_launch: hipFuncSetAttribute failed\n"); grid = -1; return; }
#if MK_PER_PHASE
        (void)hipFuncSetAttribute((const void*)part_fwd<1>, hipFuncAttributeMaxDynamicSharedMemorySize, LDS_BYTES); (void)hipFuncSetAttribute((const void*)part_fwd<2>, hipFuncAttributeMaxDynamicSharedMemorySize, LDS_BYTES);
        (void)hipFuncSetAttribute((const void*)part_fwd<4>, hipFuncAttributeMaxDynamicSharedMemorySize, LDS_BYTES); (void)hipFuncSetAttribute((const void*)part_fwd<56>, hipFuncAttributeMaxDynamicSharedMemorySize, LDS_BYTES);
        (void)hipFuncSetAttribute((const void*)part_fwd<448>, hipFuncAttributeMaxDynamicSharedMemorySize, LDS_BYTES); (void)hipFuncSetAttribute((const void*)part_fwd<512>, hipFuncAttributeMaxDynamicSharedMemorySize, LDS_BYTES);
#endif
        if (hipOccupancyMaxActiveBlocksPerMultiprocessor(&per_cu, (const void*)MAIN_KERNEL, 512, LDS_BYTES) != hipSuccess || per_cu < 1) { fprintf(stderr, "kernel_launch: occupancy query says %d\n", per_cu); per_cu = 1; }
        (void)hipGetLastError();
        grid = cus;
    }
    if (grid < 0) return;
    hipMemsetAsync((char*)d_ws + WS_CTL, 0, 4096, stream);
    Args a{};
    for (int i = 0; i < 33; ++i) a.in[i] = (const float*)d_in[i];
    a.out = (float*)d_out; a.ws = (unsigned char*)d_ws;
#if MK_PER_PHASE
    for (int ph = 0; ph < NPHASE; ++ph) {
        a.ph_lo = ph; a.ph_hi = ph + 1;
        const int sp = (ph == 0 || ph == NPHASE - 1) ? -1 : (ph - 1) % 12;
        if (ph == 0) hipLaunchKernelGGL(part_fwd<1>, dim3(grid), dim3(512), LDS_BYTES, stream, a);
        else if (sp == -1 || sp == 0 || sp == 3 || sp == 9) hipLaunchKernelGGL(part_fwd<2>, dim3(grid), dim3(512), LDS_BYTES, stream, a);
        else if (sp == 5) hipLaunchKernelGGL(part_fwd<56>, dim3(grid), dim3(512), LDS_BYTES, stream, a);
        else if (sp == 6) hipLaunchKernelGGL(part_fwd<448>, dim3(grid), dim3(512), LDS_BYTES, stream, a);
        else if (sp == 7) hipLaunchKernelGGL(part_fwd<512>, dim3(grid), dim3(512), LDS_BYTES, stream, a);
        else hipLaunchKernelGGL(part_fwd<4>, dim3(grid), dim3(512), LDS_BYTES, stream, a);
    }
#else
    a.ph_lo = 0; a.ph_hi = NPHASE;
    void* args[] = {&a};
    hipError_t e = hipLaunchCooperativeKernel((const void*)mega_fwd, dim3(grid), dim3(512), args, LDS_BYTES, stream);
    if (e != hipSuccess) fprintf(stderr, "kernel_launch: cooperative launch failed: %s (grid %d)\n", hipGetErrorString(e), grid);
#endif
}
```

```cpp
#include <hip/hip_runtime.h>
#include <hip/hip_cooperative_groups.h>
#include <cstdio>
#include <cstdint>
namespace cg = cooperative_groups;
#define MK_PER_PHASE 0
namespace pg8 {
#define PG8_LAS __attribute__((address_space(3)))
typedef unsigned short bf16_t;
typedef short bf16x8 __attribute__((ext_vector_type(8)));
typedef float f32x4 __attribute__((ext_vector_type(4)));
typedef unsigned u32x4 __attribute__((ext_vector_type(4)));
constexpr int BM = 256, BK = 64, HALF = 128, HTB = HALF * BK * 2  , STAGE_BYTES = 8 * HTB, NXCD = 8, WGM = 8;

__host__ __device__ __forceinline__ int lds_byte(int r, int c) { const int st = (r >> 4) * 2 + (c >> 5), rr = r & 15, cc = c & 31, ob = rr * 64 + cc * 2; return st * 1024 + (ob ^ (((ob >> 9) & 1) << 5)); }
__host__ __device__ __forceinline__ void stage_rc(int b, int& R, int& C) { const int st = b / 1024, sb = b % 1024, swz = sb ^ (((sb >> 9) & 1) << 5); R = (st >> 1) * 16 + swz / 64; C = (st & 1) * 32 + (swz % 64) / 2; }
__host__ __device__ __forceinline__ int perm32(int rho) { const int n = rho >> 4, i = rho & 15; return 8 * (i >> 2) + 4 * n + (i & 3); }

struct Unit { int pm, pn; };
struct Gemm { const bf16_t* A; const bf16_t* Bt; int M, N, K; };

struct StaticOrder {
    int nM, nN, nwg, G, c;
    __host__ __device__ void init(int M, int N, int G_, int c_) { nM = M / BM; nN = N / BM; nwg = nM * nN; G = G_; c = c_; }
    __host__ __device__ bool next(int i, Unit& u) const {
        const long L = (long)i * G + c; if (L >= nwg) return false;
        int wgid = (int)L; { const int q = nwg / NXCD, r = nwg % NXCD, xcd = wgid % NXCD, off = wgid / NXCD; wgid = (xcd < r ? xcd * (q + 1) : r * (q + 1) + (xcd - r) * q) + off; }
        const int nig = WGM * nN, gid = wgid / nig, fm = gid * WGM, gsz = (nM - fm) < WGM ? (nM - fm) : WGM;
        u.pm = fm + ((wgid % nig) % gsz); u.pn = (wgid % nig) / gsz; return true;
    }
    __device__ __forceinline__ void a_ready(const Unit&) const {}
    __device__ __forceinline__ void done(const Unit&) const {}
};

__device__ __forceinline__ unsigned cvt_pk_bf16(float lo, float hi) { unsigned r; asm volatile("v_cvt_pk_bf16_f32 %0, %1, %2" : "=v"(r) : "v"(lo), "v"(hi)); return r; }
template <class Epi, class Sched, bool ALIGN_EPI = false, bool SP2 = false>
__device__ __forceinline__ void gemm_phase(PG8_LAS unsigned char* lds, const Gemm g, const Sched& S, const Epi& E) {
    int tid_l = threadIdx.x; asm volatile("" : "+v"(tid_l)); const int tid = tid_l, wid = __builtin_amdgcn_readfirstlane(tid >> 6), lane = tid & 63, wr = wid >> 2, wc = wid & 3, fr = lane & 15, fq = lane >> 4;
    const int K = g.K, nt = K / BK;
    unsigned voffA[2], voffB[2];
#pragma unroll
    for (int i = 0; i < 2; ++i) { int R, C; stage_rc(tid * 16 + i * 8192, R, C); const int Rb = Epi::PERM ? ((R & ~31) + perm32(R & 31)) : R;
        voffA[i] = (unsigned)(R * K + C) * 2u; voffB[i] = (unsigned)(Rb * K + C) * 2u; }
    const size_t kstep = (size_t)(BK * 2);
    const size_t hstep = (size_t)HALF * K * 2;
    const size_t tstep = 2 * hstep;
    const unsigned ldsw = (unsigned)wid * 1024u;
    const int aoff = lds_byte(wr * 64 + fr, fq * 8), boff = lds_byte(wc * 32 + fr, fq * 8);
#define PG8_SA(b, h) (((b) * 2 + (h)) * HTB)
#define PG8_SB(b, h) ((4 + (b) * 2 + (h)) * HTB)
#define PG8_STAGE(bufoff, gbase, voff) do { _Pragma("unroll") for (int _i = 0; _i < 2; ++_i) \
        __builtin_amdgcn_global_load_lds((const unsigned*)((const char*)(gbase) + (voff)[_i]), (PG8_LAS unsigned*)(lds + (bufoff) + ldsw + _i * 8192), 16, 0, 0); } while (0)
#define PG8_LDA(dst, b, h) do { _Pragma("unroll") for (int m = 0; m < 4; ++m) _Pragma("unroll") for (int k = 0; k < 2; ++k) dst[m][k] = *(const PG8_LAS bf16x8*)(lds + PG8_SA(b, h) + aoff + m * 2048 + k * 1024); } while (0)
#define PG8_LDB(dst, b, h) do { _Pragma("unroll") for (int n = 0; n < 2; ++n) _Pragma("unroll") for (int k = 0; k < 2; ++k) dst[n][k] = *(const PG8_LAS bf16x8*)(lds + PG8_SB(b, h) + boff + n * 2048 + k * 1024); } while (0)
#define PG8_MMA(ai, bj, At, Bt) do { __builtin_amdgcn_s_setprio(1); _Pragma("unroll") for (int m = 0; m < 4; ++m) _Pragma("unroll") for (int n = 0; n < 2; ++n) _Pragma("unroll") for (int k = 0; k < 2; ++k) \
        acc[ai][bj][m][n] = __builtin_amdgcn_mfma_f32_16x16x32_bf16(Bt[n][k], At[m][k], acc[ai][bj][m][n], 0, 0, 0); __builtin_amdgcn_s_setprio(0); } while (0)
#define PG8_WAIT_V(n) asm volatile("s_waitcnt vmcnt(" #n ")" ::: "memory")
#define PG8_WAIT_L(n) asm volatile("s_waitcnt lgkmcnt(" #n ")" ::: "memory")
#define PG8_BAR __builtin_amdgcn_s_barrier()
#define PG8_SCHED __builtin_amdgcn_sched_barrier(0)
    Unit cur, nxt; int ui = 0;
    if (!S.next(0, cur)) return;
    f32x4 acc[2][2][4][2];
#pragma unroll
    for (int a = 0; a < 2; ++a)
#pragma unroll
        for (int b = 0; b < 2; ++b)
#pragma unroll
            for (int m = 0; m < 4; ++m)
#pragma unroll
                for (int n = 0; n < 2; ++n) acc[a][b][m][n] = (f32x4){0.f, 0.f, 0.f, 0.f};
    bf16x8 At[4][2], B0[2][2], B1[2][2];
    const char* cA = (const char*)g.A + (size_t)cur.pm * tstep; const char* cB = (const char*)g.Bt + (size_t)cur.pn * tstep;
    S.a_ready(cur);
    if constexpr (SP2) {
        PG8_STAGE(PG8_SB(0, 0), cB, voffB); PG8_STAGE(PG8_SB(0, 1), cB + hstep, voffB); PG8_STAGE(PG8_SA(0, 0), cA, voffA); PG8_STAGE(PG8_SA(0, 1), cA + hstep, voffA);
        if (wr == 1) PG8_BAR;
        PG8_WAIT_V(2); PG8_BAR;
        PG8_STAGE(PG8_SB(1, 0), cB + kstep, voffB); PG8_STAGE(PG8_SA(1, 0), cA + kstep, voffA); PG8_STAGE(PG8_SB(1, 1), cB + hstep + kstep, voffB);
        PG8_WAIT_V(6); PG8_BAR;
    } else {
        PG8_STAGE(PG8_SB(0, 0), cB, voffB); PG8_STAGE(PG8_SA(0, 0), cA, voffA); PG8_STAGE(PG8_SB(0, 1), cB + hstep, voffB); PG8_STAGE(PG8_SA(0, 1), cA + hstep, voffA);
        if (wr == 1) PG8_BAR;
        PG8_WAIT_V(4); PG8_BAR;
        PG8_STAGE(PG8_SB(1, 0), cB + kstep, voffB); PG8_STAGE(PG8_SA(1, 0), cA + kstep, voffA); PG8_STAGE(PG8_SB(1, 1), cB + hstep + kstep, voffB);
        PG8_WAIT_V(6); PG8_BAR;
    }
    for (;;) {
        const bool has_next = S.next(ui + 1, nxt);
        const char* nA = has_next ? (const char*)g.A + (size_t)nxt.pm * tstep : cA; const char* nB = has_next ? (const char*)g.Bt + (size_t)nxt.pn * tstep : cB;
        for (int t = 0; t < nt; t += 2) {
            const bool last = (t == nt - 2);
            const char* a1 = cA + (size_t)(t + 1) * kstep;
            const char* a2 = last ? nA : cA + (size_t)(t + 2) * kstep; const char* b2 = last ? nB : cB + (size_t)(t + 2) * kstep;
            const char* a3 = a2 + kstep; const char* b3 = b2 + kstep;
            if (last && has_next) S.a_ready(nxt);
            if constexpr (SP2) {
            PG8_LDB(B0, 0, 0); PG8_LDB(B1, 0, 1); PG8_SCHED; PG8_LDA(At, 0, 0); PG8_STAGE(PG8_SA(1, 1), a1 + hstep, voffA);
            PG8_WAIT_V(8); PG8_WAIT_L(0); PG8_BAR; PG8_MMA(0, 0, At, B0); PG8_MMA(0, 1, At, B1); PG8_BAR; PG8_SCHED;
            PG8_LDA(At, 0, 1); PG8_STAGE(PG8_SB(0, 0), b2, voffB); PG8_STAGE(PG8_SB(0, 1), b2 + hstep, voffB); PG8_STAGE(PG8_SA(0, 0), a2, voffA);
            PG8_WAIT_V(8); PG8_WAIT_L(0); PG8_BAR; PG8_MMA(1, 0, At, B0); PG8_MMA(1, 1, At, B1); PG8_BAR; PG8_SCHED;
            PG8_LDB(B0, 1, 0); PG8_LDB(B1, 1, 1); PG8_SCHED; PG8_LDA(At, 1, 0); PG8_STAGE(PG8_SA(0, 1), a2 + hstep, voffA);
            PG8_WAIT_V(8); PG8_WAIT_L(0); PG8_BAR; PG8_MMA(0, 0, At, B0); PG8_MMA(0, 1, At, B1); PG8_BAR; PG8_SCHED;
            PG8_LDA(At, 1, 1); PG8_STAGE(PG8_SB(1, 0), b3, voffB); PG8_STAGE(PG8_SB(1, 1), b3 + hstep, voffB); PG8_STAGE(PG8_SA(1, 0), a3, voffA);
            PG8_WAIT_V(8); PG8_WAIT_L(0); PG8_BAR; PG8_MMA(1, 0, At, B0); PG8_MMA(1, 1, At, B1); PG8_BAR; PG8_SCHED;
            } else {
            PG8_LDB(B0, 0, 0); PG8_SCHED; PG8_LDA(At, 0, 0); PG8_STAGE(PG8_SA(1, 1), a1 + hstep, voffA);
            PG8_WAIT_L(8); PG8_BAR; PG8_WAIT_L(0); PG8_MMA(0, 0, At, B0); PG8_BAR; PG8_SCHED;
            PG8_LDB(B1, 0, 1); PG8_STAGE(PG8_SB(0, 0), b2, voffB);
            PG8_BAR; PG8_WAIT_L(0); PG8_MMA(0, 1, At, B1); PG8_BAR;
            PG8_LDA(At, 0, 1); PG8_STAGE(PG8_SA(0, 0), a2, voffA);
            PG8_BAR; PG8_WAIT_L(0); PG8_MMA(1, 0, At, B0); PG8_BAR; PG8_SCHED;
            PG8_STAGE(PG8_SB(0, 1), b2 + hstep, voffB);
            PG8_WAIT_V(6); PG8_BAR; PG8_MMA(1, 1, At, B1); PG8_BAR;
            PG8_LDB(B0, 1, 0); PG8_SCHED; PG8_LDA(At, 1, 0); PG8_STAGE(PG8_SA(0, 1), a2 + hstep, voffA);
            PG8_WAIT_L(8); PG8_BAR; PG8_WAIT_L(0); PG8_MMA(0, 0, At, B0); PG8_BAR; PG8_SCHED;
            PG8_LDB(B1, 1, 1); PG8_STAGE(PG8_SB(1, 0), b3, voffB);
            PG8_BAR; PG8_WAIT_L(0); PG8_MMA(0, 1, At, B1); PG8_BAR;
            PG8_LDA(At, 1, 1); PG8_STAGE(PG8_SA(1, 0), a3, voffA);
            PG8_BAR; PG8_WAIT_L(0); PG8_MMA(1, 0, At, B0); PG8_BAR; PG8_SCHED;
            PG8_STAGE(PG8_SB(1, 1), b3 + hstep, voffB);
            PG8_WAIT_V(6); PG8_BAR; PG8_MMA(1, 1, At, B1); PG8_BAR;
            }
        }
        if constexpr (ALIGN_EPI) { if (wr == 0) PG8_BAR; }
        if constexpr (!Epi::AFTER_DRAIN) { E(acc, cur, wr, wc, fr, fq); S.done(cur); }
        if (!has_next) break;
#pragma unroll
        for (int a = 0; a < 2; ++a)
#pragma unroll
            for (int b = 0; b < 2; ++b)
#pragma unroll
                for (int m = 0; m < 4; ++m)
#pragma unroll
                    for (int n = 0; n < 2; ++n) acc[a][b][m][n] = (f32x4){0.f, 0.f, 0.f, 0.f};
        cur = nxt; cA = nA; cB = nB; ++ui;
        if constexpr (ALIGN_EPI) { if (wr == 1) PG8_BAR; }
    }
    PG8_WAIT_V(0);
    if constexpr (!ALIGN_EPI) { if (wr == 0) PG8_BAR; }
    PG8_BAR;
    if constexpr (Epi::AFTER_DRAIN) { E.fused(acc, cur, wr, wc, fr, fq, lds, wid, lane); S.done(cur); }
#undef PG8_SA
#undef PG8_SB
#undef PG8_STAGE
#undef PG8_LDA
#undef PG8_LDB
#undef PG8_MMA
#undef PG8_WAIT_V
#undef PG8_WAIT_L
#undef PG8_BAR
#undef PG8_SCHED
}
}

#define LAS __attribute__((address_space(3)))
typedef unsigned short u16;
typedef unsigned char uchar;
typedef short bf16x8 __attribute__((ext_vector_type(8)));
typedef short s16x4 __attribute__((ext_vector_type(4)));
typedef float f32x4 __attribute__((ext_vector_type(4)));
typedef unsigned u32x4 __attribute__((ext_vector_type(4)));
typedef unsigned u32x2 __attribute__((ext_vector_type(2)));

constexpr int D = 1024, SEQ = 16384, CTXL = 256, DFF = 2816, DPROJ = 2848, NPROJ = 3072;
constexpr int MX = 2 * SEQ, MC = 2 * CTXL, MT = MX + MC;
constexpr int NKEY = CTXL + SEQ, NCH = NKEY / 64;
constexpr int C_GQ = 0, C_GK = 128, C_GV = 256, C_GG = 512, C_AF = 768, C_NQ = 800, C_NK = 1056, C_NV = 1312, C_DQ = 1568, C_DK = 1824, C_DV = 2080, C_CA = 2336, C_CG = 2592;
constexpr float LOG2E = 1.4426950408889634f;

constexpr size_t MiB = 1u << 20;
constexpr size_t WS_CTL = 0, WS_MOD = 1 * MiB, WS_MISC = 1 * MiB + 512 * 1024, WS_HC = 2 * MiB, WS_PWT = 4 * MiB, WS_W13 = 8 * MiB, WS_W2 = 52 * MiB, WS_WIN = 74 * MiB,
                 WS_WOUT = 86 * MiB, WS_A = 90 * MiB, WS_X = 155 * MiB, WS_VTD = 336 * MiB, WS_VTN = 353 * MiB, WS_U = 370 * MiB, WS_DEC = 403 * MiB, WS_BC = 404 * MiB, WS_END = 437 * MiB;
constexpr int LDS_BYTES = 131072;
constexpr int NPHASE = 26;

struct Args { const float* in[33]; float* out; unsigned char* ws; int ph_lo, ph_hi; };

enum { I_X = 0, I_C, I_CTX, I_CCTX, I_ADAW, I_ADAB, I_NF1, I_F1W13, I_F1W2, I_NMIX, I_WIN, I_WAF, I_BAF, I_WAB, I_BAB, I_GNORM, I_RPB, I_LQ1, I_LK1, I_LQ2, I_LK2, I_DNORM,
       I_CDW, I_CDWB, I_CLNG, I_CLNB, I_CPW, I_CPWB, I_WOUT, I_NF2, I_F2W13, I_F2W2, I_FNORM };

__device__ __forceinline__ float bf2f(unsigned short h) { return __uint_as_float(((unsigned)h) << 16); }
__device__ __forceinline__ unsigned short f2bf(float f) { unsigned u = __float_as_uint(f); return (unsigned short)((u + 0x7fffu + ((u >> 16) & 1u)) >> 16); }
__device__ __forceinline__ unsigned pk2(float lo, float hi) { return (unsigned)f2bf(lo) | ((unsigned)f2bf(hi) << 16); }
__device__ __forceinline__ float wave_sum(float v) {
#pragma unroll
    for (int o = 1; o < 64; o <<= 1) v += __shfl_xor(v, o);
    return v;
}
__device__ __forceinline__ float silu_f(float x) { return x * __builtin_amdgcn_rcpf(1.0f + __expf(-x)); }
#define WAVE_SYNC() do { asm volatile("s_waitcnt lgkmcnt(0)" ::: "memory"); __builtin_amdgcn_wave_barrier(); } while (0)
__device__ __forceinline__ int row_of(int b, int c, int tk) { return (c < 4) ? (MX + b * CTXL + c * 64 + tk) : (b * SEQ + (c - 4) * 64 + tk); }
__device__ __forceinline__ float* hrow(const Args& a, int row) { return (row < MX) ? (a.out + (size_t)row * D) : ((float*)(a.ws + WS_HC) + (size_t)(row - MX) * D); }
__device__ __forceinline__ const float* modp(const Args& a, int layer, int g, int j) { return (const float*)(a.ws + WS_MOD) + ((size_t)(layer * 3 + g) * 9 + j) * D; }

struct EpiSwiglu {
    static constexpr bool PERM = true, AFTER_DRAIN = false;
    u16* O;
    __device__ __forceinline__ void operator()(const f32x4 (&acc)[2][2][4][2], const pg8::Unit& u, int wr, int wc, int fr, int fq) const {
        const int row0 = u.pm * 256 + wr * 64 + fr, col0 = u.pn * 128 + wc * 32 + 8 * fq;
#pragma unroll
        for (int ai = 0; ai < 2; ++ai)
#pragma unroll
            for (int m = 0; m < 4; ++m) {
                u16* rowp = O + (size_t)(row0 + ai * 128 + m * 16) * DFF + col0;
                const f32x4 a0 = acc[ai][0][m][0], a1 = acc[ai][0][m][1], u0 = acc[ai][1][m][0], u1 = acc[ai][1][m][1];
                float h[8];
#pragma unroll
                for (int e = 0; e < 4; ++e) { h[e] = silu_f(a0[e]) * u0[e]; h[4 + e] = silu_f(a1[e]) * u1[e]; }
                u32x4 w; w.x = pg8::cvt_pk_bf16(h[0], h[1]); w.y = pg8::cvt_pk_bf16(h[2], h[3]); w.z = pg8::cvt_pk_bf16(h[4], h[5]); w.w = pg8::cvt_pk_bf16(h[6], h[7]);
                *(u32x4*)rowp = w;
            }
    }
};
struct EpiResid {
    static constexpr bool PERM = false, AFTER_DRAIN = false;
    float* hx; float* hc; const float* gate0;
    float coef;
    __device__ __forceinline__ void operator()(const f32x4 (&acc)[2][2][4][2], const pg8::Unit& u, int wr, int wc, int fr, int fq) const {
        const int g = u.pm < 64 ? 0 : (u.pm < 128 ? 1 : 2);
        float* base = (u.pm < 128) ? (hx + (size_t)u.pm * 256 * D) : (hc + (size_t)(u.pm - 128) * 256 * D);
        const int row0 = wr * 64 + fr, col0 = u.pn * 256 + wc * 32 + 4 * fq;
        const float* gate = gate0 + (size_t)g * 9 * D;
        f32x4 gv[2][2];
#pragma unroll
        for (int bj = 0; bj < 2; ++bj)
#pragma unroll
            for (int n = 0; n < 2; ++n) gv[bj][n] = *(const f32x4*)(gate + col0 + bj * 128 + n * 16) * coef;
#pragma unroll
        for (int ai = 0; ai < 2; ++ai)
#pragma unroll
            for (int m = 0; m < 4; ++m) {
                float* rowp = base + (size_t)(row0 + ai * 128 + m * 16) * D + col0;
#pragma unroll
                for (int bj = 0; bj < 2; ++bj)
#pragma unroll
                    for (int n = 0; n < 2; ++n) { f32x4* p = (f32x4*)(rowp + bj * 128 + n * 16); *p = *p + gv[bj][n] * acc[ai][bj][m][n]; }
            }
    }
};
struct EpiProj {
    static constexpr bool PERM = true, AFTER_DRAIN = false;
    u16* O;
    __device__ __forceinline__ void operator()(const f32x4 (&acc)[2][2][4][2], const pg8::Unit& u, int wr, int wc, int fr, int fq) const {
        const int row0 = u.pm * 256 + wr * 64 + fr, col0 = u.pn * 256 + wc * 32 + 8 * fq;
#pragma unroll
        for (int ai = 0; ai < 2; ++ai)
#pragma unroll
            for (int m = 0; m < 4; ++m) {
                u16* rowp = O + (size_t)(row0 + ai * 128 + m * 16) * DPROJ;
#pragma unroll
                for (int bj = 0; bj < 2; ++bj) {
                    const int col = col0 + bj * 128;
                    if (col < DPROJ) {
                        const f32x4 v0 = acc[ai][bj][m][0], v1 = acc[ai][bj][m][1];
                        u32x4 w; w.x = pg8::cvt_pk_bf16(v0[0], v0[1]); w.y = pg8::cvt_pk_bf16(v0[2], v0[3]); w.z = pg8::cvt_pk_bf16(v1[0], v1[1]); w.w = pg8::cvt_pk_bf16(v1[2], v1[3]);
                        *(u32x4*)(rowp + col) = w;
                    }
                }
            }
    }
};

__device__ __forceinline__ void transpose_item(const float* W, int N, u16* WT, int K, int k0, int n0, int drow0, float* scr, int lane) {
#pragma unroll 8
    for (int i = 0; i < 32; ++i) { const int kk = 2 * i + (lane >> 5); scr[kk * 33 + (lane & 31)] = W[(size_t)(k0 + kk) * N + n0 + (lane & 31)]; }
    WAVE_SYNC();
    const int c = lane & 7;
#pragma unroll
    for (int j = 0; j < 4; ++j) {
        const int n = (lane >> 3) + 8 * j; const float* s = scr + (8 * c) * 33 + n;
        u32x4 o; o.x = pk2(s[0 * 33], s[1 * 33]); o.y = pk2(s[2 * 33], s[3 * 33]); o.z = pk2(s[4 * 33], s[5 * 33]); o.w = pk2(s[6 * 33], s[7 * 33]);
        *(u32x4*)(WT + (size_t)(drow0 + n) * K + k0 + 8 * c) = o;
    }
    WAVE_SYNC();
}

__device__ __forceinline__ void phase_prep(const Args& a, uchar* lds) {
    int tid = threadIdx.x; asm volatile("" : "+v"(tid)); const int lane = tid & 63, wave = tid >> 6, G = gridDim.x, bid = blockIdx.x;
    {
        float* sc = (float*)lds;
        float* red = sc + 3 * D;
        float* mod = (float*)(a.ws + WS_MOD);
        for (int i = tid; i < 3 * D; i += 512) { const int g = i >> 10, k = i & 1023; const float v = (g < 2) ? a.in[I_C][g * D + k] : a.in[I_CCTX][k]; sc[i] = silu_f(v); }
        __syncthreads();
        for (int u = bid; u < 2 * 144; u += G) {
            const int l = u / 144, cgp = u % 144, kc = tid >> 6, col = tid & 63;
            const float* w = a.in[I_ADAW] + ((size_t)l * D + kc * 128) * 9216 + cgp * 64 + col;
            float a0 = 0.f, a1 = 0.f, a2 = 0.f;
#pragma unroll 8
            for (int kk = 0; kk < 128; ++kk) { const float wv = w[(size_t)kk * 9216]; const int k = kc * 128 + kk; a0 += sc[k] * wv; a1 += sc[D + k] * wv; a2 += sc[2 * D + k] * wv; }
            red[(kc * 3 + 0) * 64 + col] = a0; red[(kc * 3 + 1) * 64 + col] = a1; red[(kc * 3 + 2) * 64 + col] = a2;
            __syncthreads();
            if (tid < 192) {
                const int g = tid >> 6, cc = tid & 63; float s = a.in[I_ADAB][l * 9216 + cgp * 64 + cc];
#pragma unroll
                for (int k8 = 0; k8 < 8; ++k8) s += red[(k8 * 3 + g) * 64 + cc];
                mod[(size_t)(l * 3 + g) * 9216 + cgp * 64 + cc] = s;
            }
            __syncthreads();
        }
        __syncthreads();
    }
    if (bid == 0) {
        float* tr = (float*)(a.ws + WS_MISC);
        for (int i = tid; i < 2560; i += 512) {
            const int j = i & 7; const int pos = (i < 2048) ? (i >> 3) : ((i - 2048) >> 3);
            const double inv = ((j & 1) ? 0.31622776601683794 : 1.0) * ((j >> 1) == 0 ? 1.0 : ((j >> 1) == 1 ? 0.1 : ((j >> 1) == 2 ? 0.01 : 0.001))), ang = (double)pos * inv;
            float* dst = (i < 2048) ? (tr + (size_t)i * 2) : (tr + 4096 + (size_t)(i - 2048) * 2);
            dst[0] = (float)cos(ang); dst[1] = (float)sin(ang);
        }
    }
    if (bid == (1 % G) && wave < 2) {
        const float* rpb = a.in[I_RPB] + wave * 4 * 15 * 31; float m = 0.f;
        for (int i = lane; i < 4 * 15 * 31; i += 64) m = fmaxf(m, fabsf(rpb[i]));
#pragma unroll
        for (int o = 1; o < 64; o <<= 1) m = fmaxf(m, __shfl_xor(m, o));
        if (lane == 0) ((float*)(a.ws + WS_MISC))[8192 + wave] = m;
    }
    {
        const size_t gt = (size_t)bid * 512 + tid, GT = (size_t)G * 512;
        for (int l = 0; l < 2; ++l) { u32x4* z = (u32x4*)((u16*)(a.ws + WS_WIN) + ((size_t)l * NPROJ + DPROJ) * D);
            for (size_t i = gt; i < (size_t)(NPROJ - DPROJ) * D / 8; i += GT) z[i] = (u32x4){0u, 0u, 0u, 0u}; }
    }
    {
        float* scr = (float*)lds + wave * (64 * 33);
        const int gw = bid * 8 + wave, NGW = G * 8;
        constexpr int I13 = 16 * 176, I2 = 44 * 32, IIN = 16 * 89, IOUT = 16 * 32, IPW = 4 * 8;
        constexpr int NIT = 4 * I13 + 4 * I2 + 2 * IIN + 2 * IOUT + 2 * IPW;
        for (int it = gw; it < NIT; it += NGW) {
            int r = it;
            if (r < 4 * I13) { const int mi = r / I13; r -= mi * I13; const int l = mi >> 1, f = mi & 1, kb = r / 176, nb = r % 176, n0 = nb * 32;
                const int j = (n0 < DFF) ? n0 : n0 - DFF; const int drow0 = 256 * (j >> 7) + (j & 127) + ((n0 < DFF) ? 0 : 128);
                transpose_item(a.in[f ? I_F2W13 : I_F1W13] + (size_t)l * D * 2 * DFF, 2 * DFF, (u16*)(a.ws + WS_W13) + (size_t)mi * 2 * DFF * D, D, kb * 64, n0, drow0, scr, lane); continue; }
            r -= 4 * I13;
            if (r < 4 * I2) { const int mi = r / I2; r -= mi * I2; const int l = mi >> 1, f = mi & 1, kb = r / 32, nb = r % 32;
                transpose_item(a.in[f ? I_F2W2 : I_F1W2] + (size_t)l * DFF * D, D, (u16*)(a.ws + WS_W2) + (size_t)mi * D * DFF, DFF, kb * 64, nb * 32, nb * 32, scr, lane); continue; }
            r -= 4 * I2;
            if (r < 2 * IIN) { const int l = r / IIN; r -= l * IIN; const int kb = r / 89, nb = r % 89;
                transpose_item(a.in[I_WIN] + (size_t)l * D * DPROJ, DPROJ, (u16*)(a.ws + WS_WIN) + (size_t)l * NPROJ * D, D, kb * 64, nb * 32, nb * 32, scr, lane); continue; }
            r -= 2 * IIN;
            if (r < 2 * IOUT) { const int l = r / IOUT; r -= l * IOUT; const int kb = r / 32, nb = r % 32;
                transpose_item(a.in[I_WOUT] + (size_t)l * D * D, D, (u16*)(a.ws + WS_WOUT) + (size_t)l * D * D, D, kb * 64, nb * 32, nb * 32, scr, lane); continue; }
            r -= 2 * IOUT;
            { const int l = r / IPW; r -= l * IPW; const int kb = r / 8, nb = r % 8;
                transpose_item(a.in[I_CPW] + (size_t)l * 256 * 256, 256, (u16*)(a.ws + WS_PWT) + (size_t)l * 256 * 256, 256, kb * 64, nb * 32, nb * 32, scr, lane); }
        }
    }
}

__device__ __forceinline__ void phase_norm(const Args& a, int layer, int which, int M, bool first) {
    int tid = threadIdx.x; asm volatile("" : "+v"(tid)); const int lane = tid & 63, wave = tid >> 6;
    const float* nw = a.in[which == 0 ? I_NF1 : (which == 1 ? I_NMIX : I_NF2)] + (size_t)layer * D;
    u16* A = (u16*)(a.ws + WS_A);
    for (int row = blockIdx.x * 8 + wave; row < M; row += gridDim.x * 8) {
        const float* src = first ? ((row < MX) ? a.in[I_X] + (size_t)row * D : a.in[I_CTX] + (size_t)(row - MX) * D) : hrow(a, row);
        const int g = row < SEQ ? 0 : (row < MX ? 1 : 2);
        const float* sh = modp(a, layer, g, 3 * which), * scl = modp(a, layer, g, 3 * which + 1);
        f32x4 v[4]; float ss = 0.f;
#pragma unroll
        for (int j = 0; j < 4; ++j) { v[j] = ((const f32x4*)src)[lane + 64 * j]; ss += (v[j].x * v[j].x + v[j].y * v[j].y) + (v[j].z * v[j].z + v[j].w * v[j].w); }
        if (first) { f32x4* hd = (f32x4*)hrow(a, row);
#pragma unroll
            for (int j = 0; j < 4; ++j) hd[lane + 64 * j] = v[j]; }
        const float rstd = rsqrtf(wave_sum(ss) * (1.0f / D) + 1e-6f);
        u32x2* o = (u32x2*)(A + (size_t)row * D);
#pragma unroll
        for (int j = 0; j < 4; ++j) {
            const f32x4 w4 = ((const f32x4*)nw)[lane + 64 * j], s4 = ((const f32x4*)scl)[lane + 64 * j], b4 = ((const f32x4*)sh)[lane + 64 * j];
            const f32x4 y = (v[j] * rstd) * w4 * (s4 + 1.0f) + b4;
            u32x2 p; p.x = pk2(y.x, y.y); p.y = pk2(y.z, y.w); o[lane + 64 * j] = p;
        }
    }
}
__device__ __forceinline__ void phase_final(const Args& a) {
    int tid = threadIdx.x; asm volatile("" : "+v"(tid)); const int lane = tid & 63, wave = tid >> 6;
    const float* nw = a.in[I_FNORM];
    for (int row = blockIdx.x * 8 + wave; row < MX; row += gridDim.x * 8) {
        f32x4* p = (f32x4*)(a.out + (size_t)row * D);
        f32x4 v[4]; float ss = 0.f;
#pragma unroll
        for (int j = 0; j < 4; ++j) { v[j] = p[lane + 64 * j]; ss += (v[j].x * v[j].x + v[j].y * v[j].y) + (v[j].z * v[j].z + v[j].w * v[j].w); }
        const float rstd = rsqrtf(wave_sum(ss) * (1.0f / D) + 1e-6f);
#pragma unroll
        for (int j = 0; j < 4; ++j) p[lane + 64 * j] = (v[j] * rstd) * ((const f32x4*)nw)[lane + 64 * j];
    }
}

__device__ __forceinline__ void prep_unit(const Args& a, int layer, int unit, uchar* lds) {
    int tid = threadIdx.x; asm volatile("" : "+v"(tid)); const int b = unit / NCH, c = unit % NCH;
    u16* P = (u16*)(a.ws + WS_X);
    unsigned* ctl = (unsigned*)(a.ws + WS_CTL) + layer * 64;
    unsigned* lmax = (unsigned*)lds;
    u16* T = (u16*)(lds + 256);
    if (tid < 12) lmax[tid] = 0u;
    __syncthreads();
    const float* tr = (const float*)(a.ws + WS_MISC);
    {
        const int tk = tid >> 3, row = row_of(b, c, tk);
        const int t = (c - 4) * 64 + tk, gr = t >> 6, gc = t & 63;
#pragma unroll
        for (int e = 0; e < 2; ++e) {
            const int id = (tid & 7) * 2 + e, isk = id >> 3, h = (id >> 1) & 3, s = id & 1;
            u16* p = P + (size_t)row * DPROJ + C_DQ + isk * 256 + h * 64 + s * 32;
            bf16x8 raw[4];
#pragma unroll
            for (int q = 0; q < 4; ++q) raw[q] = ((const bf16x8*)p)[q];
            float x[32];
#pragma unroll
            for (int q = 0; q < 4; ++q)
#pragma unroll
                for (int i = 0; i < 8; ++i) x[q * 8 + i] = bf2f((u16)raw[q][i]);
            if (c >= 4) {
#pragma unroll
                for (int j = 0; j < 8; ++j) {
                    const float cr = tr[(gr * 8 + j) * 2], sr = tr[(gr * 8 + j) * 2 + 1], cc = tr[4096 + (gc * 8 + j) * 2], sc = tr[4096 + (gc * 8 + j) * 2 + 1];
                    const float x0 = x[j], x1 = x[j + 8], y0 = x[16 + j], y1 = x[24 + j];
                    x[j] = x0 * cr - x1 * sr; x[j + 8] = x1 * cr + x0 * sr;
                    x[16 + j] = y0 * cc - y1 * sc; x[24 + j] = y1 * cc + y0 * sc;
                }
                u32x4 o[4];
#pragma unroll
                for (int q = 0; q < 4; ++q) { o[q].x = pk2(x[q * 8], x[q * 8 + 1]); o[q].y = pk2(x[q * 8 + 2], x[q * 8 + 3]); o[q].z = pk2(x[q * 8 + 4], x[q * 8 + 5]); o[q].w = pk2(x[q * 8 + 6], x[q * 8 + 7]); }
#pragma unroll
                for (int q = 0; q < 4; ++q) ((u32x4*)p)[q] = o[q];
            }
            if (isk) {
                float n2 = 0.f;
#pragma unroll
                for (int i = 0; i < 32; ++i) { const float r = bf2f(f2bf(x[i])); n2 += r * r; }
                atomicMax(&lmax[h * 2 + s], __float_as_uint(n2));
            }
        }
    }
    {
        const int tk = tid >> 3, h = (tid & 7) >> 1, hf = tid & 1, row = row_of(b, c, tk);
        const u16* p = P + (size_t)row * DPROJ + C_NK + h * 64 + hf * 32;
        float n2 = 0.f;
#pragma unroll
        for (int q = 0; q < 4; ++q) { const bf16x8 r = ((const bf16x8*)p)[q];
#pragma unroll
            for (int i = 0; i < 8; ++i) { const float f = bf2f((u16)r[i]); n2 += f * f; } }
        n2 += __shfl_xor(n2, 1);
        if (hf == 0) atomicMax(&lmax[8 + h], __float_as_uint(n2));
    }
#pragma unroll 1
    for (int wh = 0; wh < 2; ++wh) {
        const int ccol = wh ? C_NV : C_DV;
        u16* VT = (u16*)(a.ws + (wh ? WS_VTN : WS_VTD));
        __syncthreads();
        for (int i = tid; i < 64 * 32; i += 512) { const int tk = i >> 5, pc = i & 31;
            *(bf16x8*)(T + tk * 264 + pc * 8) = *(const bf16x8*)(P + (size_t)row_of(b, c, tk) * DPROJ + ccol + pc * 8); }
        __syncthreads();
        {
            const int r = tid >> 1, hf = tid & 1, h = r >> 6, dv = r & 63;
            u16* dst = VT + ((size_t)(b * 4 + h) * 64 + dv) * NKEY + c * 64 + hf * 32;
#pragma unroll
            for (int q = 0; q < 4; ++q) {
                u32x4 o; unsigned w[4];
#pragma unroll
                for (int i = 0; i < 4; ++i) { const int t0 = hf * 32 + q * 8 + i * 2; w[i] = (unsigned)T[t0 * 264 + r] | ((unsigned)T[(t0 + 1) * 264 + r] << 16); }
                o.x = w[0]; o.y = w[1]; o.z = w[2]; o.w = w[3];
                ((u32x4*)dst)[q] = o;
            }
        }
    }
    __syncthreads();
    if (tid < 8) atomicMax(&ctl[(b * 4 + (tid >> 1)) * 2 + (tid & 1)], lmax[tid]);
    else if (tid < 12) atomicMax(&ctl[16 + b * 4 + (tid - 8)], lmax[tid]);
    __syncthreads();
}

__device__ __forceinline__ void gla_bcum(const Args& a, int layer, const u16* prow, int h, int dir, int lane, float (&bc)[32]) {
    const float* wa = a.in[dir ? I_WAB : I_WAF] + (size_t)layer * 16 * 128 + h * 32;
    const float* ba = a.in[dir ? I_BAB : I_BAF] + (size_t)layer * 128 + h * 32;
    const bf16x8 r0 = *(const bf16x8*)(prow + C_AF + dir * 16), r1 = *(const bf16x8*)(prow + C_AF + dir * 16 + 8);
    float av[16];
#pragma unroll
    for (int i = 0; i < 8; ++i) { av[i] = bf2f((u16)r0[i]); av[8 + i] = bf2f((u16)r1[i]); }
#pragma unroll
    for (int d = 0; d < 32; ++d) {
        float z = ba[d];
#pragma unroll
        for (int r = 0; r < 16; ++r) z += av[r] * wa[r * 128 + d];
        const float ls = fminf(z, 0.f) - __logf(1.0f + __expf(-fabsf(z)));
        bc[d] = ls * (1.0f / 16.0f);
        if ((d & 3) == 3) __builtin_amdgcn_sched_barrier(0);
    }
#pragma unroll
    for (int off = 1; off < 64; off <<= 1) {
#pragma unroll
        for (int d = 0; d < 32; ++d) {
            if (dir == 0) { const float t = __shfl_up(bc[d], off); if (lane >= off) bc[d] += t; }
            else { const float t = __shfl_down(bc[d], off); if (lane + off < 64) bc[d] += t; }
        }
    }
}
__device__ __forceinline__ int gla_scan_idx(int dir, int c) { return dir == 0 ? c : ((c < 4) ? 3 - c : 263 - c); }

__device__ __forceinline__ void gla_g1_wave(const Args& a, int layer, int b, int c, int h, int dir, uchar* wlds, int lane) {
    asm volatile("" : "+v"(lane));
    const int fr = lane & 15, fq = lane >> 4;
    const u16* P = (const u16*)(a.ws + WS_X);
    const u16* prow = P + (size_t)row_of(b, c, lane) * DPROJ;
    u16* VT = (u16*)wlds;
    u16* KT = (u16*)(wlds + 8192);
    float* U = (float*)(a.ws + WS_U); float* DEC = (float*)(a.ws + WS_DEC);
    {
        bf16x8 vr[8];
#pragma unroll
        for (int q = 0; q < 8; ++q) vr[q] = ((const bf16x8*)(prow + C_GV + h * 64))[q];
#pragma unroll
        for (int q = 0; q < 8; ++q)
#pragma unroll
            for (int i = 0; i < 8; ++i) VT[(q * 8 + i) * 64 + lane] = (u16)vr[q][i];
    }
    float bc[32];
    gla_bcum(a, layer, prow, h, dir, lane, bc);
    const int n = gla_scan_idx(dir, c);
    const size_t sidx = ((size_t)((b * 2 + dir) * 4 + h) * NCH + n);
    {
        f32x4* bcp = (f32x4*)((float*)(a.ws + WS_BC) + ((((size_t)((b * 2 + dir) * 4 + h) * NCH + c) * 64 + lane) * 32));
#pragma unroll
        for (int q = 0; q < 8; ++q) bcp[q] = (f32x4){bc[q * 4], bc[q * 4 + 1], bc[q * 4 + 2], bc[q * 4 + 3]};
    }
    {
        bf16x8 kr[4];
#pragma unroll
        for (int q = 0; q < 4; ++q) kr[q] = ((const bf16x8*)(prow + C_GK + h * 32))[q];
#pragma unroll
        for (int d = 0; d < 32; ++d) { const float bl = __shfl(bc[d], dir ? 0 : 63); KT[d * 64 + lane] = f2bf(bf2f((u16)kr[d >> 3][d & 7]) * __expf(bl - bc[d])); }
    }
    if (lane == (dir ? 0 : 63)) {
#pragma unroll
        for (int q = 0; q < 8; ++q) { f32x4 o;
#pragma unroll
            for (int e = 0; e < 4; ++e) o[e] = __expf(bc[q * 4 + e]);
            ((f32x4*)(DEC + sidx * 32))[q] = o; }
    }
    WAVE_SYNC();
    f32x4 acc[4][2];
#pragma unroll
    for (int dvb = 0; dvb < 4; ++dvb)
#pragma unroll
        for (int db = 0; db < 2; ++db) acc[dvb][db] = (f32x4){0.f, 0.f, 0.f, 0.f};
#pragma unroll
    for (int ks = 0; ks < 2; ++ks) {
        bf16x8 kf[2];
#pragma unroll
        for (int db = 0; db < 2; ++db) kf[db] = *(const bf16x8*)(KT + (db * 16 + fr) * 64 + ks * 32 + fq * 8);
#pragma unroll
        for (int dvb = 0; dvb < 4; ++dvb) {
            const bf16x8 vf = *(const bf16x8*)(VT + (dvb * 16 + fr) * 64 + ks * 32 + fq * 8);
#pragma unroll
            for (int db = 0; db < 2; ++db) acc[dvb][db] = __builtin_amdgcn_mfma_f32_16x16x32_bf16(vf, kf[db], acc[dvb][db], 0, 0, 0);
        }
    }
    float* ub = U + sidx * 2048;
#pragma unroll
    for (int dvb = 0; dvb < 4; ++dvb)
#pragma unroll
        for (int db = 0; db < 2; ++db) *(f32x4*)(ub + (db * 16 + fr) * 64 + dvb * 16 + fq * 4) = acc[dvb][db];
    WAVE_SYNC();
}
__device__ __forceinline__ void gla_scan(const Args& a, uchar* lds) {
    int tid = threadIdx.x; asm volatile("" : "+v"(tid));
    float* U = (float*)(a.ws + WS_U); const float* DEC = (const float*)(a.ws + WS_DEC);
    float* PL = (float*)lds;
    const int seg = tid >> 7, el = tid & 127;
    constexpr int SEGN = NCH / 4;
    for (int blk = blockIdx.x; blk < 16 * 16; blk += gridDim.x) {
        const int seq = blk >> 4, e = (blk & 15) * 128 + el, d = e >> 6;
        float* u = U + ((size_t)seq * NCH + seg * SEGN) * 2048 + e; const float* dc = DEC + ((size_t)seq * NCH + seg * SEGN) * 32 + d;
        float pr = 1.f, s = 0.f;
#pragma unroll 5
        for (int n = 0; n < SEGN; ++n) { const float un = u[(size_t)n * 2048], dn = dc[n * 32]; s = dn * s + un; pr *= dn; }
        __syncthreads();
        PL[(seg * 128 + el) * 2] = pr; PL[(seg * 128 + el) * 2 + 1] = s;
        __syncthreads();
        float s0 = 0.f;
        for (int k = 0; k < seg; ++k) s0 = PL[(k * 128 + el) * 2] * s0 + PL[(k * 128 + el) * 2 + 1];
        s = s0;
#pragma unroll 5
        for (int n = 0; n < SEGN; ++n) { const float un = u[(size_t)n * 2048], dn = dc[n * 32]; u[(size_t)n * 2048] = s; s = dn * s + un; }
    }
    __syncthreads();
}
__device__ __forceinline__ void gla_g3_wave(const Args& a, int layer, int wu, uchar* wlds, int lane) {
    asm volatile("" : "+v"(lane));
    const int h = __builtin_amdgcn_readfirstlane(wu & 3), bc_ = __builtin_amdgcn_readfirstlane(wu >> 2), b = bc_ / NCH, c = bc_ % NCH;
    const int fr = lane & 15, fq = lane >> 4;
    const u16* P = (const u16*)(a.ws + WS_X);
    const int row_l = row_of(b, c, lane);
    const u16* prow = P + (size_t)row_l * DPROJ;
    u16* R0 = (u16*)wlds;
    u16* ST = (u16*)(wlds + 4096);
    u16* VT = (u16*)(wlds + 8192);
    const float* U = (const float*)(a.ws + WS_U);
    {
        bf16x8 vr[8];
#pragma unroll
        for (int q = 0; q < 8; ++q) vr[q] = ((const bf16x8*)(prow + C_GV + h * 64))[q];
#pragma unroll
        for (int q = 0; q < 8; ++q)
#pragma unroll
            for (int i = 0; i < 8; ++i) VT[(q * 8 + i) * 64 + lane] = (u16)vr[q][i];
    }
    f32x4 O[4][4];
#pragma unroll
    for (int qb = 0; qb < 4; ++qb)
#pragma unroll
        for (int dvb = 0; dvb < 4; ++dvb) O[qb][dvb] = (f32x4){0.f, 0.f, 0.f, 0.f};
#pragma unroll 1
    for (int dir = 0; dir < 2; ++dir) {
        const int n = gla_scan_idx(dir, c);
        const float* sp = U + ((size_t)((b * 2 + dir) * 4 + h) * NCH + n) * 2048;
        u32x4 qpk[4], kpk[4];
        {
            const f32x4* bcp = (const f32x4*)((const float*)(a.ws + WS_BC) + ((((size_t)((b * 2 + dir) * 4 + h) * NCH + c) * 64 + lane) * 32));
#pragma unroll
            for (int q = 0; q < 4; ++q) {
                const bf16x8 qr = ((const bf16x8*)(prow + C_GQ + h * 32))[q], kr = ((const bf16x8*)(prow + C_GK + h * 32))[q];
                const f32x4 b0 = bcp[2 * q], b1 = bcp[2 * q + 1];
                float e[8];
#pragma unroll
                for (int i = 0; i < 4; ++i) { e[i] = __expf(b0[i]); e[4 + i] = __expf(b1[i]); }
                unsigned wq[4], wk[4];
#pragma unroll
                for (int i = 0; i < 4; ++i) {
                    wq[i] = pk2(bf2f((u16)qr[2 * i]) * 0.17677669529663687f * e[2 * i], bf2f((u16)qr[2 * i + 1]) * 0.17677669529663687f * e[2 * i + 1]);
                    wk[i] = pk2(bf2f((u16)kr[2 * i]) * __builtin_amdgcn_rcpf(e[2 * i]), bf2f((u16)kr[2 * i + 1]) * __builtin_amdgcn_rcpf(e[2 * i + 1]));
                }
                qpk[q] = (u32x4){wq[0], wq[1], wq[2], wq[3]}; kpk[q] = (u32x4){wk[0], wk[1], wk[2], wk[3]};
            }
        }
        WAVE_SYNC();
#pragma unroll
        for (int q = 0; q < 4; ++q) ((u32x4*)(R0 + lane * 32))[q] = qpk[q];
#pragma unroll
        for (int q = 0; q < 4; ++q) { u32x4 o; unsigned w[4];
#pragma unroll
            for (int i = 0; i < 4; ++i) { const int d = q * 8 + 2 * i; w[i] = pk2(sp[d * 64 + lane], sp[(d + 1) * 64 + lane]); }
            o.x = w[0]; o.y = w[1]; o.z = w[2]; o.w = w[3]; ((u32x4*)(ST + lane * 32))[q] = o; }
        WAVE_SYNC();
        bf16x8 qf[4];
#pragma unroll
        for (int qb = 0; qb < 4; ++qb) qf[qb] = *(const bf16x8*)(R0 + (qb * 16 + fr) * 32 + fq * 8);
        WAVE_SYNC();
#pragma unroll
        for (int q = 0; q < 4; ++q) ((u32x4*)(R0 + lane * 32))[q] = kpk[q];
        WAVE_SYNC();
#pragma unroll
        for (int dvb = 0; dvb < 4; ++dvb) {
            const bf16x8 sf = *(const bf16x8*)(ST + (dvb * 16 + fr) * 32 + fq * 8);
#pragma unroll
            for (int qb = 0; qb < 4; ++qb) O[qb][dvb] = __builtin_amdgcn_mfma_f32_16x16x32_bf16(sf, qf[qb], O[qb][dvb], 0, 0, 0);
        }
#pragma unroll
        for (int ip = 0; ip < 2; ++ip) {
            const bf16x8 kf0 = *(const bf16x8*)(R0 + ((2 * ip) * 16 + fr) * 32 + fq * 8), kf1 = *(const bf16x8*)(R0 + ((2 * ip + 1) * 16 + fr) * 32 + fq * 8);
            bf16x8 pf[4];
#pragma unroll
            for (int qb = 0; qb < 4; ++qb) {
                f32x4 a0 = (f32x4){0.f, 0.f, 0.f, 0.f}, a1 = a0;
                a0 = __builtin_amdgcn_mfma_f32_16x16x32_bf16(kf0, qf[qb], a0, 0, 0, 0);
                a1 = __builtin_amdgcn_mfma_f32_16x16x32_bf16(kf1, qf[qb], a1, 0, 0, 0);
                const int i = qb * 16 + fr;
                float p[8];
#pragma unroll
                for (int jj = 0; jj < 4; ++jj) {
                    const int j0 = (2 * ip) * 16 + fq * 4 + jj, j1 = j0 + 16;
                    p[jj] = (dir == 0 ? (j0 <= i) : (j0 >= i)) ? a0[jj] : 0.f;
                    p[4 + jj] = (dir == 0 ? (j1 <= i) : (j1 >= i)) ? a1[jj] : 0.f;
                }
                u32x4 w; w.x = pk2(p[0], p[1]); w.y = pk2(p[2], p[3]); w.z = pk2(p[4], p[5]); w.w = pk2(p[6], p[7]);
                pf[qb] = __builtin_bit_cast(bf16x8, w);
            }
#pragma unroll
            for (int dvb = 0; dvb < 4; ++dvb) {
                const u16* vp = VT + (dvb * 16 + fr) * 64 + (2 * ip) * 16 + fq * 4;
                const s16x4 lo = *(const s16x4*)vp, hi = *(const s16x4*)(vp + 16);
                const bf16x8 vf = __builtin_shufflevector(lo, hi, 0, 1, 2, 3, 4, 5, 6, 7);
#pragma unroll
                for (int qb = 0; qb < 4; ++qb) O[qb][dvb] = __builtin_amdgcn_mfma_f32_16x16x32_bf16(vf, pf[qb], O[qb][dvb], 0, 0, 0);
            }
        }
    }
    const float* gnw = a.in[I_GNORM] + layer * 64;
    u16* MIX = (u16*)(a.ws + WS_A);
#pragma unroll
    for (int qb = 0; qb < 4; ++qb) {
        float ss = 0.f;
#pragma unroll
        for (int dvb = 0; dvb < 4; ++dvb)
#pragma unroll
            for (int jj = 0; jj < 4; ++jj) ss += O[qb][dvb][jj] * O[qb][dvb][jj];
        ss += __shfl_xor(ss, 16); ss += __shfl_xor(ss, 32);
        const float r = rsqrtf(ss * (1.0f / 64.0f) + 1e-6f);
        const int row = row_of(b, c, qb * 16 + fr);
#pragma unroll
        for (int dvb = 0; dvb < 4; ++dvb) {
            const int v0 = dvb * 16 + fq * 4;
            const s16x4 g4 = *(const s16x4*)(P + (size_t)row * DPROJ + C_GG + h * 64 + v0);
            const f32x4 nw = *(const f32x4*)(gnw + v0);
            float o[4];
#pragma unroll
            for (int jj = 0; jj < 4; ++jj) o[jj] = O[qb][dvb][jj] * r * nw[jj] * silu_f(bf2f((u16)g4[jj]));
            u32x2 w; w.x = pk2(o[0], o[1]); w.y = pk2(o[2], o[3]);
            *(u32x2*)(MIX + (size_t)row * D + h * 64 + v0) = w;
        }
    }
    WAVE_SYNC();
}

__device__ __forceinline__ void conv_unit(const Args& a, int layer, int unit, uchar* lds, const bf16x8 (&wf)[2][8]) {
    int tid = threadIdx.x; asm volatile("" : "+v"(tid)); const int lane = tid & 63, wave = tid >> 6, fr = lane & 15, fq = lane >> 4;
    int t0, L, rowbase;
    if (unit < 1024) { const int b = unit >> 9; t0 = (unit & 511) * 32; L = SEQ; rowbase = b * SEQ; }
    else { const int uu = unit - 1024, b = uu >> 3; t0 = (uu & 7) * 32; L = CTXL; rowbase = MX + b * CTXL; }
    const u16* P = (const u16*)(a.ws + WS_X);
    float* Ub = (float*)lds;
    float* Y = (float*)(lds + 65536);
    u16* Z = (u16*)(lds + 98304);
    for (int i = tid; i < 62 * 64; i += 512) {
        const int p = i >> 6, c4 = (i & 63) * 4, t = t0 - 15 + p;
        f32x4 u = (f32x4){0.f, 0.f, 0.f, 0.f};
        if (t >= 0 && t < L) {
            const u16* pr = P + (size_t)(rowbase + t) * DPROJ;
            const s16x4 av = *(const s16x4*)(pr + C_CA + c4), gv = *(const s16x4*)(pr + C_CG + c4);
#pragma unroll
            for (int e = 0; e < 4; ++e) { const float g = bf2f((u16)gv[e]); u[e] = bf2f((u16)av[e]) / (1.0f + __expf(-g)); }
        }
        *(f32x4*)(Ub + p * 256 + c4) = u;
    }
    __syncthreads();
    {
        const int c = tid & 255, th = tid >> 8;
        const float* dw = a.in[I_CDW] + (size_t)layer * 31 * 256 + c;
        float w[31];
#pragma unroll
        for (int k = 0; k < 31; ++k) w[k] = dw[k * 256];
        const float bias = a.in[I_CDWB][layer * 256 + c];
        float uw[46];
#pragma unroll
        for (int i = 0; i < 46; ++i) uw[i] = Ub[(th * 16 + i) * 256 + c];
#pragma unroll
        for (int tt = 0; tt < 16; ++tt) {
            float acc = bias;
#pragma unroll
            for (int k = 0; k < 31; ++k) acc += w[k] * uw[tt + k];
            Y[(th * 16 + tt) * 256 + c] = acc;
        }
    }
    __syncthreads();
    {
        const f32x4 g4 = *(const f32x4*)(a.in[I_CLNG] + layer * 256 + lane * 4), b4 = *(const f32x4*)(a.in[I_CLNB] + layer * 256 + lane * 4);
#pragma unroll
        for (int q = 0; q < 4; ++q) {
            const int t = wave * 4 + q;
            const f32x4 v = *(const f32x4*)(Y + t * 256 + lane * 4);
            const float mu = wave_sum((v.x + v.y) + (v.z + v.w)) * (1.0f / 256.0f);
            const f32x4 dlt = v - mu;
            const float var = wave_sum((dlt.x * dlt.x + dlt.y * dlt.y) + (dlt.z * dlt.z + dlt.w * dlt.w)) * (1.0f / 256.0f);
            const float rs = rsqrtf(var + 1e-5f);
            float z[4];
#pragma unroll
            for (int e = 0; e < 4; ++e) z[e] = silu_f(dlt[e] * rs * g4[e] + b4[e]);
            u32x2 w; w.x = pk2(z[0], z[1]); w.y = pk2(z[2], z[3]);
            *(u32x2*)(Z + t * 264 + lane * 4) = w;
        }
    }
    __syncthreads();
    {
        f32x4 acc[2][2];
#pragma unroll
        for (int i = 0; i < 2; ++i)
#pragma unroll
            for (int j = 0; j < 2; ++j) acc[i][j] = (f32x4){0.f, 0.f, 0.f, 0.f};
#pragma unroll
        for (int ks = 0; ks < 8; ++ks) {
            bf16x8 zf[2];
#pragma unroll
            for (int tb = 0; tb < 2; ++tb) zf[tb] = *(const bf16x8*)(Z + (tb * 16 + fr) * 264 + ks * 32 + fq * 8);
#pragma unroll
            for (int nbi = 0; nbi < 2; ++nbi)
#pragma unroll
                for (int tb = 0; tb < 2; ++tb) acc[nbi][tb] = __builtin_amdgcn_mfma_f32_16x16x32_bf16(wf[nbi][ks], zf[tb], acc[nbi][tb], 0, 0, 0);
        }
        u16* MIX = (u16*)(a.ws + WS_A);
#pragma unroll
        for (int nbi = 0; nbi < 2; ++nbi) {
            const int n0 = (wave * 2 + nbi) * 16 + fq * 4;
            const f32x4 pb = *(const f32x4*)(a.in[I_CPWB] + layer * 256 + n0);
#pragma unroll
            for (int tb = 0; tb < 2; ++tb) {
                const int row = rowbase + t0 + tb * 16 + fr;
                u32x2 w; w.x = pk2(acc[nbi][tb][0] + pb[0], acc[nbi][tb][1] + pb[1]); w.y = pk2(acc[nbi][tb][2] + pb[2], acc[nbi][tb][3] + pb[3]);
                *(u32x2*)(MIX + (size_t)row * D + 768 + n0) = w;
            }
        }
    }
    __syncthreads();
}

typedef float f32x2_t __attribute__((ext_vector_type(2)));
typedef __bf16 bf16x2_t __attribute__((ext_vector_type(2)));
__device__ __forceinline__ unsigned cvtpk_s(float lo, float hi) { f32x2_t v = {lo, hi}; bf16x2_t b = __builtin_convertvector(v, bf16x2_t); return __builtin_bit_cast(unsigned, b); }
__device__ __forceinline__ bf16x8 pack8(const f32x4& p0, const f32x4& p1) {
    u32x4 w; w.x = cvtpk_s(p0[0], p0[1]); w.y = cvtpk_s(p0[2], p0[3]); w.z = cvtpk_s(p1[0], p1[1]); w.w = cvtpk_s(p1[2], p1[3]);
    return __builtin_bit_cast(bf16x8, w);
}
__device__ __forceinline__ bf16x8 load_scaled8(const u16* p, float sc, float& n2) {
    const bf16x8 raw = *(const bf16x8*)p; bf16x8 o;
#pragma unroll
    for (int i = 0; i < 8; ++i) { const u16 r = f2bf(bf2f((u16)raw[i]) * sc); const float f = bf2f(r); n2 += f * f; o[i] = (short)r; }
    return o;
}

__device__ __forceinline__ void diff_unit(const Args& a, int layer, int b, int h, int q0row, int ntiles, uchar* lds) {
    int tid = threadIdx.x; asm volatile("" : "+v"(tid)); const int lane = tid & 63, wave = tid >> 6, fr = lane & 15, fq = lane >> 4;
    const u16* P = (const u16*)(a.ws + WS_X);
    const u16* VTD = (const u16*)(a.ws + WS_VTD) + (size_t)(b * 4 + h) * 64 * NKEY;
    const unsigned* ctl = (const unsigned*)(a.ws + WS_CTL) + layer * 64;
    u16* Ks = (u16*)lds;
    u16* Vs = (u16*)(lds + 2 * 64 * 72 * 2);
    const float C2 = 0.17677669529663687f * LOG2E;
    bf16x8 qf[2][2]; float negb[2][2];
#pragma unroll
    for (int qb = 0; qb < 2; ++qb)
#pragma unroll
        for (int s = 0; s < 2; ++s) {
            const int row = q0row + wave * 32 + qb * 16 + fr; float n2 = 0.f;
            qf[qb][s] = load_scaled8(P + (size_t)row * DPROJ + C_DQ + h * 64 + s * 32 + fq * 8, C2, n2);
            n2 += __shfl_xor(n2, 16); n2 += __shfl_xor(n2, 32);
            const float km = __uint_as_float(ctl[(b * 4 + h) * 2 + s]);
            negb[qb][s] = -sqrtf(n2 * km);
        }
    f32x4 O[2][2][4], Ls[2][2];
    const bf16x8 ones = (bf16x8){(short)0x3F80, (short)0x3F80, (short)0x3F80, (short)0x3F80, (short)0x3F80, (short)0x3F80, (short)0x3F80, (short)0x3F80};
#pragma unroll
    for (int qb = 0; qb < 2; ++qb)
#pragma unroll
        for (int s = 0; s < 2; ++s) { Ls[qb][s] = (f32x4){0.f, 0.f, 0.f, 0.f};
#pragma unroll
            for (int dvb = 0; dvb < 4; ++dvb) O[qb][s][dvb] = (f32x4){0.f, 0.f, 0.f, 0.f}; }
    const int sr = tid >> 3, pc = tid & 7;
    auto kaddr = [&](int t) -> const u16* { const int krow = (t < 4) ? (MX + b * CTXL + t * 64 + sr) : (b * SEQ + (t - 4) * 64 + sr); return P + (size_t)krow * DPROJ + C_DK + h * 64 + pc * 8; };
    auto vaddr = [&](int t) -> const u16* { return VTD + (size_t)sr * NKEY + t * 64 + pc * 8; };
    auto compute_tile = [&](const u16* Kb, const u16* Vb) {
        f32x4 S0[2][2], S1[2][2];
        bf16x8 pfr[2][2];
        bf16x8 vfr[4];
#define DIFF_QK(g) do { const int i_ = (g) >> 1, s_ = (g) & 1; \
            const bf16x8 kf0 = *(const bf16x8*)(Kb + ((2 * i_) * 16 + fr) * 72 + s_ * 32 + fq * 8), kf1 = *(const bf16x8*)(Kb + ((2 * i_ + 1) * 16 + fr) * 72 + s_ * 32 + fq * 8); \
            _Pragma("unroll") for (int qb = 0; qb < 2; ++qb) { const float nb = negb[qb][s_]; const f32x4 c0 = (f32x4){nb, nb, nb, nb}; \
                S0[(g) & 1][qb] = __builtin_amdgcn_mfma_f32_16x16x32_bf16(kf0, qf[qb][s_], c0, 0, 0, 0); \
                S1[(g) & 1][qb] = __builtin_amdgcn_mfma_f32_16x16x32_bf16(kf1, qf[qb][s_], c0, 0, 0, 0); } } while (0)
#define DIFF_EXP(g) do { _Pragma("unroll") for (int qb = 0; qb < 2; ++qb) { f32x4 e0, e1; \
                _Pragma("unroll") for (int j = 0; j < 4; ++j) { e0[j] = __builtin_amdgcn_exp2f(S0[(g) & 1][qb][j]); e1[j] = __builtin_amdgcn_exp2f(S1[(g) & 1][qb][j]); } \
                pfr[(g) & 1][qb] = pack8(e0, e1); } } while (0)
#define DIFF_VLOAD(i_) do { _Pragma("unroll") for (int dvb = 0; dvb < 4; ++dvb) { const u16* vp = Vb + (dvb * 16 + fr) * 72 + (2 * (i_)) * 16 + fq * 4; \
                const s16x4 lo = *(const s16x4*)vp, hi = *(const s16x4*)(vp + 16); vfr[dvb] = __builtin_shufflevector(lo, hi, 0, 1, 2, 3, 4, 5, 6, 7); } } while (0)
#define DIFF_PV(g) do { const int s_ = (g) & 1; \
            _Pragma("unroll") for (int qb = 0; qb < 2; ++qb) Ls[qb][s_] = __builtin_amdgcn_mfma_f32_16x16x32_bf16(ones, pfr[(g) & 1][qb], Ls[qb][s_], 0, 0, 0); \
            _Pragma("unroll") for (int dvb = 0; dvb < 4; ++dvb) _Pragma("unroll") for (int qb = 0; qb < 2; ++qb) \
                O[qb][s_][dvb] = __builtin_amdgcn_mfma_f32_16x16x32_bf16(vfr[dvb], pfr[(g) & 1][qb], O[qb][s_][dvb], 0, 0, 0); } while (0)
        DIFF_QK(0); DIFF_VLOAD(0);
        DIFF_QK(1); DIFF_EXP(0);
        DIFF_QK(2); DIFF_EXP(1); DIFF_PV(0);
        DIFF_QK(3); DIFF_EXP(2); DIFF_PV(1); DIFF_VLOAD(1);
        DIFF_EXP(3); DIFF_PV(2);
        DIFF_PV(3);
#undef DIFF_QK
#undef DIFF_EXP
#undef DIFF_VLOAD
#undef DIFF_PV
    };
    bf16x8 kA = *(const bf16x8*)kaddr(0), vA = *(const bf16x8*)vaddr(0), kB = *(const bf16x8*)kaddr(1), vB = *(const bf16x8*)vaddr(1);
    __syncthreads();
#pragma unroll 1
    for (int t = 0; t < ntiles; t += 2) {
        *(bf16x8*)(Ks + sr * 72 + pc * 8) = kA; *(bf16x8*)(Vs + sr * 72 + pc * 8) = vA;
        __syncthreads();
        if (t + 2 < ntiles) { kA = *(const bf16x8*)kaddr(t + 2); vA = *(const bf16x8*)vaddr(t + 2); }
        compute_tile(Ks, Vs);
        *(bf16x8*)(Ks + 64 * 72 + sr * 72 + pc * 8) = kB; *(bf16x8*)(Vs + 64 * 72 + sr * 72 + pc * 8) = vB;
        __syncthreads();
        if (t + 3 < ntiles) { kB = *(const bf16x8*)kaddr(t + 3); vB = *(const bf16x8*)vaddr(t + 3); }
        compute_tile(Ks + 64 * 72, Vs + 64 * 72);
    }
    const float lam_init = (layer == 0) ? 0.2f : (0.8f - 0.6f * 0.7408182206817179f);
    float d1 = 0.f, d2 = 0.f;
    if (lane < 32) { d1 = a.in[I_LQ1][layer * 32 + lane] * a.in[I_LK1][layer * 32 + lane]; d2 = a.in[I_LQ2][layer * 32 + lane] * a.in[I_LK2][layer * 32 + lane]; }
    const float lam = expf(wave_sum(d1)) - expf(wave_sum(d2)) + lam_init;
    const float* dnw = a.in[I_DNORM] + layer * 64;
    u16* MIX = (u16*)(a.ws + WS_A);
#pragma unroll
    for (int qb = 0; qb < 2; ++qb) {
        const float l1 = Ls[qb][0][0], l2 = Ls[qb][1][0];
        const float i1 = 1.0f / l1, i2 = lam / l2;
        f32x4 o[4]; float ss = 0.f;
#pragma unroll
        for (int dvb = 0; dvb < 4; ++dvb) { o[dvb] = O[qb][0][dvb] * i1 - O[qb][1][dvb] * i2; ss += (o[dvb][0] * o[dvb][0] + o[dvb][1] * o[dvb][1]) + (o[dvb][2] * o[dvb][2] + o[dvb][3] * o[dvb][3]); }
        ss += __shfl_xor(ss, 16); ss += __shfl_xor(ss, 32);
        const float r = rsqrtf(ss * (1.0f / 64.0f) + 1e-6f) * (1.0f - lam_init);
        const int row = q0row + wave * 32 + qb * 16 + fr;
#pragma unroll
        for (int dvb = 0; dvb < 4; ++dvb) {
            const int v0 = dvb * 16 + fq * 4; const f32x4 nw = *(const f32x4*)(dnw + v0);
            u32x2 w; w.x = pk2(o[dvb][0] * r * nw[0], o[dvb][1] * r * nw[1]); w.y = pk2(o[dvb][2] * r * nw[2], o[dvb][3] * r * nw[3]);
            *(u32x2*)(MIX + (size_t)row * D + 512 + h * 64 + v0) = w;
        }
    }
}

__device__ __forceinline__ void na_wave(const Args& a, int layer, bool ctxq, int wu, int lane) {
    asm volatile("" : "+v"(lane));
    const int fr = lane & 15, fq = lane >> 4;
    const u16* P = (const u16*)(a.ws + WS_X);
    int b, h, r, qblk, qrow;
    if (!ctxq) { qblk = wu & 3; h = (wu >> 2) & 3; r = (wu >> 4) & 255; b = wu >> 12; qrow = b * SEQ + r * 64 + qblk * 16 + fr; }
    else { qblk = wu & 15; h = (wu >> 4) & 3; b = wu >> 6; r = 0; qrow = MX + b * CTXL + qblk * 16 + fr; }
    const int c = qblk * 16 + fr;
    const u16* VTN = (const u16*)(a.ws + WS_VTN) + (size_t)(b * 4 + h) * 64 * NKEY;
    const float C2 = 0.125f * LOG2E;
    bf16x8 qf[2]; float n2 = 0.f;
#pragma unroll
    for (int ks = 0; ks < 2; ++ks) qf[ks] = load_scaled8(P + (size_t)qrow * DPROJ + C_NQ + h * 64 + ks * 32 + fq * 8, C2, n2);
    n2 += __shfl_xor(n2, 16); n2 += __shfl_xor(n2, 32);
    const float km = __uint_as_float(((const unsigned*)(a.ws + WS_CTL))[layer * 64 + 16 + b * 4 + h]);
    const float bmax = ((const float*)(a.ws + WS_MISC))[8192 + layer];
    const float negb = -(sqrtf(n2 * km) + bmax * LOG2E);
    const float* rpb = a.in[I_RPB] + (size_t)(layer * 4 + h) * 15 * 31;
    const int rs = min(max(r - 4, 0), 248), cs = min(max(c - 8, 0), 48);
    f32x4 O[4]; float ls = 0.f;
#pragma unroll
    for (int dvb = 0; dvb < 4; ++dvb) O[dvb] = (f32x4){0.f, 0.f, 0.f, 0.f};
    const int nwh = (qblk == 0 || qblk == 3) ? 1 : 2, nwin = ctxq ? 0 : 8 * nwh, nsteps = nwin + 8;
    struct NaStep { bf16x8 kf[2][2]; s16x4 vlo[4], vhi[4]; float iv[2][4]; };
    auto load_step = [&](int st, NaStep& S) {
        int t, i; bool win;
        if (st < nwin) { win = true; if (nwh == 2) { t = st >> 1; i = st & 1; } else { t = st; i = (qblk == 3) ? 1 : 0; } }
        else { win = false; const int s2 = st - nwin; t = s2 >> 1; i = s2 & 1; }
        const int kr = rs + t;
        const int krow0 = win ? (b * SEQ + kr * 64) : (MX + b * CTXL + t * 64);
        const int key0 = win ? (CTXL + kr * 64) : (t * 64);
#pragma unroll
        for (int kbb = 0; kbb < 2; ++kbb) {
            const int kb = 2 * i + kbb;
#pragma unroll
            for (int ks = 0; ks < 2; ++ks) S.kf[kbb][ks] = *(const bf16x8*)(P + (size_t)(krow0 + kb * 16 + fr) * DPROJ + C_NK + h * 64 + ks * 32 + fq * 8);
#pragma unroll
            for (int j = 0; j < 4; ++j) {
                float iv = negb;
                if (win) { const int kc = kb * 16 + fq * 4 + j; const bool inw = (kc >= cs) && (kc < cs + 16);
                    const int co = min(max(kc - c + 15, 0), 30);
                    const float bias = rpb[(kr - r + 7) * 31 + co];
                    iv = inw ? (bias * LOG2E + negb) : -1e30f; }
                S.iv[kbb][j] = iv;
            }
        }
#pragma unroll
        for (int dvb = 0; dvb < 4; ++dvb) {
            const u16* vp = VTN + (size_t)(dvb * 16 + fr) * NKEY + key0 + (2 * i) * 16 + fq * 4;
            S.vlo[dvb] = *(const s16x4*)vp; S.vhi[dvb] = *(const s16x4*)(vp + 16);
        }
    };
    auto compute_step = [&](const NaStep& S) {
        f32x4 acc[2];
#pragma unroll
        for (int kbb = 0; kbb < 2; ++kbb) {
            acc[kbb] = (f32x4){S.iv[kbb][0], S.iv[kbb][1], S.iv[kbb][2], S.iv[kbb][3]};
#pragma unroll
            for (int ks = 0; ks < 2; ++ks) acc[kbb] = __builtin_amdgcn_mfma_f32_16x16x32_bf16(S.kf[kbb][ks], qf[ks], acc[kbb], 0, 0, 0);
#pragma unroll
            for (int j = 0; j < 4; ++j) acc[kbb][j] = __builtin_amdgcn_exp2f(acc[kbb][j]);
            ls += (acc[kbb][0] + acc[kbb][1]) + (acc[kbb][2] + acc[kbb][3]);
        }
        const bf16x8 pf = pack8(acc[0], acc[1]);
#pragma unroll
        for (int dvb = 0; dvb < 4; ++dvb) {
            const bf16x8 vf = __builtin_shufflevector(S.vlo[dvb], S.vhi[dvb], 0, 1, 2, 3, 4, 5, 6, 7);
            O[dvb] = __builtin_amdgcn_mfma_f32_16x16x32_bf16(vf, pf, O[dvb], 0, 0, 0);
        }
    };
    {
        NaStep SA, SB;
        load_step(0, SA);
#pragma unroll 1
        for (int st = 0; st < nsteps; st += 2) {
            load_step(st + 1, SB);
            compute_step(SA);
            if (st + 2 < nsteps) load_step(st + 2, SA);
            compute_step(SB);
        }
    }
    ls += __shfl_xor(ls, 16); ls += __shfl_xor(ls, 32);
    const float il = 1.0f / ls;
    u16* MIX = (u16*)(a.ws + WS_A);
#pragma unroll
    for (int dvb = 0; dvb < 4; ++dvb) {
        u32x2 w; w.x = pk2(O[dvb][0] * il, O[dvb][1] * il); w.y = pk2(O[dvb][2] * il, O[dvb][3] * il);
        *(u32x2*)(MIX + (size_t)qrow * D + 256 + h * 64 + dvb * 16 + fq * 4) = w;
    }
}


#ifndef PROBE_DIFF
#define PROBE_DIFF 1
#endif
#ifndef PROBE_NA
#define PROBE_NA 1
#endif
#ifndef PROBE_G13
#define PROBE_G13 1
#endif
#ifndef PROBE_G1
#define PROBE_G1 1
#endif
#ifndef PROBE_CONV
#define PROBE_CONV 1
#endif
#ifndef PROBE_G3
#define PROBE_G3 1
#endif
#ifndef PROBE_NORM
#define PROBE_NORM 1
#endif
template <int PHMASK, int PH> __device__ __forceinline__ void phase_body(unsigned char* lds) {
#if defined(__HIP_DEVICE_COMPILE__)
    const __attribute__((address_space(4))) Args* kp = (const __attribute__((address_space(4))) Args*)__builtin_amdgcn_kernarg_segment_ptr();
    asm volatile("" : "+s"(kp));
    Args a; __builtin_memcpy(&a, (const void*)kp, sizeof(Args));
#else
    Args a{};
#endif
    int tid = threadIdx.x; asm volatile("" : "+v"(tid)); const int lane = tid & 63, wave = __builtin_amdgcn_readfirstlane(tid >> 6), G = gridDim.x, bid = blockIdx.x;
    u16* const Abuf = (u16*)(a.ws + WS_A);
    u16* const Xbuf = (u16*)(a.ws + WS_X);
    if constexpr (PH == 0) { if constexpr ((PHMASK & 1) != 0) phase_prep(a, lds); }
    else if constexpr (PH == NPHASE - 1) { if constexpr ((PHMASK & 2) != 0) phase_final(a); }
    else {
        constexpr int layer = (PH - 1) / 12, sp = (PH - 1) % 12;
        constexpr bool last = (layer == 1);
        constexpr int Mpost = last ? MX : MT;
        if constexpr (sp == 0) { if constexpr ((PHMASK & 2) != 0) for (int rep = 0; rep < PROBE_NORM; ++rep) phase_norm(a, layer, 0, MT, layer == 0); }
        if constexpr (sp == 3) { if constexpr ((PHMASK & 2) != 0) for (int rep = 0; rep < PROBE_NORM; ++rep) phase_norm(a, layer, 1, MT, false); }
        if constexpr (sp == 9) { if constexpr ((PHMASK & 2) != 0) for (int rep = 0; rep < PROBE_NORM; ++rep) phase_norm(a, layer, 2, Mpost, false); }
        if constexpr ((sp == 1 || sp == 10) && (PHMASK & 4)) {
            const int M = (sp == 1) ? MT : Mpost;
            pg8::Gemm g{Abuf, (const u16*)(a.ws + WS_W13) + (size_t)(layer * 2 + (sp == 1 ? 0 : 1)) * 2 * DFF * D, M, 2 * DFF, D};
            pg8::StaticOrder S; S.init(M, 2 * DFF, G, bid);
            EpiSwiglu E{Xbuf};
            for (int rep = 0; rep < PROBE_G13; ++rep) pg8::gemm_phase<EpiSwiglu, pg8::StaticOrder, true, true>((LAS unsigned char*)lds, g, S, E);
        }
        if constexpr ((sp == 2 || sp == 11) && (PHMASK & 4)) {
            const int M = (sp == 2) ? MT : Mpost;
            pg8::Gemm g{Xbuf, (const u16*)(a.ws + WS_W2) + (size_t)(layer * 2 + (sp == 2 ? 0 : 1)) * D * DFF, M, D, DFF};
            pg8::StaticOrder S; S.init(M, D, G, bid);
            EpiResid E{a.out, (float*)(a.ws + WS_HC), modp(a, layer, 0, sp == 2 ? 2 : 8), 0.5f};
            pg8::gemm_phase<EpiResid, pg8::StaticOrder, true, true>((LAS unsigned char*)lds, g, S, E);
        }
        if constexpr (sp == 4 && (PHMASK & 4)) {
            pg8::Gemm g{Abuf, (const u16*)(a.ws + WS_WIN) + (size_t)layer * NPROJ * D, MT, NPROJ, D};
            pg8::StaticOrder S; S.init(MT, NPROJ, G, bid);
            EpiProj E{Xbuf};
            pg8::gemm_phase<EpiProj, pg8::StaticOrder, true, true>((LAS unsigned char*)lds, g, S, E);
        }
        if constexpr (sp == 5) {
            if constexpr ((PHMASK & 8) != 0) for (int u = bid; u < 2 * NCH; u += G) prep_unit(a, layer, u, lds);
            __syncthreads();
            if constexpr ((PHMASK & 16) != 0) for (int rep = 0; rep < PROBE_G1; ++rep) {
                const int gw = bid * 8 + wave, NGW = G * 8;
                for (int wu = gw; wu < 4096; wu += NGW) {
                    const int dir = wu & 1, h = (wu >> 1) & 3, xc = (wu >> 3) & 255, b = wu >> 11;
                    gla_g1_wave(a, layer, b, xc + 4, h, dir, lds + wave * 16384, lane);
                }
                for (int j = 0; j < 64; ++j) if ((j * 32) % NGW == gw) {
                    const int dir = j & 1, h = (j >> 1) & 3, c = (j >> 3) & 3, b = j >> 5;
                    gla_g1_wave(a, layer, b, c, h, dir, lds + wave * 16384, lane);
                }
            }
            __syncthreads();
            const int ncu = last ? 1024 : 1040;
            if constexpr ((PHMASK & 32) != 0) {
                bf16x8 wf[2][8];
                { const u16* PWT = (const u16*)(a.ws + WS_PWT) + (size_t)layer * 256 * 256; const int fr = lane & 15, fq = lane >> 4;
#pragma unroll
                  for (int nbi = 0; nbi < 2; ++nbi)
#pragma unroll
                    for (int ks = 0; ks < 8; ++ks) wf[nbi][ks] = *(const bf16x8*)(PWT + (size_t)((wave * 2 + nbi) * 16 + fr) * 256 + ks * 32 + fq * 8); }
                for (int rep = 0; rep < PROBE_CONV; ++rep) for (int u = bid; u < ncu; u += G) conv_unit(a, layer, u, lds, wf);
            }
        }
        if constexpr (sp == 6) {
            if constexpr ((PHMASK & 64) != 0) gla_scan(a, lds);
            if constexpr ((PHMASK & 128) != 0) for (int rep = 0; rep < PROBE_NA; ++rep) for (int wu = bid * 8 + wave; wu < 2 * 256 * 16; wu += G * 8) na_wave(a, layer, false, wu, lane);
            if constexpr ((PHMASK & 128) != 0 && !last) for (int wu = bid * 8 + wave; wu < 2 * 4 * 16; wu += G * 8) na_wave(a, layer, true, wu, lane);
            if constexpr ((PHMASK & 256) != 0) for (int rep = 0; rep < PROBE_DIFF; ++rep) for (int u = bid; u < 512; u += G) { const int b = u >> 8, h = (u >> 6) & 3, qb = u & 63; diff_unit(a, layer, b, h, b * SEQ + qb * 256, NCH, lds); }
            if constexpr ((PHMASK & 256) != 0 && !last) for (int u = bid; u < 8; u += G) { const int b = u >> 2, h = u & 3; diff_unit(a, layer, b, h, MX + b * CTXL, 4, lds); }
        }
        if constexpr (sp == 7) {
            __syncthreads();
            if constexpr ((PHMASK & 512) != 0) for (int rep = 0; rep < PROBE_G3; ++rep) for (int wu = bid * 8 + wave; wu < 2 * NCH * 4; wu += G * 8) { const int c = (wu >> 2) % NCH; if (last && c < 4) continue; gla_g3_wave(a, layer, wu, lds + wave * 16384, lane); }
        }
        if constexpr (sp == 8 && (PHMASK & 4)) {
            pg8::Gemm g{Abuf, (const u16*)(a.ws + WS_WOUT) + (size_t)layer * D * D, Mpost, D, D};
            pg8::StaticOrder S; S.init(Mpost, D, G, bid);
            EpiResid E{a.out, (float*)(a.ws + WS_HC), modp(a, layer, 0, 5), 1.0f};
            pg8::gemm_phase<EpiResid, pg8::StaticOrder, true, true>((LAS unsigned char*)lds, g, S, E);
        }
    }
}
template <int PHMASK, int PH> __device__ __forceinline__ void run_phase(int lo, int hi, unsigned char* lds, cg::grid_group& grid) {
    if (lo <= PH && PH < hi) { if (PH > lo) grid.sync(); phase_body<PHMASK, PH>(lds); }
}
template <int PHMASK> __device__ __forceinline__ void run_phases(const Args& a, unsigned char* lds) {
    cg::grid_group grid = cg::this_grid();
    const int lo = a.ph_lo, hi = a.ph_hi;
#define RP(k) run_phase<PHMASK, k>(lo, hi, lds, grid);
    RP(0) RP(1) RP(2) RP(3) RP(4) RP(5) RP(6) RP(7) RP(8) RP(9) RP(10) RP(11) RP(12) RP(13) RP(14) RP(15) RP(16) RP(17) RP(18) RP(19) RP(20) RP(21) RP(22) RP(23) RP(24) RP(25)
#undef RP
}
extern __shared__ __attribute__((aligned(16))) unsigned char dyn_lds[];
template <int PM> __global__ void __launch_bounds__(512, 2) part_fwd(Args a) { run_phases<PM>(a, dyn_lds); }
#ifndef MK_PER_PHASE
#define MK_PER_PHASE 0
#endif
#if !MK_PER_PHASE
__global__ void __launch_bounds__(512, 2) mega_fwd(Args a) { run_phases<0xFFFF>(a, dyn_lds); }
#define MAIN_KERNEL mega_fwd
#else
#define MAIN_KERNEL part_fwd<4>
#endif
#ifndef MK_PER_PHASE
#define MK_PER_PHASE 0
#endif
extern "C" void kernel_launch(void* const* d_in, const int* in_sizes, int n_in, void* d_out, int out_size, void* d_ws, size_t ws_size, hipStream_t stream) {
    static int grid = 0;
    if (grid == 0) {
        if (n_in != 33 || ws_size < WS_END) { fprintf(stderr, "kernel_launch: unexpected n_in %d / ws_size %zu (need %zu)\n", n_in, ws_size, (size_t)WS_END); grid = -1; return; }
        int dev = 0, cus = 0, per_cu = 0;
        hipGetDevice(&dev); hipDeviceGetAttribute(&cus, hipDeviceAttributeMultiprocessorCount, dev);
        if (hipFuncSetAttribute((const void*)MAIN_KERNEL, hipFuncAttributeMaxDynamicSharedMemorySize, LDS_BYTES) != hipSuccess) { fprintf(stderr, "kernel_launch: hipFuncSetAttribute failed\n"); grid = -1; return; }
#if MK_PER_PHASE
        (void)hipFuncSetAttribute((const void*)part_fwd<1>, hipFuncAttributeMaxDynamicSharedMemorySize, LDS_BYTES); (void)hipFuncSetAttribute((const void*)part_fwd<2>, hipFuncAttributeMaxDynamicSharedMemorySize, LDS_BYTES);
        (void)hipFuncSetAttribute((const void*)part_fwd<4>, hipFuncAttributeMaxDynamicSharedMemorySize, LDS_BYTES); (void)hipFuncSetAttribute((const void*)part_fwd<56>, hipFuncAttributeMaxDynamicSharedMemorySize, LDS_BYTES);
        (void)hipFuncSetAttribute((const void*)part_fwd<448>, hipFuncAttributeMaxDynamicSharedMemorySize, LDS_BYTES); (void)hipFuncSetAttribute((const void*)part_fwd<512>, hipFuncAttributeMaxDynamicSharedMemorySize, LDS_BYTES);
#endif
        if (hipOccupancyMaxActiveBlocksPerMultiprocessor(&per_cu, (const void*)MAIN_KERNEL, 512, LDS_BYTES) != hipSuccess || per_cu < 1) { fprintf(stderr, "kernel_launch: occupancy query says %d\n", per_cu); per_cu = 1; }
        (void)hipGetLastError();
        grid = cus;
    }
    if (grid < 0) return;
    hipMemsetAsync((char*)d_ws + WS_CTL, 0, 4096, stream);
    Args a{};
    for (int i = 0; i < 33; ++i) a.in[i] = (const float*)d_in[i];
    a.out = (float*)d_out; a.ws = (unsigned char*)d_ws;
#if MK_PER_PHASE
    for (int ph = 0; ph < NPHASE; ++ph) {
        a.ph_lo = ph; a.ph_hi = ph + 1;
        const int sp = (ph == 0 || ph == NPHASE - 1) ? -1 : (ph - 1) % 12;
        if (ph == 0) hipLaunchKernelGGL(part_fwd<1>, dim3(grid), dim3(512), LDS_BYTES, stream, a);
        else if (sp == -1 || sp == 0 || sp == 3 || sp == 9) hipLaunchKernelGGL(part_fwd<2>, dim3(grid), dim3(512), LDS_BYTES, stream, a);
        else if (sp == 5) hipLaunchKernelGGL(part_fwd<56>, dim3(grid), dim3(512), LDS_BYTES, stream, a);
        else if (sp == 6) hipLaunchKernelGGL(part_fwd<448>, dim3(grid), dim3(512), LDS_BYTES, stream, a);
        else if (sp == 7) hipLaunchKernelGGL(part_fwd<512>, dim3(grid), dim3(512), LDS_BYTES, stream, a);
        else hipLaunchKernelGGL(part_fwd<4>, dim3(grid), dim3(512), LDS_BYTES, stream, a);
    }
#else
    a.ph_lo = 0; a.ph_hi = NPHASE;
    void* args[] = {&a};
    hipError_t e = hipLaunchCooperativeKernel((const void*)mega_fwd, dim3(grid), dim3(512), args, LDS_BYTES, stream);
    if (e != hipSuccess) fprintf(stderr, "kernel_launch: cooperative launch failed: %s (grid %d)\n", hipGetErrorString(e), grid);
#endif
}
```

```cpp
#include <hip/hip_runtime.h>
#include <hip/hip_cooperative_groups.h>
#include <cstdio>
#include <cstdint>
namespace cg = cooperative_groups;
#define MK_PER_PHASE 0
namespace pg8 {
#define PG8_LAS __attribute__((address_space(3)))
typedef unsigned short bf16_t;
typedef short bf16x8 __attribute__((ext_vector_type(8)));
typedef float f32x4 __attribute__((ext_vector_type(4)));
typedef unsigned u32x4 __attribute__((ext_vector_type(4)));
constexpr int BM = 256, BK = 64, HALF = 128, HTB = HALF * BK * 2  , STAGE_BYTES = 8 * HTB, NXCD = 8, WGM = 8;

__host__ __device__ __forceinline__ int lds_byte(int r, int c) { const int st = (r >> 4) * 2 + (c >> 5), rr = r & 15, cc = c & 31, ob = rr * 64 + cc * 2; return st * 1024 + (ob ^ (((ob >> 9) & 1) << 5)); }
__host__ __device__ __forceinline__ void stage_rc(int b, int& R, int& C) { const int st = b / 1024, sb = b % 1024, swz = sb ^ (((sb >> 9) & 1) << 5); R = (st >> 1) * 16 + swz / 64; C = (st & 1) * 32 + (swz % 64) / 2; }
__host__ __device__ __forceinline__ int perm32(int rho) { const int n = rho >> 4, i = rho & 15; return 8 * (i >> 2) + 4 * n + (i & 3); }

struct Unit { int pm, pn; };
struct Gemm { const bf16_t* A; const bf16_t* Bt; int M, N, K; };

struct StaticOrder {
    int nM, nN, nwg, G, c;
    __host__ __device__ void init(int M, int N, int G_, int c_) { nM = M / BM; nN = N / BM; nwg = nM * nN; G = G_; c = c_; }
    __host__ __device__ bool next(int i, Unit& u) const {
        const long L = (long)i * G + c; if (L >= nwg) return false;
        int wgid = (int)L; { const int q = nwg / NXCD, r = nwg % NXCD, xcd = wgid % NXCD, off = wgid / NXCD; wgid = (xcd < r ? xcd * (q + 1) : r * (q + 1) + (xcd - r) * q) + off; }
        const int nig = WGM * nN, gid = wgid / nig, fm = gid * WGM, gsz = (nM - fm) < WGM ? (nM - fm) : WGM;
        u.pm = fm + ((wgid % nig) % gsz); u.pn = (wgid % nig) / gsz; return true;
    }
    __device__ __forceinline__ void a_ready(const Unit&) const {}
    __device__ __forceinline__ void done(const Unit&) const {}
};

__device__ __forceinline__ unsigned cvt_pk_bf16(float lo, float hi) { unsigned r; asm volatile("v_cvt_pk_bf16_f32 %0, %1, %2" : "=v"(r) : "v"(lo), "v"(hi)); return r; }
template <class Epi, class Sched, bool ALIGN_EPI = false, bool SP2 = false>
__device__ __forceinline__ void gemm_phase(PG8_LAS unsigned char* lds, const Gemm g, const Sched& S, const Epi& E) {
    int tid_l = threadIdx.x; asm volatile("" : "+v"(tid_l)); const int tid = tid_l, wid = __builtin_amdgcn_readfirstlane(tid >> 6), lane = tid & 63, wr = wid >> 2, wc = wid & 3, fr = lane & 15, fq = lane >> 4;
    const int K = g.K, nt = K / BK;
    unsigned voffA[2], voffB[2];
#pragma unroll
    for (int i = 0; i < 2; ++i) { int R, C; stage_rc(tid * 16 + i * 8192, R, C); const int Rb = Epi::PERM ? ((R & ~31) + perm32(R & 31)) : R;
        voffA[i] = (unsigned)(R * K + C) * 2u; voffB[i] = (unsigned)(Rb * K + C) * 2u; }
    const size_t kstep = (size_t)(BK * 2);
    const size_t hstep = (size_t)HALF * K * 2;
    const size_t tstep = 2 * hstep;
    const unsigned ldsw = (unsigned)wid * 1024u;
    const int aoff = lds_byte(wr * 64 + fr, fq * 8), boff = lds_byte(wc * 32 + fr, fq * 8);
#define PG8_SA(b, h) (((b) * 2 + (h)) * HTB)
#define PG8_SB(b, h) ((4 + (b) * 2 + (h)) * HTB)
#define PG8_STAGE(bufoff, gbase, voff) do { _Pragma("unroll") for (int _i = 0; _i < 2; ++_i) \
        __builtin_amdgcn_global_load_lds((const unsigned*)((const char*)(gbase) + (voff)[_i]), (PG8_LAS unsigned*)(lds + (bufoff) + ldsw + _i * 8192), 16, 0, 0); } while (0)
#define PG8_LDA(dst, b, h) do { _Pragma("unroll") for (int m = 0; m < 4; ++m) _Pragma("unroll") for (int k = 0; k < 2; ++k) dst[m][k] = *(const PG8_LAS bf16x8*)(lds + PG8_SA(b, h) + aoff + m * 2048 + k * 1024); } while (0)
#define PG8_LDB(dst, b, h) do { _Pragma("unroll") for (int n = 0; n < 2; ++n) _Pragma("unroll") for (int k = 0; k < 2; ++k) dst[n][k] = *(const PG8_LAS bf16x8*)(lds + PG8_SB(b, h) + boff + n * 2048 + k * 1024); } while (0)
#define PG8_MMA(ai, bj, At, Bt) do { __builtin_amdgcn_s_setprio(1); _Pragma("unroll") for (int m = 0; m < 4; ++m) _Pragma("unroll") for (int n = 0; n < 2; ++n) _Pragma("unroll") for (int k = 0; k < 2; ++k) \
        acc[ai][bj][m][n] = __builtin_amdgcn_mfma_f32_16x16x32_bf16(Bt[n][k], At[m][k], acc[ai][bj][m][n], 0, 0, 0); __builtin_amdgcn_s_setprio(0); } while (0)
#define PG8_WAIT_V(n) asm volatile("s_waitcnt vmcnt(" #n ")" ::: "memory")
#define PG8_WAIT_L(n) asm volatile("s_waitcnt lgkmcnt(" #n ")" ::: "memory")
#define PG8_BAR __builtin_amdgcn_s_barrier()
#define PG8_SCHED __builtin_amdgcn_sched_barrier(0)
    Unit cur, nxt; int ui = 0;
    if (!S.next(0, cur)) return;
    f32x4 acc[2][2][4][2];
#pragma unroll
    for (int a = 0; a < 2; ++a)
#pragma unroll
        for (int b = 0; b < 2; ++b)
#pragma unroll
            for (int m = 0; m < 4; ++m)
#pragma unroll
                for (int n = 0; n < 2; ++n) acc[a][b][m][n] = (f32x4){0.f, 0.f, 0.f, 0.f};
    bf16x8 At[4][2], B0[2][2], B1[2][2];
    const char* cA = (const char*)g.A + (size_t)cur.pm * tstep; const char* cB = (const char*)g.Bt + (size_t)cur.pn * tstep;
    S.a_ready(cur);
    if constexpr (SP2) {
        PG8_STAGE(PG8_SB(0, 0), cB, voffB); PG8_STAGE(PG8_SB(0, 1), cB + hstep, voffB); PG8_STAGE(PG8_SA(0, 0), cA, voffA); PG8_STAGE(PG8_SA(0, 1), cA + hstep, voffA);
        if (wr == 1) PG8_BAR;
        PG8_WAIT_V(2); PG8_BAR;
        PG8_STAGE(PG8_SB(1, 0), cB + kstep, voffB); PG8_STAGE(PG8_SA(1, 0), cA + kstep, voffA); PG8_STAGE(PG8_SB(1, 1), cB + hstep + kstep, voffB);
        PG8_WAIT_V(6); PG8_BAR;
    } else {
        PG8_STAGE(PG8_SB(0, 0), cB, voffB); PG8_STAGE(PG8_SA(0, 0), cA, voffA); PG8_STAGE(PG8_SB(0, 1), cB + hstep, voffB); PG8_STAGE(PG8_SA(0, 1), cA + hstep, voffA);
        if (wr == 1) PG8_BAR;
        PG8_WAIT_V(4); PG8_BAR;
        PG8_STAGE(PG8_SB(1, 0), cB + kstep, voffB); PG8_STAGE(PG8_SA(1, 0), cA + kstep, voffA); PG8_STAGE(PG8_SB(1, 1), cB + hstep + kstep, voffB);
        PG8_WAIT_V(6); PG8_BAR;
    }
    for (;;) {
        const bool has_next = S.next(ui + 1, nxt);
        const char* nA = has_next ? (const char*)g.A + (size_t)nxt.pm * tstep : cA; const char* nB = has_next ? (const char*)g.Bt + (size_t)nxt.pn * tstep : cB;
        for (int t = 0; t < nt; t += 2) {
            const bool last = (t == nt - 2);
            const char* a1 = cA + (size_t)(t + 1) * kstep;
            const char* a2 = last ? nA : cA + (size_t)(t + 2) * kstep; const char* b2 = last ? nB : cB + (size_t)(t + 2) * kstep;
            const char* a3 = a2 + kstep; const char* b3 = b2 + kstep;
            if (last && has_next) S.a_ready(nxt);
            if constexpr (SP2) {
            PG8_LDB(B0, 0, 0); PG8_LDB(B1, 0, 1); PG8_SCHED; PG8_LDA(At, 0, 0); PG8_STAGE(PG8_SA(1, 1), a1 + hstep, voffA);
            PG8_WAIT_V(8); PG8_WAIT_L(0); PG8_BAR; PG8_MMA(0, 0, At, B0); PG8_MMA(0, 1, At, B1); PG8_BAR; PG8_SCHED;
            PG8_LDA(At, 0, 1); PG8_STAGE(PG8_SB(0, 0), b2, voffB); PG8_STAGE(PG8_SB(0, 1), b2 + hstep, voffB); PG8_STAGE(PG8_SA(0, 0), a2, voffA);
            PG8_WAIT_V(8); PG8_WAIT_L(0); PG8_BAR; PG8_MMA(1, 0, At, B0); PG8_MMA(1, 1, At, B1); PG8_BAR; PG8_SCHED;
            PG8_LDB(B0, 1, 0); PG8_LDB(B1, 1, 1); PG8_SCHED; PG8_LDA(At, 1, 0); PG8_STAGE(PG8_SA(0, 1), a2 + hstep, voffA);
            PG8_WAIT_V(8); PG8_WAIT_L(0); PG8_BAR; PG8_MMA(0, 0, At, B0); PG8_MMA(0, 1, At, B1); PG8_BAR; PG8_SCHED;
            PG8_LDA(At, 1, 1); PG8_STAGE(PG8_SB(1, 0), b3, voffB); PG8_STAGE(PG8_SB(1, 1), b3 + hstep, voffB); PG8_STAGE(PG8_SA(1, 0), a3, voffA);
            PG8_WAIT_V(8); PG8_WAIT_L(0); PG8_BAR; PG8_MMA(1, 0, At, B0); PG8_MMA(1, 1, At, B1); PG8_BAR; PG8_SCHED;
            } else {
            PG8_LDB(B0, 0, 0); PG8_SCHED; PG8_LDA(At, 0, 0); PG8_STAGE(PG8_SA(1, 1), a1 + hstep, voffA);
            PG8_WAIT_L(8); PG8_BAR; PG8_WAIT_L(0); PG8_MMA(0, 0, At, B0); PG8_BAR; PG8_SCHED;
            PG8_LDB(B1, 0, 1); PG8_STAGE(PG8_SB(0, 0), b2, voffB);
            PG8_BAR; PG8_WAIT_L(0); PG8_MMA(0, 1, At, B1); PG8_BAR;
            PG8_LDA(At, 0, 1); PG8_STAGE(PG8_SA(0, 0), a2, voffA);
            PG8_BAR; PG8_WAIT_L(0); PG8_MMA(1, 0, At, B0); PG8_BAR; PG8_SCHED;
            PG8_STAGE(PG8_SB(0, 1), b2 + hstep, voffB);
            PG8_WAIT_V(6); PG8_BAR; PG8_MMA(1, 1, At, B1); PG8_BAR;
            PG8_LDB(B0, 1, 0); PG8_SCHED; PG8_LDA(At, 1, 0); PG8_STAGE(PG8_SA(0, 1), a2 + hstep, voffA);
            PG8_WAIT_L(8); PG8_BAR; PG8_WAIT_L(0); PG8_MMA(0, 0, At, B0); PG8_BAR; PG8_SCHED;
            PG8_LDB(B1, 1, 1); PG8_STAGE(PG8_SB(1, 0), b3, voffB);
            PG8_BAR; PG8_WAIT_L(0); PG8_MMA(0, 1, At, B1); PG8_BAR;
            PG8_LDA(At, 1, 1); PG8_STAGE(PG8_SA(1, 0), a3, voffA);
            PG8_BAR; PG8_WAIT_L(0); PG8_MMA(1, 0, At, B0); PG8_BAR; PG8_SCHED;
            PG8_STAGE(PG8_SB(1, 1), b3 + hstep, voffB);
            PG8_WAIT_V(6); PG8_BAR; PG8_MMA(1, 1, At, B1); PG8_BAR;
            }
        }
        if constexpr (ALIGN_EPI) { if (wr == 0) PG8_BAR; }
        if constexpr (!Epi::AFTER_DRAIN) { E(acc, cur, wr, wc, fr, fq); S.done(cur); }
        if (!has_next) break;
#pragma unroll
        for (int a = 0; a < 2; ++a)
#pragma unroll
            for (int b = 0; b < 2; ++b)
#pragma unroll
                for (int m = 0; m < 4; ++m)
#pragma unroll
                    for (int n = 0; n < 2; ++n) acc[a][b][m][n] = (f32x4){0.f, 0.f, 0.f, 0.f};
        cur = nxt; cA = nA; cB = nB; ++ui;
        if constexpr (ALIGN_EPI) { if (wr == 1) PG8_BAR; }
    }
    PG8_WAIT_V(0);
    if constexpr (!ALIGN_EPI) { if (wr == 0) PG8_BAR; }
    PG8_BAR;
    if constexpr (Epi::AFTER_DRAIN) { E.fused(acc, cur, wr, wc, fr, fq, lds, wid, lane); S.done(cur); }
#undef PG8_SA
#undef PG8_SB
#undef PG8_STAGE
#undef PG8_LDA
#undef PG8_LDB
#undef PG8_MMA
#undef PG8_WAIT_V
#undef PG8_WAIT_L
#undef PG8_BAR
#undef PG8_SCHED
}
}

#define LAS __attribute__((address_space(3)))
typedef unsigned short u16;
typedef unsigned char uchar;
typedef short bf16x8 __attribute__((ext_vector_type(8)));
typedef short s16x4 __attribute__((ext_vector_type(4)));
typedef float f32x4 __attribute__((ext_vector_type(4)));
typedef unsigned u32x4 __attribute__((ext_vector_type(4)));
typedef unsigned u32x2 __attribute__((ext_vector_type(2)));

constexpr int D = 1024, SEQ = 16384, CTXL = 256, DFF = 2816, DPROJ = 2848, NPROJ = 3072;
constexpr int MX = 2 * SEQ, MC = 2 * CTXL, MT = MX + MC;
constexpr int NKEY = CTXL + SEQ, NCH = NKEY / 64;
constexpr int C_GQ = 0, C_GK = 128, C_GV = 256, C_GG = 512, C_AF = 768, C_NQ = 800, C_NK = 1056, C_NV = 1312, C_DQ = 1568, C_DK = 1824, C_DV = 2080, C_CA = 2336, C_CG = 2592;
constexpr float LOG2E = 1.4426950408889634f;

constexpr size_t MiB = 1u << 20;
constexpr size_t WS_CTL = 0, WS_MOD = 1 * MiB, WS_MISC = 1 * MiB + 512 * 1024, WS_HC = 2 * MiB, WS_PWT = 4 * MiB, WS_W13 = 8 * MiB, WS_W2 = 52 * MiB, WS_WIN = 74 * MiB,
                 WS_WOUT = 86 * MiB, WS_A = 90 * MiB, WS_X = 155 * MiB, WS_VTD = 336 * MiB, WS_VTN = 353 * MiB, WS_U = 370 * MiB, WS_DEC = 403 * MiB, WS_BC = 404 * MiB, WS_END = 437 * MiB;
constexpr int LDS_BYTES = 131072;
constexpr int NPHASE = 26;

struct Args { const float* in[33]; float* out; unsigned char* ws; int ph_lo, ph_hi; };

enum { I_X = 0, I_C, I_CTX, I_CCTX, I_ADAW, I_ADAB, I_NF1, I_F1W13, I_F1W2, I_NMIX, I_WIN, I_WAF, I_BAF, I_WAB, I_BAB, I_GNORM, I_RPB, I_LQ1, I_LK1, I_LQ2, I_LK2, I_DNORM,
       I_CDW, I_CDWB, I_CLNG, I_CLNB, I_CPW, I_CPWB, I_WOUT, I_NF2, I_F2W13, I_F2W2, I_FNORM };

__device__ __forceinline__ float bf2f(unsigned short h) { return __uint_as_float(((unsigned)h) << 16); }
__device__ __forceinline__ unsigned short f2bf(float f) { unsigned u = __float_as_uint(f); return (unsigned short)((u + 0x7fffu + ((u >> 16) & 1u)) >> 16); }
__device__ __forceinline__ unsigned pk2(float lo, float hi) { return (unsigned)f2bf(lo) | ((unsigned)f2bf(hi) << 16); }
__device__ __forceinline__ float wave_sum(float v) {
#pragma unroll
    for (int o = 1; o < 64; o <<= 1) v += __shfl_xor(v, o);
    return v;
}
__device__ __forceinline__ float silu_f(float x) { return x * __builtin_amdgcn_rcpf(1.0f + __expf(-x)); }
#define WAVE_SYNC() do { asm volatile("s_waitcnt lgkmcnt(0)" ::: "memory"); __builtin_amdgcn_wave_barrier(); } while (0)
__device__ __forceinline__ int row_of(int b, int c, int tk) { return (c < 4) ? (MX + b * CTXL + c * 64 + tk) : (b * SEQ + (c - 4) * 64 + tk); }
__device__ __forceinline__ float* hrow(const Args& a, int row) { return (row < MX) ? (a.out + (size_t)row * D) : ((float*)(a.ws + WS_HC) + (size_t)(row - MX) * D); }
__device__ __forceinline__ const float* modp(const Args& a, int layer, int g, int j) { return (const float*)(a.ws + WS_MOD) + ((size_t)(layer * 3 + g) * 9 + j) * D; }

struct EpiSwiglu {
    static constexpr bool PERM = true, AFTER_DRAIN = false;
    u16* O;
    __device__ __forceinline__ void operator()(const f32x4 (&acc)[2][2][4][2], const pg8::Unit& u, int wr, int wc, int fr, int fq) const {
        const int row0 = u.pm * 256 + wr * 64 + fr, col0 = u.pn * 128 + wc * 32 + 8 * fq;
#pragma unroll
        for (int ai = 0; ai < 2; ++ai)
#pragma unroll
            for (int m = 0; m < 4; ++m) {
                u16* rowp = O + (size_t)(row0 + ai * 128 + m * 16) * DFF + col0;
                const f32x4 a0 = acc[ai][0][m][0], a1 = acc[ai][0][m][1], u0 = acc[ai][1][m][0], u1 = acc[ai][1][m][1];
                float h[8];
#pragma unroll
                for (int e = 0; e < 4; ++e) { h[e] = silu_f(a0[e]) * u0[e]; h[4 + e] = silu_f(a1[e]) * u1[e]; }
                u32x4 w; w.x = pg8::cvt_pk_bf16(h[0], h[1]); w.y = pg8::cvt_pk_bf16(h[2], h[3]); w.z = pg8::cvt_pk_bf16(h[4], h[5]); w.w = pg8::cvt_pk_bf16(h[6], h[7]);
                *(u32x4*)rowp = w;
            }
    }
};
struct EpiResid {
    static constexpr bool PERM = false, AFTER_DRAIN = false;
    float* hx; float* hc; const float* gate0;
    float coef;
    __device__ __forceinline__ void operator()(const f32x4 (&acc)[2][2][4][2], const pg8::Unit& u, int wr, int wc, int fr, int fq) const {
        const int g = u.pm < 64 ? 0 : (u.pm < 128 ? 1 : 2);
        float* base = (u.pm < 128) ? (hx + (size_t)u.pm * 256 * D) : (hc + (size_t)(u.pm - 128) * 256 * D);
        const int row0 = wr * 64 + fr, col0 = u.pn * 256 + wc * 32 + 4 * fq;
        const float* gate = gate0 + (size_t)g * 9 * D;
        f32x4 gv[2][2];
#pragma unroll
        for (int bj = 0; bj < 2; ++bj)
#pragma unroll
            for (int n = 0; n < 2; ++n) gv[bj][n] = *(const f32x4*)(gate + col0 + bj * 128 + n * 16) * coef;
#pragma unroll
        for (int ai = 0; ai < 2; ++ai)
#pragma unroll
            for (int m = 0; m < 4; ++m) {
                float* rowp = base + (size_t)(row0 + ai * 128 + m * 16) * D + col0;
#pragma unroll
                for (int bj = 0; bj < 2; ++bj)
#pragma unroll
                    for (int n = 0; n < 2; ++n) { f32x4* p = (f32x4*)(rowp + bj * 128 + n * 16); *p = *p + gv[bj][n] * acc[ai][bj][m][n]; }
            }
    }
};
struct EpiProj {
    static constexpr bool PERM = true, AFTER_DRAIN = false;
    u16* O;
    __device__ __forceinline__ void operator()(const f32x4 (&acc)[2][2][4][2], const pg8::Unit& u, int wr, int wc, int fr, int fq) const {
        const int row0 = u.pm * 256 + wr * 64 + fr, col0 = u.pn * 256 + wc * 32 + 8 * fq;
#pragma unroll
        for (int ai = 0; ai < 2; ++ai)
#pragma unroll
            for (int m = 0; m < 4; ++m) {
                u16* rowp = O + (size_t)(row0 + ai * 128 + m * 16) * DPROJ;
#pragma unroll
                for (int bj = 0; bj < 2; ++bj) {
                    const int col = col0 + bj * 128;
                    if (col < DPROJ) {
                        const f32x4 v0 = acc[ai][bj][m][0], v1 = acc[ai][bj][m][1];
                        u32x4 w; w.x = pg8::cvt_pk_bf16(v0[0], v0[1]); w.y = pg8::cvt_pk_bf16(v0[2], v0[3]); w.z = pg8::cvt_pk_bf16(v1[0], v1[1]); w.w = pg8::cvt_pk_bf16(v1[2], v1[3]);
                        *(u32x4*)(rowp + col) = w;
                    }
                }
            }
    }
};

__device__ __forceinline__ void transpose_item(const float* W, int N, u16* WT, int K, int k0, int n0, int drow0, float* scr, int lane) {
#pragma unroll 8
    for (int i = 0; i < 32; ++i) { const int kk = 2 * i + (lane >> 5); scr[kk * 33 + (lane & 31)] = W[(size_t)(k0 + kk) * N + n0 + (lane & 31)]; }
    WAVE_SYNC();
    const int c = lane & 7;
#pragma unroll
    for (int j = 0; j < 4; ++j) {
        const int n = (lane >> 3) + 8 * j; const float* s = scr + (8 * c) * 33 + n;
        u32x4 o; o.x = pk2(s[0 * 33], s[1 * 33]); o.y = pk2(s[2 * 33], s[3 * 33]); o.z = pk2(s[4 * 33], s[5 * 33]); o.w = pk2(s[6 * 33], s[7 * 33]);
        *(u32x4*)(WT + (size_t)(drow0 + n) * K + k0 + 8 * c) = o;
    }
    WAVE_SYNC();
}

__device__ __forceinline__ void phase_prep(const Args& a, uchar* lds) {
    int tid = threadIdx.x; asm volatile("" : "+v"(tid)); const int lane = tid & 63, wave = tid >> 6, G = gridDim.x, bid = blockIdx.x;
    {
        float* sc = (float*)lds;
        float* red = sc + 3 * D;
        float* mod = (float*)(a.ws + WS_MOD);
        for (int i = tid; i < 3 * D; i += 512) { const int g = i >> 10, k = i & 1023; const float v = (g < 2) ? a.in[I_C][g * D + k] : a.in[I_CCTX][k]; sc[i] = silu_f(v); }
        __syncthreads();
        for (int u = bid; u < 2 * 144; u += G) {
            const int l = u / 144, cgp = u % 144, kc = tid >> 6, col = tid & 63;
            const float* w = a.in[I_ADAW] + ((size_t)l * D + kc * 128) * 9216 + cgp * 64 + col;
            float a0 = 0.f, a1 = 0.f, a2 = 0.f;
#pragma unroll 8
            for (int kk = 0; kk < 128; ++kk) { const float wv = w[(size_t)kk * 9216]; const int k = kc * 128 + kk; a0 += sc[k] * wv; a1 += sc[D + k] * wv; a2 += sc[2 * D + k] * wv; }
            red[(kc * 3 + 0) * 64 + col] = a0; red[(kc * 3 + 1) * 64 + col] = a1; red[(kc * 3 + 2) * 64 + col] = a2;
            __syncthreads();
            if (tid < 192) {
                const int g = tid >> 6, cc = tid & 63; float s = a.in[I_ADAB][l * 9216 + cgp * 64 + cc];
#pragma unroll
                for (int k8 = 0; k8 < 8; ++k8) s += red[(k8 * 3 + g) * 64 + cc];
                mod[(size_t)(l * 3 + g) * 9216 + cgp * 64 + cc] = s;
            }
            __syncthreads();
        }
        __syncthreads();
    }
    if (bid == 0) {
        float* tr = (float*)(a.ws + WS_MISC);
        for (int i = tid; i < 2560; i += 512) {
            const int j = i & 7; const int pos = (i < 2048) ? (i >> 3) : ((i - 2048) >> 3);
            const double inv = ((j & 1) ? 0.31622776601683794 : 1.0) * ((j >> 1) == 0 ? 1.0 : ((j >> 1) == 1 ? 0.1 : ((j >> 1) == 2 ? 0.01 : 0.001))), ang = (double)pos * inv;
            float* dst = (i < 2048) ? (tr + (size_t)i * 2) : (tr + 4096 + (size_t)(i - 2048) * 2);
            dst[0] = (float)cos(ang); dst[1] = (float)sin(ang);
        }
    }
    if (bid == (1 % G) && wave < 2) {
        const float* rpb = a.in[I_RPB] + wave * 4 * 15 * 31; float m = 0.f;
        for (int i = lane; i < 4 * 15 * 31; i += 64) m = fmaxf(m, fabsf(rpb[i]));
#pragma unroll
        for (int o = 1; o < 64; o <<= 1) m = fmaxf(m, __shfl_xor(m, o));
        if (lane == 0) ((float*)(a.ws + WS_MISC))[8192 + wave] = m;
    }
    {
        const size_t gt = (size_t)bid * 512 + tid, GT = (size_t)G * 512;
        for (int l = 0; l < 2; ++l) { u32x4* z = (u32x4*)((u16*)(a.ws + WS_WIN) + ((size_t)l * NPROJ + DPROJ) * D);
            for (size_t i = gt; i < (size_t)(NPROJ - DPROJ) * D / 8; i += GT) z[i] = (u32x4){0u, 0u, 0u, 0u}; }
    }
    {
        float* scr = (float*)lds + wave * (64 * 33);
        const int gw = bid * 8 + wave, NGW = G * 8;
        constexpr int I13 = 16 * 176, I2 = 44 * 32, IIN = 16 * 89, IOUT = 16 * 32, IPW = 4 * 8;
        constexpr int NIT = 4 * I13 + 4 * I2 + 2 * IIN + 2 * IOUT + 2 * IPW;
        for (int it = gw; it < NIT; it += NGW) {
            int r = it;
            if (r < 4 * I13) { const int mi = r / I13; r -= mi * I13; const int l = mi >> 1, f = mi & 1, kb = r / 176, nb = r % 176, n0 = nb * 32;
                const int j = (n0 < DFF) ? n0 : n0 - DFF; const int drow0 = 256 * (j >> 7) + (j & 127) + ((n0 < DFF) ? 0 : 128);
                transpose_item(a.in[f ? I_F2W13 : I_F1W13] + (size_t)l * D * 2 * DFF, 2 * DFF, (u16*)(a.ws + WS_W13) + (size_t)mi * 2 * DFF * D, D, kb * 64, n0, drow0, scr, lane); continue; }
            r -= 4 * I13;
            if (r < 4 * I2) { const int mi = r / I2; r -= mi * I2; const int l = mi >> 1, f = mi & 1, kb = r / 32, nb = r % 32;
                transpose_item(a.in[f ? I_F2W2 : I_F1W2] + (size_t)l * DFF * D, D, (u16*)(a.ws + WS_W2) + (size_t)mi * D * DFF, DFF, kb * 64, nb * 32, nb * 32, scr, lane); continue; }
            r -= 4 * I2;
            if (r < 2 * IIN) { const int l = r / IIN; r -= l * IIN; const int kb = r / 89, nb = r % 89;
                transpose_item(a.in[I_WIN] + (size_t)l * D * DPROJ, DPROJ, (u16*)(a.ws + WS_WIN) + (size_t)l * NPROJ * D, D, kb * 64, nb * 32, nb * 32, scr, lane); continue; }
            r -= 2 * IIN;
            if (r < 2 * IOUT) { const int l = r / IOUT; r -= l * IOUT; const int kb = r / 32, nb = r % 32;
                transpose_item(a.in[I_WOUT] + (size_t)l * D * D, D, (u16*)(a.ws + WS_WOUT) + (size_t)l * D * D, D, kb * 64, nb * 32, nb * 32, scr, lane); continue; }
            r -= 2 * IOUT;
            { const int l = r / IPW; r -= l * IPW; const int kb = r / 8, nb = r % 8;
                transpose_item(a.in[I_CPW] + (size_t)l * 256 * 256, 256, (u16*)(a.ws + WS_PWT) + (size_t)l * 256 * 256, 256, kb * 64, nb * 32, nb * 32, scr, lane); }
        }
    }
}

__device__ __forceinline__ void phase_norm(const Args& a, int layer, int which, int M, bool first) {
    int tid = threadIdx.x; asm volatile("" : "+v"(tid)); const int lane = tid & 63, wave = tid >> 6;
    const float* nw = a.in[which == 0 ? I_NF1 : (which == 1 ? I_NMIX : I_NF2)] + (size_t)layer * D;
    u16* A = (u16*)(a.ws + WS_A);
    for (int row = blockIdx.x * 8 + wave; row < M; row += gridDim.x * 8) {
        const float* src = first ? ((row < MX) ? a.in[I_X] + (size_t)row * D : a.in[I_CTX] + (size_t)(row - MX) * D) : hrow(a, row);
        const int g = row < SEQ ? 0 : (row < MX ? 1 : 2);
        const float* sh = modp(a, layer, g, 3 * which), * scl = modp(a, layer, g, 3 * which + 1);
        f32x4 v[4]; float ss = 0.f;
#pragma unroll
        for (int j = 0; j < 4; ++j) { v[j] = ((const f32x4*)src)[lane + 64 * j]; ss += (v[j].x * v[j].x + v[j].y * v[j].y) + (v[j].z * v[j].z + v[j].w * v[j].w); }
        if (first) { f32x4* hd = (f32x4*)hrow(a, row);
#pragma unroll
            for (int j = 0; j < 4; ++j) hd[lane + 64 * j] = v[j]; }
        const float rstd = rsqrtf(wave_sum(ss) * (1.0f / D) + 1e-6f);
        u32x2* o = (u32x2*)(A + (size_t)row * D);
#pragma unroll
        for (int j = 0; j < 4; ++j) {
            const f32x4 w4 = ((const f32x4*)nw)[lane + 64 * j], s4 = ((const f32x4*)scl)[lane + 64 * j], b4 = ((const f32x4*)sh)[lane + 64 * j];
            const f32x4 y = (v[j] * rstd) * w4 * (s4 + 1.0f) + b4;
            u32x2 p; p.x = pk2(y.x, y.y); p.y = pk2(y.z, y.w); o[lane + 64 * j] = p;
        }
    }
}
__device__ __forceinline__ void phase_final(const Args& a) {
    int tid = threadIdx.x; asm volatile("" : "+v"(tid)); const int lane = tid & 63, wave = tid >> 6;
    const float* nw = a.in[I_FNORM];
    for (int row = blockIdx.x * 8 + wave; row < MX; row += gridDim.x * 8) {
        f32x4* p = (f32x4*)(a.out + (size_t)row * D);
        f32x4 v[4]; float ss = 0.f;
#pragma unroll
        for (int j = 0; j < 4; ++j) { v[j] = p[lane + 64 * j]; ss += (v[j].x * v[j].x + v[j].y * v[j].y) + (v[j].z * v[j].z + v[j].w * v[j].w); }
        const float rstd = rsqrtf(wave_sum(ss) * (1.0f / D) + 1e-6f);
#pragma unroll
        for (int j = 0; j < 4; ++j) p[lane + 64 * j] = (v[j] * rstd) * ((const f32x4*)nw)[lane + 64 * j];
    }
}

__device__ __forceinline__ void prep_unit(const Args& a, int layer, int unit, uchar* lds) {
    int tid = threadIdx.x; asm volatile("" : "+v"(tid)); const int b = unit / NCH, c = unit % NCH;
    u16* P = (u16*)(a.ws + WS_X);
    unsigned* ctl = (unsigned*)(a.ws + WS_CTL) + layer * 64;
    unsigned* lmax = (unsigned*)lds;
    u16* T = (u16*)(lds + 256);
    if (tid < 12) lmax[tid] = 0u;
    __syncthreads();
    const float* tr = (const float*)(a.ws + WS_MISC);
    {
        const int tk = tid >> 3, row = row_of(b, c, tk);
        const int t = (c - 4) * 64 + tk, gr = t >> 6, gc = t & 63;
#pragma unroll
        for (int e = 0; e < 2; ++e) {
            const int id = (tid & 7) * 2 + e, isk = id >> 3, h = (id >> 1) & 3, s = id & 1;
            u16* p = P + (size_t)row * DPROJ + C_DQ + isk * 256 + h * 64 + s * 32;
            bf16x8 raw[4];
#pragma unroll
            for (int q = 0; q < 4; ++q) raw[q] = ((const bf16x8*)p)[q];
            float x[32];
#pragma unroll
            for (int q = 0; q < 4; ++q)
#pragma unroll
                for (int i = 0; i < 8; ++i) x[q * 8 + i] = bf2f((u16)raw[q][i]);
            if (c >= 4) {
#pragma unroll
                for (int j = 0; j < 8; ++j) {
                    const float cr = tr[(gr * 8 + j) * 2], sr = tr[(gr * 8 + j) * 2 + 1], cc = tr[4096 + (gc * 8 + j) * 2], sc = tr[4096 + (gc * 8 + j) * 2 + 1];
                    const float x0 = x[j], x1 = x[j + 8], y0 = x[16 + j], y1 = x[24 + j];
                    x[j] = x0 * cr - x1 * sr; x[j + 8] = x1 * cr + x0 * sr;
                    x[16 + j] = y0 * cc - y1 * sc; x[24 + j] = y1 * cc + y0 * sc;
                }
                u32x4 o[4];
#pragma unroll
                for (int q = 0; q < 4; ++q) { o[q].x = pk2(x[q * 8], x[q * 8 + 1]); o[q].y = pk2(x[q * 8 + 2], x[q * 8 + 3]); o[q].z = pk2(x[q * 8 + 4], x[q * 8 + 5]); o[q].w = pk2(x[q * 8 + 6], x[q * 8 + 7]); }
#pragma unroll
                for (int q = 0; q < 4; ++q) ((u32x4*)p)[q] = o[q];
            }
            if (isk) {
                float n2 = 0.f;
#pragma unroll
                for (int i = 0; i < 32; ++i) { const float r = bf2f(f2bf(x[i])); n2 += r * r; }
                atomicMax(&lmax[h * 2 + s], __float_as_uint(n2));
            }
        }
    }
    {
        const int tk = tid >> 3, h = (tid & 7) >> 1, hf = tid & 1, row = row_of(b, c, tk);
        const u16* p = P + (size_t)row * DPROJ + C_NK + h * 64 + hf * 32;
        float n2 = 0.f;
#pragma unroll
        for (int q = 0; q < 4; ++q) { const bf16x8 r = ((const bf16x8*)p)[q];
#pragma unroll
            for (int i = 0; i < 8; ++i) { const float f = bf2f((u16)r[i]); n2 += f * f; } }
        n2 += __shfl_xor(n2, 1);
        if (hf == 0) atomicMax(&lmax[8 + h], __float_as_uint(n2));
    }
#pragma unroll 1
    for (int wh = 0; wh < 2; ++wh) {
        const int ccol = wh ? C_NV : C_DV;
        u16* VT = (u16*)(a.ws + (wh ? WS_VTN : WS_VTD));
        __syncthreads();
        for (int i = tid; i < 64 * 32; i += 512) { const int tk = i >> 5, pc = i & 31;
            *(bf16x8*)(T + tk * 264 + pc * 8) = *(const bf16x8*)(P + (size_t)row_of(b, c, tk) * DPROJ + ccol + pc * 8); }
        __syncthreads();
        {
            const int r = tid >> 1, hf = tid & 1, h = r >> 6, dv = r & 63;
            u16* dst = VT + ((size_t)(b * 4 + h) * 64 + dv) * NKEY + c * 64 + hf * 32;
#pragma unroll
            for (int q = 0; q < 4; ++q) {
                u32x4 o; unsigned w[4];
#pragma unroll
                for (int i = 0; i < 4; ++i) { const int t0 = hf * 32 + q * 8 + i * 2; w[i] = (unsigned)T[t0 * 264 + r] | ((unsigned)T[(t0 + 1) * 264 + r] << 16); }
                o.x = w[0]; o.y = w[1]; o.z = w[2]; o.w = w[3];
                ((u32x4*)dst)[q] = o;
            }
        }
    }
    __syncthreads();
    if (tid < 8) atomicMax(&ctl[(b * 4 + (tid >> 1)) * 2 + (tid & 1)], lmax[tid]);
    else if (tid < 12) atomicMax(&ctl[16 + b * 4 + (tid - 8)], lmax[tid]);
    __syncthreads();
}

__device__ __forceinline__ void gla_bcum(const Args& a, int layer, const u16* prow, int h, int dir, int lane, float (&bc)[32]) {
    const float* wa = a.in[dir ? I_WAB : I_WAF] + (size_t)layer * 16 * 128 + h * 32;
    const float* ba = a.in[dir ? I_BAB : I_BAF] + (size_t)layer * 128 + h * 32;
    const bf16x8 r0 = *(const bf16x8*)(prow + C_AF + dir * 16), r1 = *(const bf16x8*)(prow + C_AF + dir * 16 + 8);
    float av[16];
#pragma unroll
    for (int i = 0; i < 8; ++i) { av[i] = bf2f((u16)r0[i]); av[8 + i] = bf2f((u16)r1[i]); }
#pragma unroll
    for (int d = 0; d < 32; ++d) {
        float z = ba[d];
#pragma unroll
        for (int r = 0; r < 16; ++r) z += av[r] * wa[r * 128 + d];
        const float ls = fminf(z, 0.f) - __logf(1.0f + __expf(-fabsf(z)));
        bc[d] = ls * (1.0f / 16.0f);
        if ((d & 3) == 3) __builtin_amdgcn_sched_barrier(0);
    }
#pragma unroll
    for (int off = 1; off < 64; off <<= 1) {
#pragma unroll
        for (int d = 0; d < 32; ++d) {
            if (dir == 0) { const float t = __shfl_up(bc[d], off); if (lane >= off) bc[d] += t; }
            else { const float t = __shfl_down(bc[d], off); if (lane + off < 64) bc[d] += t; }
        }
    }
}
__device__ __forceinline__ int gla_scan_idx(int dir, int c) { return dir == 0 ? c : ((c < 4) ? 3 - c : 263 - c); }

__device__ __forceinline__ void gla_g1_wave(const Args& a, int layer, int b, int c, int h, int dir, uchar* wlds, int lane) {
    asm volatile("" : "+v"(lane));
    const int fr = lane & 15, fq = lane >> 4;
    const u16* P = (const u16*)(a.ws + WS_X);
    const u16* prow = P + (size_t)row_of(b, c, lane) * DPROJ;
    u16* VT = (u16*)wlds;
    u16* KT = (u16*)(wlds + 8192);
    float* U = (float*)(a.ws + WS_U); float* DEC = (float*)(a.ws + WS_DEC);
    {
        bf16x8 vr[8];
#pragma unroll
        for (int q = 0; q < 8; ++q) vr[q] = ((const bf16x8*)(prow + C_GV + h * 64))[q];
#pragma unroll
        for (int q = 0; q < 8; ++q)
#pragma unroll
            for (int i = 0; i < 8; ++i) VT[(q * 8 + i) * 64 + lane] = (u16)vr[q][i];
    }
    float bc[32];
    gla_bcum(a, layer, prow, h, dir, lane, bc);
    const int n = gla_scan_idx(dir, c);
    const size_t sidx = ((size_t)((b * 2 + dir) * 4 + h) * NCH + n);
    {
        f32x4* bcp = (f32x4*)((float*)(a.ws + WS_BC) + ((((size_t)((b * 2 + dir) * 4 + h) * NCH + c) * 64 + lane) * 32));
#pragma unroll
        for (int q = 0; q < 8; ++q) bcp[q] = (f32x4){bc[q * 4], bc[q * 4 + 1], bc[q * 4 + 2], bc[q * 4 + 3]};
    }
    {
        bf16x8 kr[4];
#pragma unroll
        for (int q = 0; q < 4; ++q) kr[q] = ((const bf16x8*)(prow + C_GK + h * 32))[q];
#pragma unroll
        for (int d = 0; d < 32; ++d) { const float bl = __shfl(bc[d], dir ? 0 : 63); KT[d * 64 + lane] = f2bf(bf2f((u16)kr[d >> 3][d & 7]) * __expf(bl - bc[d])); }
    }
    if (lane == (dir ? 0 : 63)) {
#pragma unroll
        for (int q = 0; q < 8; ++q) { f32x4 o;
#pragma unroll
            for (int e = 0; e < 4; ++e) o[e] = __expf(bc[q * 4 + e]);
            ((f32x4*)(DEC + sidx * 32))[q] = o; }
    }
    WAVE_SYNC();
    f32x4 acc[4][2];
#pragma unroll
    for (int dvb = 0; dvb < 4; ++dvb)
#pragma unroll
        for (int db = 0; db < 2; ++db) acc[dvb][db] = (f32x4){0.f, 0.f, 0.f, 0.f};
#pragma unroll
    for (int ks = 0; ks < 2; ++ks) {
        bf16x8 kf[2];
#pragma unroll
        for (int db = 0; db < 2; ++db) kf[db] = *(const bf16x8*)(KT + (db * 16 + fr) * 64 + ks * 32 + fq * 8);
#pragma unroll
        for (int dvb = 0; dvb < 4; ++dvb) {
            const bf16x8 vf = *(const bf16x8*)(VT + (dvb * 16 + fr) * 64 + ks * 32 + fq * 8);
#pragma unroll
            for (int db = 0; db < 2; ++db) acc[dvb][db] = __builtin_amdgcn_mfma_f32_16x16x32_bf16(vf, kf[db], acc[dvb][db], 0, 0, 0);
        }
    }
    float* ub = U + sidx * 2048;
#pragma unroll
    for (int dvb = 0; dvb < 4; ++dvb)
#pragma unroll
        for (int db = 0; db < 2; ++db) *(f32x4*)(ub + (db * 16 + fr) * 64 + dvb * 16 + fq * 4) = acc[dvb][db];
    WAVE_SYNC();
}
__device__ __forceinline__ void gla_scan(const Args& a, uchar* lds) {
    int tid = threadIdx.x; asm volatile("" : "+v"(tid));
    float* U = (float*)(a.ws + WS_U); const float* DEC = (const float*)(a.ws + WS_DEC);
    float* PL = (float*)lds;
    const int seg = tid >> 7, el = tid & 127;
    constexpr int SEGN = NCH / 4;
    for (int blk = blockIdx.x; blk < 16 * 16; blk += gridDim.x) {
        const int seq = blk >> 4, e = (blk & 15) * 128 + el, d = e >> 6;
        float* u = U + ((size_t)seq * NCH + seg * SEGN) * 2048 + e; const float* dc = DEC + ((size_t)seq * NCH + seg * SEGN) * 32 + d;
        float pr = 1.f, s = 0.f;
#pragma unroll 5
        for (int n = 0; n < SEGN; ++n) { const float un = u[(size_t)n * 2048], dn = dc[n * 32]; s = dn * s + un; pr *= dn; }
        __syncthreads();
        PL[(seg * 128 + el) * 2] = pr; PL[(seg * 128 + el) * 2 + 1] = s;
        __syncthreads();
        float s0 = 0.f;
        for (int k = 0; k < seg; ++k) s0 = PL[(k * 128 + el) * 2] * s0 + PL[(k * 128 + el) * 2 + 1];
        s = s0;
#pragma unroll 5
        for (int n = 0; n < SEGN; ++n) { const float un = u[(size_t)n * 2048], dn = dc[n * 32]; u[(size_t)n * 2048] = s; s = dn * s + un; }
    }
    __syncthreads();
}
__device__ __forceinline__ void gla_g3_wave(const Args& a, int layer, int wu, uchar* wlds, int lane) {
    asm volatile("" : "+v"(lane));
    const int h = __builtin_amdgcn_readfirstlane(wu & 3), bc_ = __builtin_amdgcn_readfirstlane(wu >> 2), b = bc_ / NCH, c = bc_ % NCH;
    const int fr = lane & 15, fq = lane >> 4;
    const u16* P = (const u16*)(a.ws + WS_X);
    const int row_l = row_of(b, c, lane);
    const u16* prow = P + (size_t)row_l * DPROJ;
    u16* R0 = (u16*)wlds;
    u16* ST = (u16*)(wlds + 4096);
    u16* VT = (u16*)(wlds + 8192);
    const float* U = (const float*)(a.ws + WS_U);
    {
        bf16x8 vr[8];
#pragma unroll
        for (int q = 0; q < 8; ++q) vr[q] = ((const bf16x8*)(prow + C_GV + h * 64))[q];
#pragma unroll
        for (int q = 0; q < 8; ++q)
#pragma unroll
            for (int i = 0; i < 8; ++i) VT[(q * 8 + i) * 64 + lane] = (u16)vr[q][i];
    }
    f32x4 O[4][4];
#pragma unroll
    for (int qb = 0; qb < 4; ++qb)
#pragma unroll
        for (int dvb = 0; dvb < 4; ++dvb) O[qb][dvb] = (f32x4){0.f, 0.f, 0.f, 0.f};
#pragma unroll 1
    for (int dir = 0; dir < 2; ++dir) {
        const int n = gla_scan_idx(dir, c);
        const float* sp = U + ((size_t)((b * 2 + dir) * 4 + h) * NCH + n) * 2048;
        u32x4 qpk[4], kpk[4];
        {
            const f32x4* bcp = (const f32x4*)((const float*)(a.ws + WS_BC) + ((((size_t)((b * 2 + dir) * 4 + h) * NCH + c) * 64 + lane) * 32));
#pragma unroll
            for (int q = 0; q < 4; ++q) {
                const bf16x8 qr = ((const bf16x8*)(prow + C_GQ + h * 32))[q], kr = ((const bf16x8*)(prow + C_GK + h * 32))[q];
                const f32x4 b0 = bcp[2 * q], b1 = bcp[2 * q + 1];
                float e[8];
#pragma unroll
                for (int i = 0; i < 4; ++i) { e[i] = __expf(b0[i]); e[4 + i] = __expf(b1[i]); }
                unsigned wq[4], wk[4];
#pragma unroll
                for (int i = 0; i < 4; ++i) {
                    wq[i] = pk2(bf2f((u16)qr[2 * i]) * 0.17677669529663687f * e[2 * i], bf2f((u16)qr[2 * i + 1]) * 0.17677669529663687f * e[2 * i + 1]);
                    wk[i] = pk2(bf2f((u16)kr[2 * i]) * __builtin_amdgcn_rcpf(e[2 * i]), bf2f((u16)kr[2 * i + 1]) * __builtin_amdgcn_rcpf(e[2 * i + 1]));
                }
                qpk[q] = (u32x4){wq[0], wq[1], wq[2], wq[3]}; kpk[q] = (u32x4){wk[0], wk[1], wk[2], wk[3]};
            }
        }
        WAVE_SYNC();
#pragma unroll
        for (int q = 0; q < 4; ++q) ((u32x4*)(R0 + lane * 32))[q] = qpk[q];
#pragma unroll
        for (int q = 0; q < 4; ++q) { u32x4 o; unsigned w[4];
#pragma unroll
            for (int i = 0; i < 4; ++i) { const int d = q * 8 + 2 * i; w[i] = pk2(sp[d * 64 + lane], sp[(d + 1) * 64 + lane]); }
            o.x = w[0]; o.y = w[1]; o.z = w[2]; o.w = w[3]; ((u32x4*)(ST + lane * 32))[q] = o; }
        WAVE_SYNC();
        bf16x8 qf[4];
#pragma unroll
        for (int qb = 0; qb < 4; ++qb) qf[qb] = *(const bf16x8*)(R0 + (qb * 16 + fr) * 32 + fq * 8);
        WAVE_SYNC();
#pragma unroll
        for (int q = 0; q < 4; ++q) ((u32x4*)(R0 + lane * 32))[q] = kpk[q];
        WAVE_SYNC();
#pragma unroll
        for (int dvb = 0; dvb < 4; ++dvb) {
            const bf16x8 sf = *(const bf16x8*)(ST + (dvb * 16 + fr) * 32 + fq * 8);
#pragma unroll
            for (int qb = 0; qb < 4; ++qb) O[qb][dvb] = __builtin_amdgcn_mfma_f32_16x16x32_bf16(sf, qf[qb], O[qb][dvb], 0, 0, 0);
        }
#pragma unroll
        for (int ip = 0; ip < 2; ++ip) {
            const bf16x8 kf0 = *(const bf16x8*)(R0 + ((2 * ip) * 16 + fr) * 32 + fq * 8), kf1 = *(const bf16x8*)(R0 + ((2 * ip + 1) * 16 + fr) * 32 + fq * 8);
            bf16x8 pf[4];
#pragma unroll
            for (int qb = 0; qb < 4; ++qb) {
                f32x4 a0 = (f32x4){0.f, 0.f, 0.f, 0.f}, a1 = a0;
                a0 = __builtin_amdgcn_mfma_f32_16x16x32_bf16(kf0, qf[qb], a0, 0, 0, 0);
                a1 = __builtin_amdgcn_mfma_f32_16x16x32_bf16(kf1, qf[qb], a1, 0, 0, 0);
                const int i = qb * 16 + fr;
                float p[8];
#pragma unroll
                for (int jj = 0; jj < 4; ++jj) {
                    const int j0 = (2 * ip) * 16 + fq * 4 + jj, j1 = j0 + 16;
                    p[jj] = (dir == 0 ? (j0 <= i) : (j0 >= i)) ? a0[jj] : 0.f;
                    p[4 + jj] = (dir == 0 ? (j1 <= i) : (j1 >= i)) ? a1[jj] : 0.f;
                }
                u32x4 w; w.x = pk2(p[0], p[1]); w.y = pk2(p[2], p[3]); w.z = pk2(p[4], p[5]); w.w = pk2(p[6], p[7]);
                pf[qb] = __builtin_bit_cast(bf16x8, w);
            }
#pragma unroll
            for (int dvb = 0; dvb < 4; ++dvb) {
                const u16* vp = VT + (dvb * 16 + fr) * 64 + (2 * ip) * 16 + fq * 4;
                const s16x4 lo = *(const s16x4*)vp, hi = *(const s16x4*)(vp + 16);
                const bf16x8 vf = __builtin_shufflevector(lo, hi, 0, 1, 2, 3, 4, 5, 6, 7);
#pragma unroll
                for (int qb = 0; qb < 4; ++qb) O[qb][dvb] = __builtin_amdgcn_mfma_f32_16x16x32_bf16(vf, pf[qb], O[qb][dvb], 0, 0, 0);
            }
        }
    }
    const float* gnw = a.in[I_GNORM] + layer * 64;
    u16* MIX = (u16*)(a.ws + WS_A);
#pragma unroll
    for (int qb = 0; qb < 4; ++qb) {
        float ss = 0.f;
#pragma unroll
        for (int dvb = 0; dvb < 4; ++dvb)
#pragma unroll
            for (int jj = 0; jj < 4; ++jj) ss += O[qb][dvb][jj] * O[qb][dvb][jj];
        ss += __shfl_xor(ss, 16); ss += __shfl_xor(ss, 32);
        const float r = rsqrtf(ss * (1.0f / 64.0f) + 1e-6f);
        const int row = row_of(b, c, qb * 16 + fr);
#pragma unroll
        for (int dvb = 0; dvb < 4; ++dvb) {
            const int v0 = dvb * 16 + fq * 4;
            const s16x4 g4 = *(const s16x4*)(P + (size_t)row * DPROJ + C_GG + h * 64 + v0);
            const f32x4 nw = *(const f32x4*)(gnw + v0);
            float o[4];
#pragma unroll
            for (int jj = 0; jj < 4; ++jj) o[jj] = O[qb][dvb][jj] * r * nw[jj] * silu_f(bf2f((u16)g4[jj]));
            u32x2 w; w.x = pk2(o[0], o[1]); w.y = pk2(o[2], o[3]);
            *(u32x2*)(MIX + (size_t)row * D + h * 64 + v0) = w;
        }
    }
    WAVE_SYNC();
}

__device__ __forceinline__ void conv_unit(const Args& a, int layer, int unit, uchar* lds, const bf16x8 (&wf)[2][8]) {
    int tid = threadIdx.x; asm volatile("" : "+v"(tid)); const int lane = tid & 63, wave = tid >> 6, fr = lane & 15, fq = lane >> 4;
    int t0, L, rowbase;
    if (unit < 1024) { const int b = unit >> 9; t0 = (unit & 511) * 32; L = SEQ; rowbase = b * SEQ; }
    else { const int uu = unit - 1024, b = uu >> 3; t0 = (uu & 7) * 32; L = CTXL; rowbase = MX + b * CTXL; }
    const u16* P = (const u16*)(a.ws + WS_X);
    float* Ub = (float*)lds;
    float* Y = (float*)(lds + 65536);
    u16* Z = (u16*)(lds + 98304);
    for (int i = tid; i < 62 * 64; i += 512) {
        const int p = i >> 6, c4 = (i & 63) * 4, t = t0 - 15 + p;
        f32x4 u = (f32x4){0.f, 0.f, 0.f, 0.f};
        if (t >= 0 && t < L) {
            const u16* pr = P + (size_t)(rowbase + t) * DPROJ;
            const s16x4 av = *(const s16x4*)(pr + C_CA + c4), gv = *(const s16x4*)(pr + C_CG + c4);
#pragma unroll
            for (int e = 0; e < 4; ++e) { const float g = bf2f((u16)gv[e]); u[e] = bf2f((u16)av[e]) / (1.0f + __expf(-g)); }
        }
        *(f32x4*)(Ub + p * 256 + c4) = u;
    }
    __syncthreads();
    {
        const int c = tid & 255, th = tid >> 8;
        const float* dw = a.in[I_CDW] + (size_t)layer * 31 * 256 + c;
        float w[31];
#pragma unroll
        for (int k = 0; k < 31; ++k) w[k] = dw[k * 256];
        const float bias = a.in[I_CDWB][layer * 256 + c];
        float uw[46];
#pragma unroll
        for (int i = 0; i < 46; ++i) uw[i] = Ub[(th * 16 + i) * 256 + c];
#pragma unroll
        for (int tt = 0; tt < 16; ++tt) {
            float acc = bias;
#pragma unroll
            for (int k = 0; k < 31; ++k) acc += w[k] * uw[tt + k];
            Y[(th * 16 + tt) * 256 + c] = acc;
        }
    }
    __syncthreads();
    {
        const f32x4 g4 = *(const f32x4*)(a.in[I_CLNG] + layer * 256 + lane * 4), b4 = *(const f32x4*)(a.in[I_CLNB] + layer * 256 + lane * 4);
#pragma unroll
        for (int q = 0; q < 4; ++q) {
            const int t = wave * 4 + q;
            const f32x4 v = *(const f32x4*)(Y + t * 256 + lane * 4);
            const float mu = wave_sum((v.x + v.y) + (v.z + v.w)) * (1.0f / 256.0f);
            const f32x4 dlt = v - mu;
            const float var = wave_sum((dlt.x * dlt.x + dlt.y * dlt.y) + (dlt.z * dlt.z + dlt.w * dlt.w)) * (1.0f / 256.0f);
            const float rs = rsqrtf(var + 1e-5f);
            float z[4];
#pragma unroll
            for (int e = 0; e < 4; ++e) z[e] = silu_f(dlt[e] * rs * g4[e] + b4[e]);
            u32x2 w; w.x = pk2(z[0], z[1]); w.y = pk2(z[2], z[3]);
            *(u32x2*)(Z + t * 264 + lane * 4) = w;
        }
    }
    __syncthreads();
    {
        f32x4 acc[2][2];
#pragma unroll
        for (int i = 0; i < 2; ++i)
#pragma unroll
            for (int j = 0; j < 2; ++j) acc[i][j] = (f32x4){0.f, 0.f, 0.f, 0.f};
#pragma unroll
        for (int ks = 0; ks < 8; ++ks) {
            bf16x8 zf[2];
#pragma unroll
            for (int tb = 0; tb < 2; ++tb) zf[tb] = *(const bf16x8*)(Z + (tb * 16 + fr) * 264 + ks * 32 + fq * 8);
#pragma unroll
            for (int nbi = 0; nbi < 2; ++nbi)
#pragma unroll
                for (int tb = 0; tb < 2; ++tb) acc[nbi][tb] = __builtin_amdgcn_mfma_f32_16x16x32_bf16(wf[nbi][ks], zf[tb], acc[nbi][tb], 0, 0, 0);
        }
        u16* MIX = (u16*)(a.ws + WS_A);
#pragma unroll
        for (int nbi = 0; nbi < 2; ++nbi) {
            const int n0 = (wave * 2 + nbi) * 16 + fq * 4;
            const f32x4 pb = *(const f32x4*)(a.in[I_CPWB] + layer * 256 + n0);
#pragma unroll
            for (int tb = 0; tb < 2; ++tb) {
                const int row = rowbase + t0 + tb * 16 + fr;
                u32x2 w; w.x = pk2(acc[nbi][tb][0] + pb[0], acc[nbi][tb][1] + pb[1]); w.y = pk2(acc[nbi][tb][2] + pb[2], acc[nbi][tb][3] + pb[3]);
                *(u32x2*)(MIX + (size_t)row * D + 768 + n0) = w;
            }
        }
    }
    __syncthreads();
}

typedef float f32x2_t __attribute__((ext_vector_type(2)));
typedef __bf16 bf16x2_t __attribute__((ext_vector_type(2)));
__device__ __forceinline__ unsigned cvtpk_s(float lo, float hi) { f32x2_t v = {lo, hi}; bf16x2_t b = __builtin_convertvector(v, bf16x2_t); return __builtin_bit_cast(unsigned, b); }
__device__ __forceinline__ bf16x8 pack8(const f32x4& p0, const f32x4& p1) {
    u32x4 w; w.x = cvtpk_s(p0[0], p0[1]); w.y = cvtpk_s(p0[2], p0[3]); w.z = cvtpk_s(p1[0], p1[1]); w.w = cvtpk_s(p1[2], p1[3]);
    return __builtin_bit_cast(bf16x8, w);
}
__device__ __forceinline__ bf16x8 load_scaled8(const u16* p, float sc, float& n2) {
    const bf16x8 raw = *(const bf16x8*)p; bf16x8 o;
#pragma unroll
    for (int i = 0; i < 8; ++i) { const u16 r = f2bf(bf2f((u16)raw[i]) * sc); const float f = bf2f(r); n2 += f * f; o[i] = (short)r; }
    return o;
}

__device__ __forceinline__ void diff_unit(const Args& a, int layer, int b, int h, int q0row, int ntiles, uchar* lds) {
    int tid = threadIdx.x; asm volatile("" : "+v"(tid)); const int lane = tid & 63, wave = tid >> 6, fr = lane & 15, fq = lane >> 4;
    const u16* P = (const u16*)(a.ws + WS_X);
    const u16* VTD = (const u16*)(a.ws + WS_VTD) + (size_t)(b * 4 + h) * 64 * NKEY;
    const unsigned* ctl = (const unsigned*)(a.ws + WS_CTL) + layer * 64;
    u16* Ks = (u16*)lds;
    u16* Vs = (u16*)(lds + 2 * 64 * 64 * 2);
    const float C2 = 0.17677669529663687f * LOG2E;
    bf16x8 qf[2][2]; float negb[2][2];
#pragma unroll
    for (int qb = 0; qb < 2; ++qb)
#pragma unroll
        for (int s = 0; s < 2; ++s) {
            const int row = q0row + wave * 32 + qb * 16 + fr; float n2 = 0.f;
            qf[qb][s] = load_scaled8(P + (size_t)row * DPROJ + C_DQ + h * 64 + s * 32 + fq * 8, C2, n2);
            n2 += __shfl_xor(n2, 16); n2 += __shfl_xor(n2, 32);
            const float km = __uint_as_float(ctl[(b * 4 + h) * 2 + s]);
            negb[qb][s] = -sqrtf(n2 * km);
        }
    f32x4 O[2][2][4], Ls[2][2];
    const bf16x8 ones = (bf16x8){(short)0x3F80, (short)0x3F80, (short)0x3F80, (short)0x3F80, (short)0x3F80, (short)0x3F80, (short)0x3F80, (short)0x3F80};
#pragma unroll
    for (int qb = 0; qb < 2; ++qb)
#pragma unroll
        for (int s = 0; s < 2; ++s) { Ls[qb][s] = (f32x4){0.f, 0.f, 0.f, 0.f};
#pragma unroll
            for (int dvb = 0; dvb < 4; ++dvb) O[qb][s][dvb] = (f32x4){0.f, 0.f, 0.f, 0.f}; }
    const int sr = tid >> 3, pc = tid & 7;
    auto kaddr = [&](int t) -> const u16* { const int krow = (t < 4) ? (MX + b * CTXL + t * 64 + sr) : (b * SEQ + (t - 4) * 64 + sr); return P + (size_t)krow * DPROJ + C_DK + h * 64 + pc * 8; };
    auto vaddr = [&](int t) -> const u16* { return VTD + (size_t)sr * NKEY + t * 64 + pc * 8; };
    auto compute_tile = [&](const u16* Kb, const u16* Vb) {
        f32x4 S0[2][2], S1[2][2];
        bf16x8 pfr[2][2];
        bf16x8 vfr[4];
#define DIFF_QK(g) do { const int i_ = (g) >> 1, s_ = (g) & 1; \
            const bf16x8 kf0 = *(const bf16x8*)(Kb + ((2 * i_) * 16 + fr) * 64 + (((s_ * 4 + fq) ^ (fr >> 1)) * 8)), kf1 = *(const bf16x8*)(Kb + ((2 * i_ + 1) * 16 + fr) * 64 + (((s_ * 4 + fq) ^ (fr >> 1)) * 8)); \
            _Pragma("unroll") for (int qb = 0; qb < 2; ++qb) { const float nb = negb[qb][s_]; const f32x4 c0 = (f32x4){nb, nb, nb, nb}; \
                S0[(g) & 1][qb] = __builtin_amdgcn_mfma_f32_16x16x32_bf16(kf0, qf[qb][s_], c0, 0, 0, 0); \
                S1[(g) & 1][qb] = __builtin_amdgcn_mfma_f32_16x16x32_bf16(kf1, qf[qb][s_], c0, 0, 0, 0); } } while (0)
#define DIFF_EXP(g) do { _Pragma("unroll") for (int qb = 0; qb < 2; ++qb) { f32x4 e0, e1; \
                _Pragma("unroll") for (int j = 0; j < 4; ++j) { e0[j] = __builtin_amdgcn_exp2f(S0[(g) & 1][qb][j]); e1[j] = __builtin_amdgcn_exp2f(S1[(g) & 1][qb][j]); } \
                pfr[(g) & 1][qb] = pack8(e0, e1); } } while (0)
#define DIFF_VLOAD(i_) do { _Pragma("unroll") for (int dvb = 0; dvb < 4; ++dvb) { const u16* vp = Vb + (dvb * 16 + fr) * 72 + (2 * (i_)) * 16 + fq * 4; \
                const s16x4 lo = *(const s16x4*)vp, hi = *(const s16x4*)(vp + 16); vfr[dvb] = __builtin_shufflevector(lo, hi, 0, 1, 2, 3, 4, 5, 6, 7); } } while (0)
#define DIFF_PV(g) do { const int s_ = (g) & 1; \
            _Pragma("unroll") for (int qb = 0; qb < 2; ++qb) Ls[qb][s_] = __builtin_amdgcn_mfma_f32_16x16x32_bf16(ones, pfr[(g) & 1][qb], Ls[qb][s_], 0, 0, 0); \
            _Pragma("unroll") for (int dvb = 0; dvb < 4; ++dvb) _Pragma("unroll") for (int qb = 0; qb < 2; ++qb) \
                O[qb][s_][dvb] = __builtin_amdgcn_mfma_f32_16x16x32_bf16(vfr[dvb], pfr[(g) & 1][qb], O[qb][s_][dvb], 0, 0, 0); } while (0)
        DIFF_QK(0); DIFF_VLOAD(0);
        DIFF_QK(1); DIFF_EXP(0);
        DIFF_QK(2); DIFF_EXP(1); DIFF_PV(0);
        DIFF_QK(3); DIFF_EXP(2); DIFF_PV(1); DIFF_VLOAD(1);
        DIFF_EXP(3); DIFF_PV(2);
        DIFF_PV(3);
#undef DIFF_QK
#undef DIFF_EXP
#undef DIFF_VLOAD
#undef DIFF_PV
    };
    bf16x8 kA = *(const bf16x8*)kaddr(0), vA = *(const bf16x8*)vaddr(0), kB = *(const bf16x8*)kaddr(1), vB = *(const bf16x8*)vaddr(1);
    __syncthreads();
#pragma unroll 1
    for (int t = 0; t < ntiles; t += 2) {
        *(bf16x8*)(Ks + sr * 64 + ((pc ^ ((sr >> 1) & 7)) * 8)) = kA; *(bf16x8*)(Vs + sr * 72 + pc * 8) = vA;
        __syncthreads();
        if (t + 2 < ntiles) { kA = *(const bf16x8*)kaddr(t + 2); vA = *(const bf16x8*)vaddr(t + 2); }
        compute_tile(Ks, Vs);
        *(bf16x8*)(Ks + 64 * 64 + sr * 64 + ((pc ^ ((sr >> 1) & 7)) * 8)) = kB; *(bf16x8*)(Vs + 64 * 72 + sr * 72 + pc * 8) = vB;
        __syncthreads();
        if (t + 3 < ntiles) { kB = *(const bf16x8*)kaddr(t + 3); vB = *(const bf16x8*)vaddr(t + 3); }
        compute_tile(Ks + 64 * 64, Vs + 64 * 72);
    }
    const float lam_init = (layer == 0) ? 0.2f : (0.8f - 0.6f * 0.7408182206817179f);
    float d1 = 0.f, d2 = 0.f;
    if (lane < 32) { d1 = a.in[I_LQ1][layer * 32 + lane] * a.in[I_LK1][layer * 32 + lane]; d2 = a.in[I_LQ2][layer * 32 + lane] * a.in[I_LK2][layer * 32 + lane]; }
    const float lam = expf(wave_sum(d1)) - expf(wave_sum(d2)) + lam_init;
    const float* dnw = a.in[I_DNORM] + layer * 64;
    u16* MIX = (u16*)(a.ws + WS_A);
#pragma unroll
    for (int qb = 0; qb < 2; ++qb) {
        const float l1 = Ls[qb][0][0], l2 = Ls[qb][1][0];
        const float i1 = 1.0f / l1, i2 = lam / l2;
        f32x4 o[4]; float ss = 0.f;
#pragma unroll
        for (int dvb = 0; dvb < 4; ++dvb) { o[dvb] = O[qb][0][dvb] * i1 - O[qb][1][dvb] * i2; ss += (o[dvb][0] * o[dvb][0] + o[dvb][1] * o[dvb][1]) + (o[dvb][2] * o[dvb][2] + o[dvb][3] * o[dvb][3]); }
        ss += __shfl_xor(ss, 16); ss += __shfl_xor(ss, 32);
        const float r = rsqrtf(ss * (1.0f / 64.0f) + 1e-6f) * (1.0f - lam_init);
        const int row = q0row + wave * 32 + qb * 16 + fr;
#pragma unroll
        for (int dvb = 0; dvb < 4; ++dvb) {
            const int v0 = dvb * 16 + fq * 4; const f32x4 nw = *(const f32x4*)(dnw + v0);
            u32x2 w; w.x = pk2(o[dvb][0] * r * nw[0], o[dvb][1] * r * nw[1]); w.y = pk2(o[dvb][2] * r * nw[2], o[dvb][3] * r * nw[3]);
            *(u32x2*)(MIX + (size_t)row * D + 512 + h * 64 + v0) = w;
        }
    }
}

__device__ __forceinline__ void na_wave(const Args& a, int layer, bool ctxq, int wu, int lane) {
    asm volatile("" : "+v"(lane));
    const int fr = lane & 15, fq = lane >> 4;
    const u16* P = (const u16*)(a.ws + WS_X);
    int b, h, r, qblk, qrow;
    if (!ctxq) { qblk = wu & 3; h = (wu >> 2) & 3; r = (wu >> 4) & 255; b = wu >> 12; qrow = b * SEQ + r * 64 + qblk * 16 + fr; }
    else { qblk = wu & 15; h = (wu >> 4) & 3; b = wu >> 6; r = 0; qrow = MX + b * CTXL + qblk * 16 + fr; }
    const int c = qblk * 16 + fr;
    const u16* VTN = (const u16*)(a.ws + WS_VTN) + (size_t)(b * 4 + h) * 64 * NKEY;
    const float C2 = 0.125f * LOG2E;
    bf16x8 qf[2]; float n2 = 0.f;
#pragma unroll
    for (int ks = 0; ks < 2; ++ks) qf[ks] = load_scaled8(P + (size_t)qrow * DPROJ + C_NQ + h * 64 + ks * 32 + fq * 8, C2, n2);
    n2 += __shfl_xor(n2, 16); n2 += __shfl_xor(n2, 32);
    const float km = __uint_as_float(((const unsigned*)(a.ws + WS_CTL))[layer * 64 + 16 + b * 4 + h]);
    const float bmax = ((const float*)(a.ws + WS_MISC))[8192 + layer];
    const float negb = -(sqrtf(n2 * km) + bmax * LOG2E);
    const float* rpb = a.in[I_RPB] + (size_t)(layer * 4 + h) * 15 * 31;
    const int rs = min(max(r - 4, 0), 248), cs = min(max(c - 8, 0), 48);
    f32x4 O[4]; float ls = 0.f;
#pragma unroll
    for (int dvb = 0; dvb < 4; ++dvb) O[dvb] = (f32x4){0.f, 0.f, 0.f, 0.f};
    const int nwh = (qblk == 0 || qblk == 3) ? 1 : 2, nwin = ctxq ? 0 : 8 * nwh, nsteps = nwin + 8;
    struct NaStep { bf16x8 kf[2][2]; s16x4 vlo[4], vhi[4]; float iv[2][4]; };
    auto load_step = [&](int st, NaStep& S) {
        int t, i; bool win;
        if (st < nwin) { win = true; if (nwh == 2) { t = st >> 1; i = st & 1; } else { t = st; i = (qblk == 3) ? 1 : 0; } }
        else { win = false; const int s2 = st - nwin; t = s2 >> 1; i = s2 & 1; }
        const int kr = rs + t;
        const int krow0 = win ? (b * SEQ + kr * 64) : (MX + b * CTXL + t * 64);
        const int key0 = win ? (CTXL + kr * 64) : (t * 64);
#pragma unroll
        for (int kbb = 0; kbb < 2; ++kbb) {
            const int kb = 2 * i + kbb;
#pragma unroll
            for (int ks = 0; ks < 2; ++ks) S.kf[kbb][ks] = *(const bf16x8*)(P + (size_t)(krow0 + kb * 16 + fr) * DPROJ + C_NK + h * 64 + ks * 32 + fq * 8);
#pragma unroll
            for (int j = 0; j < 4; ++j) {
                float iv = negb;
                if (win) { const int kc = kb * 16 + fq * 4 + j; const bool inw = (kc >= cs) && (kc < cs + 16);
                    const int co = min(max(kc - c + 15, 0), 30);
                    const float bias = rpb[(kr - r + 7) * 31 + co];
                    iv = inw ? (bias * LOG2E + negb) : -1e30f; }
                S.iv[kbb][j] = iv;
            }
        }
#pragma unroll
        for (int dvb = 0; dvb < 4; ++dvb) {
            const u16* vp = VTN + (size_t)(dvb * 16 + fr) * NKEY + key0 + (2 * i) * 16 + fq * 4;
            S.vlo[dvb] = *(const s16x4*)vp; S.vhi[dvb] = *(const s16x4*)(vp + 16);
        }
    };
    auto compute_step = [&](const NaStep& S) {
        f32x4 acc[2];
#pragma unroll
        for (int kbb = 0; kbb < 2; ++kbb) {
            acc[kbb] = (f32x4){S.iv[kbb][0], S.iv[kbb][1], S.iv[kbb][2], S.iv[kbb][3]};
#pragma unroll
            for (int ks = 0; ks < 2; ++ks) acc[kbb] = __builtin_amdgcn_mfma_f32_16x16x32_bf16(S.kf[kbb][ks], qf[ks], acc[kbb], 0, 0, 0);
#pragma unroll
            for (int j = 0; j < 4; ++j) acc[kbb][j] = __builtin_amdgcn_exp2f(acc[kbb][j]);
            ls += (acc[kbb][0] + acc[kbb][1]) + (acc[kbb][2] + acc[kbb][3]);
        }
        const bf16x8 pf = pack8(acc[0], acc[1]);
#pragma unroll
        for (int dvb = 0; dvb < 4; ++dvb) {
            const bf16x8 vf = __builtin_shufflevector(S.vlo[dvb], S.vhi[dvb], 0, 1, 2, 3, 4, 5, 6, 7);
            O[dvb] = __builtin_amdgcn_mfma_f32_16x16x32_bf16(vf, pf, O[dvb], 0, 0, 0);
        }
    };
    {
        NaStep SA, SB;
        load_step(0, SA);
#pragma unroll 1
        for (int st = 0; st < nsteps; st += 2) {
            load_step(st + 1, SB);
            compute_step(SA);
            if (st + 2 < nsteps) load_step(st + 2, SA);
            compute_step(SB);
        }
    }
    ls += __shfl_xor(ls, 16); ls += __shfl_xor(ls, 32);
    const float il = 1.0f / ls;
    u16* MIX = (u16*)(a.ws + WS_A);
#pragma unroll
    for (int dvb = 0; dvb < 4; ++dvb) {
        u32x2 w; w.x = pk2(O[dvb][0] * il, O[dvb][1] * il); w.y = pk2(O[dvb][2] * il, O[dvb][3] * il);
        *(u32x2*)(MIX + (size_t)qrow * D + 256 + h * 64 + dvb * 16 + fq * 4) = w;
    }
}


template <int QH> __device__ __forceinline__ void na_unit(const Args& a, int layer, int b, int h, int g, uchar* lds) {
    int tid = threadIdx.x; asm volatile("" : "+v"(tid)); const int lane = tid & 63, wave = __builtin_amdgcn_readfirstlane(tid >> 6), fr = lane & 15, fq = lane >> 4;
    const u16* P = (const u16*)(a.ws + WS_X);
    const u16* VTN = (const u16*)(a.ws + WS_VTN) + (size_t)(b * 4 + h) * 64 * NKEY;
    u16* Ks = (u16*)lds;
    u16* Vs = (u16*)(lds + 2 * 64 * 64 * 2);
    const int r = 8 * g + wave, rsw = min(max(r - 4, 0), 248);
    const float C2 = 0.125f * LOG2E;
    const float km = __uint_as_float(((const unsigned*)(a.ws + WS_CTL))[layer * 64 + 16 + b * 4 + h]);
    const float bmax = ((const float*)(a.ws + WS_MISC))[8192 + layer];
    const float* rpb = a.in[I_RPB] + (size_t)(layer * 4 + h) * 15 * 31;
    bf16x8 qf[2][2]; float negb[2], ls[2];
    unsigned mlo = 0u;
#pragma unroll
    for (int qq = 0; qq < 2; ++qq) {
        const int qblk = 2 * QH + qq;
        const int qrow = b * SEQ + r * 64 + qblk * 16 + fr; float n2 = 0.f;
#pragma unroll
        for (int ks = 0; ks < 2; ++ks) qf[qq][ks] = load_scaled8(P + (size_t)qrow * DPROJ + C_NQ + h * 64 + ks * 32 + fq * 8, C2, n2);
        n2 += __shfl_xor(n2, 16); n2 += __shfl_xor(n2, 32);
        negb[qq] = -(sqrtf(n2 * km) + bmax * LOG2E); ls[qq] = 0.f;
        const int c = qblk * 16 + fr, cs = min(max(c - 8, 0), 48);
#pragma unroll
        for (int kb = 0; kb < 4; ++kb)
#pragma unroll
            for (int j = 0; j < 4; ++j) { const int kc = kb * 16 + fq * 4 + j; const unsigned bit = (kc >= cs && kc < cs + 16) ? 1u : 0u; const int idx = (qq * 4 + kb) * 4 + j;
                mlo |= bit << idx; }
    }
    f32x4 O[2][4];
#pragma unroll
    for (int qq = 0; qq < 2; ++qq)
#pragma unroll
        for (int dvb = 0; dvb < 4; ++dvb) O[qq][dvb] = (f32x4){0.f, 0.f, 0.f, 0.f};
    const int lo = min(max(8 * g - 4, 0), 248), hi = min(max(8 * g + 3, 0), 248) + 7, nwin = hi - lo + 1, ntiles = nwin + 4;
    const int sr = tid >> 3, pc = tid & 7;
    auto kaddr = [&](int t) -> const u16* { const int krow = (t < nwin) ? (b * SEQ + (lo + t) * 64 + sr) : (MX + b * CTXL + (t - nwin) * 64 + sr); return P + (size_t)krow * DPROJ + C_NK + h * 64 + pc * 8; };
    auto vaddr = [&](int t) -> const u16* { const int key0 = (t < nwin) ? (CTXL + (lo + t) * 64) : ((t - nwin) * 64); return VTN + (size_t)sr * NKEY + key0 + pc * 8; };
    bf16x8 kreg = *(const bf16x8*)kaddr(0), vreg = *(const bf16x8*)vaddr(0);
    __syncthreads();
#pragma unroll 1
    for (int t = 0; t < ntiles; ++t) {
        u16* Kb = Ks + (t & 1) * 64 * 64; u16* Vb = Vs + (t & 1) * 64 * 72;
        *(bf16x8*)(Kb + sr * 64 + ((pc ^ ((sr >> 1) & 7)) * 8)) = kreg; *(bf16x8*)(Vb + sr * 72 + pc * 8) = vreg;
        __syncthreads();
        if (t + 1 < ntiles) { kreg = *(const bf16x8*)kaddr(t + 1); vreg = *(const bf16x8*)vaddr(t + 1); }
        const bool win = t < nwin; const int kr = lo + t;
        if (win && (kr < rsw || kr > rsw + 7)) continue;
        float bl[3][4];
        if (win) {
#pragma unroll
            for (int dl = 0; dl < 3; ++dl)
#pragma unroll
                for (int j = 0; j < 4; ++j) { const int co = min(max(16 * (dl - 1) + fq * 4 + j - fr + 15, 0), 30); bl[dl][j] = rpb[(kr - r + 7) * 31 + co] * LOG2E; }
        }
#pragma unroll
        for (int i = 0; i < 2; ++i) {
            bf16x8 kf[2][2], vf[4];
#pragma unroll
            for (int kbb = 0; kbb < 2; ++kbb)
#pragma unroll
                for (int ks = 0; ks < 2; ++ks) kf[kbb][ks] = *(const bf16x8*)(Kb + ((2 * i + kbb) * 16 + fr) * 64 + (((ks * 4 + fq) ^ (fr >> 1)) * 8));
#pragma unroll
            for (int dvb = 0; dvb < 4; ++dvb) { const u16* vp = Vb + (dvb * 16 + fr) * 72 + (2 * i) * 16 + fq * 4;
                const s16x4 vlo = *(const s16x4*)vp, vhi = *(const s16x4*)(vp + 16); vf[dvb] = __builtin_shufflevector(vlo, vhi, 0, 1, 2, 3, 4, 5, 6, 7); }
#pragma unroll
            for (int qq = 0; qq < 2; ++qq) {
                const int qblk = 2 * QH + qq;
                if (win && ((qblk == 0 && i == 1) || (qblk == 3 && i == 0))) continue;
                f32x4 p[2];
#pragma unroll
                for (int kbb = 0; kbb < 2; ++kbb) {
                    const int kb = 2 * i + kbb, dl = kb - qblk;
                    if (win && (dl < -1 || dl > 1)) { p[kbb] = (f32x4){0.f, 0.f, 0.f, 0.f}; continue; }
                    f32x4 acc;
#pragma unroll
                    for (int j = 0; j < 4; ++j) {
                        float iv = negb[qq];
                        if (win) { const int idx = (qq * 4 + kb) * 4 + j; const bool inw = (mlo >> idx) & 1u;
                            iv = inw ? (bl[(dl + 1) < 0 ? 0 : ((dl + 1) > 2 ? 2 : (dl + 1))][j] + negb[qq]) : -1e30f; }
                        acc[j] = iv;
                    }
#pragma unroll
                    for (int ks = 0; ks < 2; ++ks) acc = __builtin_amdgcn_mfma_f32_16x16x32_bf16(kf[kbb][ks], qf[qq][ks], acc, 0, 0, 0);
#pragma unroll
                    for (int j = 0; j < 4; ++j) acc[j] = __builtin_amdgcn_exp2f(acc[j]);
                    ls[qq] += (acc[0] + acc[1]) + (acc[2] + acc[3]);
                    p[kbb] = acc;
                }
                const bf16x8 pf = pack8(p[0], p[1]);
#pragma unroll
                for (int dvb = 0; dvb < 4; ++dvb) O[qq][dvb] = __builtin_amdgcn_mfma_f32_16x16x32_bf16(vf[dvb], pf, O[qq][dvb], 0, 0, 0);
            }
        }
    }
    u16* MIX = (u16*)(a.ws + WS_A);
#pragma unroll
    for (int qq = 0; qq < 2; ++qq) {
        const int qblk = 2 * QH + qq;
        float l = ls[qq]; l += __shfl_xor(l, 16); l += __shfl_xor(l, 32);
        const float il = 1.0f / l; const int qrow = b * SEQ + r * 64 + qblk * 16 + fr;
#pragma unroll
        for (int dvb = 0; dvb < 4; ++dvb) {
            u32x2 w; w.x = pk2(O[qq][dvb][0] * il, O[qq][dvb][1] * il); w.y = pk2(O[qq][dvb][2] * il, O[qq][dvb][3] * il);
            *(u32x2*)(MIX + (size_t)qrow * D + 256 + h * 64 + dvb * 16 + fq * 4) = w;
        }
    }
}


#ifndef PROBE_DIFF
#define PROBE_DIFF 1
#endif
#ifndef PROBE_NA
#define PROBE_NA 1
#endif
#ifndef PROBE_G13
#define PROBE_G13 1
#endif
#ifndef PROBE_G1
#define PROBE_G1 1
#endif
#ifndef PROBE_CONV
#define PROBE_CONV 1
#endif
#ifndef PROBE_G3
#define PROBE_G3 1
#endif
#ifndef PROBE_NORM
#define PROBE_NORM 1
#endif
template <int PHMASK, int PH> __device__ __forceinline__ void phase_body(const Args& a, unsigned char* lds) {
    int tid = threadIdx.x; asm volatile("" : "+v"(tid)); const int lane = tid & 63, wave = __builtin_amdgcn_readfirstlane(tid >> 6), G = gridDim.x, bid = blockIdx.x;
    u16* const Abuf = (u16*)(a.ws + WS_A);
    u16* const Xbuf = (u16*)(a.ws + WS_X);
    if constexpr (PH == 0) { if constexpr ((PHMASK & 1) != 0) phase_prep(a, lds); }
    else if constexpr (PH == NPHASE - 1) { if constexpr ((PHMASK & 2) != 0) phase_final(a); }
    else {
        constexpr int layer = (PH - 1) / 12, sp = (PH - 1) % 12;
        constexpr bool last = (layer == 1);
        constexpr int Mpost = last ? MX : MT;
        if constexpr (sp == 0) { if constexpr ((PHMASK & 2) != 0) for (int rep = 0; rep < PROBE_NORM; ++rep) phase_norm(a, layer, 0, MT, layer == 0); }
        if constexpr (sp == 3) { if constexpr ((PHMASK & 2) != 0) for (int rep = 0; rep < PROBE_NORM; ++rep) phase_norm(a, layer, 1, MT, false); }
        if constexpr (sp == 9) { if constexpr ((PHMASK & 2) != 0) for (int rep = 0; rep < PROBE_NORM; ++rep) phase_norm(a, layer, 2, Mpost, false); }
        if constexpr ((sp == 1 || sp == 10) && (PHMASK & 4)) {
            const int M = (sp == 1) ? MT : Mpost;
            pg8::Gemm g{Abuf, (const u16*)(a.ws + WS_W13) + (size_t)(layer * 2 + (sp == 1 ? 0 : 1)) * 2 * DFF * D, M, 2 * DFF, D};
            pg8::StaticOrder S; S.init(M, 2 * DFF, G, bid);
            EpiSwiglu E{Xbuf};
            for (int rep = 0; rep < PROBE_G13; ++rep) pg8::gemm_phase<EpiSwiglu, pg8::StaticOrder, true, true>((LAS unsigned char*)lds, g, S, E);
        }
        if constexpr ((sp == 2 || sp == 11) && (PHMASK & 4)) {
            const int M = (sp == 2) ? MT : Mpost;
            pg8::Gemm g{Xbuf, (const u16*)(a.ws + WS_W2) + (size_t)(layer * 2 + (sp == 2 ? 0 : 1)) * D * DFF, M, D, DFF};
            pg8::StaticOrder S; S.init(M, D, G, bid);
            EpiResid E{a.out, (float*)(a.ws + WS_HC), modp(a, layer, 0, sp == 2 ? 2 : 8), 0.5f};
            pg8::gemm_phase<EpiResid, pg8::StaticOrder, true, true>((LAS unsigned char*)lds, g, S, E);
        }
        if constexpr (sp == 4 && (PHMASK & 4)) {
            pg8::Gemm g{Abuf, (const u16*)(a.ws + WS_WIN) + (size_t)layer * NPROJ * D, MT, NPROJ, D};
            pg8::StaticOrder S; S.init(MT, NPROJ, G, bid);
            EpiProj E{Xbuf};
            pg8::gemm_phase<EpiProj, pg8::StaticOrder, true, true>((LAS unsigned char*)lds, g, S, E);
        }
        if constexpr (sp == 5) {
            if constexpr ((PHMASK & 8) != 0) for (int u = bid; u < 2 * NCH; u += G) prep_unit(a, layer, u, lds);
            __syncthreads();
            if constexpr ((PHMASK & 16) != 0) for (int rep = 0; rep < PROBE_G1; ++rep) {
                const int gw = bid * 8 + wave, NGW = G * 8;
                for (int wu = gw; wu < 4096; wu += NGW) {
                    const int dir = wu & 1, h = (wu >> 1) & 3, xc = (wu >> 3) & 255, b = wu >> 11;
                    gla_g1_wave(a, layer, b, xc + 4, h, dir, lds + wave * 16384, lane);
                }
                for (int j = 0; j < 64; ++j) if ((j * 32) % NGW == gw) {
                    const int dir = j & 1, h = (j >> 1) & 3, c = (j >> 3) & 3, b = j >> 5;
                    gla_g1_wave(a, layer, b, c, h, dir, lds + wave * 16384, lane);
                }
            }
            __syncthreads();
            const int ncu = last ? 1024 : 1040;
            if constexpr ((PHMASK & 32) != 0) {
                bf16x8 wf[2][8];
                { const u16* PWT = (const u16*)(a.ws + WS_PWT) + (size_t)layer * 256 * 256; const int fr = lane & 15, fq = lane >> 4;
#pragma unroll
                  for (int nbi = 0; nbi < 2; ++nbi)
#pragma unroll
                    for (int ks = 0; ks < 8; ++ks) wf[nbi][ks] = *(const bf16x8*)(PWT + (size_t)((wave * 2 + nbi) * 16 + fr) * 256 + ks * 32 + fq * 8); }
                for (int rep = 0; rep < PROBE_CONV; ++rep) for (int u = bid; u < ncu; u += G) conv_unit(a, layer, u, lds, wf);
            }
        }
        if constexpr (sp == 6) {
            if constexpr ((PHMASK & 64) != 0) gla_scan(a, lds);
            if constexpr ((PHMASK & 128) != 0) for (int rep = 0; rep < PROBE_NA; ++rep) for (int u = bid; u < 512; u += G) { const int uu = u >> 1; if (u & 1) na_unit<1>(a, layer, uu >> 7, (uu >> 5) & 3, uu & 31, lds); else na_unit<0>(a, layer, uu >> 7, (uu >> 5) & 3, uu & 31, lds); }
            if constexpr ((PHMASK & 128) != 0 && !last) for (int wu = bid * 8 + wave; wu < 2 * 4 * 16; wu += G * 8) na_wave(a, layer, true, wu, lane);
            if constexpr ((PHMASK & 256) != 0) for (int rep = 0; rep < PROBE_DIFF; ++rep) for (int u = bid; u < 512; u += G) { const int b = u >> 8, h = (u >> 6) & 3, qb = u & 63; diff_unit(a, layer, b, h, b * SEQ + qb * 256, NCH, lds); }
            if constexpr ((PHMASK & 256) != 0 && !last) for (int u = bid; u < 8; u += G) { const int b = u >> 2, h = u & 3; diff_unit(a, layer, b, h, MX + b * CTXL, 4, lds); }
        }
        if constexpr (sp == 7) {
            __syncthreads();
            if constexpr ((PHMASK & 512) != 0) for (int rep = 0; rep < PROBE_G3; ++rep) for (int wu = bid * 8 + wave; wu < 2 * NCH * 4; wu += G * 8) { const int c = (wu >> 2) % NCH; if (last && c < 4) continue; gla_g3_wave(a, layer, wu, lds + wave * 16384, lane); }
        }
        if constexpr (sp == 8 && (PHMASK & 4)) {
            pg8::Gemm g{Abuf, (const u16*)(a.ws + WS_WOUT) + (size_t)layer * D * D, Mpost, D, D};
            pg8::StaticOrder S; S.init(Mpost, D, G, bid);
            EpiResid E{a.out, (float*)(a.ws + WS_HC), modp(a, layer, 0, 5), 1.0f};
            pg8::gemm_phase<EpiResid, pg8::StaticOrder, true, true>((LAS unsigned char*)lds, g, S, E);
        }
    }
}
template <int PHMASK, int PH> __device__ __forceinline__ void run_phase(const Args& a, int lo, int hi, unsigned char* lds, cg::grid_group& grid) {
    if (lo <= PH && PH < hi) { if (PH > lo) grid.sync(); phase_body<PHMASK, PH>(a, lds); }
}
template <int PHMASK> __device__ __forceinline__ void run_phases(const Args& a, unsigned char* lds) {
    cg::grid_group grid = cg::this_grid();
    const int lo = a.ph_lo, hi = a.ph_hi;
#define RP(k) run_phase<PHMASK, k>(a, lo, hi, lds, grid);
    RP(0) RP(1) RP(2) RP(3) RP(4) RP(5) RP(6) RP(7) RP(8) RP(9) RP(10) RP(11) RP(12) RP(13) RP(14) RP(15) RP(16) RP(17) RP(18) RP(19) RP(20) RP(21) RP(22) RP(23) RP(24) RP(25)
#undef RP
}
extern __shared__ __attribute__((aligned(16))) unsigned char dyn_lds[];
template <int PM> __global__ void __launch_bounds__(512, 2) part_fwd(Args a) { run_phases<PM>(a, dyn_lds); }
#ifndef MK_PER_PHASE
#define MK_PER_PHASE 0
#endif
#if !MK_PER_PHASE
__global__ void __launch_bounds__(512, 2) mega_fwd(Args a) { run_phases<0xFFFF>(a, dyn_lds); }
#define MAIN_KERNEL mega_fwd
#else
#define MAIN_KERNEL part_fwd<4>
#endif
#ifndef MK_PER_PHASE
#define MK_PER_PHASE 0
#endif
extern "C" void kernel_launch(void* const* d_in, const int* in_sizes, int n_in, void* d_out, int out_size, void* d_ws, size_t ws_size, hipStream_t stream) {
    static int grid = 0;
    if (grid == 0) {
        if (n_in != 33 || ws_size < WS_END) { fprintf(stderr, "kernel_launch: unexpected n_in %d / ws_size %zu (need %zu)\n", n_in, ws_size, (size_t)WS_END); grid = -1; return; }
        int dev = 0, cus = 0, per_cu = 0;
        hipGetDevice(&dev); hipDeviceGetAttribute(&cus, hipDeviceAttributeMultiprocessorCount, dev);
        if (hipFuncSetAttribute((const void*)MAIN_KERNEL, hipFuncAttributeMaxDynamicSharedMemorySize, LDS_BYTES) != hipSuccess) { fprintf(stderr, "kernel_launch: hipFuncSetAttribute failed\n"); grid = -1; return; }
#if MK_PER_PHASE
        (void)hipFuncSetAttribute((const void*)part_fwd<1>, hipFuncAttributeMaxDynamicSharedMemorySize, LDS_BYTES); (void)hipFuncSetAttribute((const void*)part_fwd<2>, hipFuncAttributeMaxDynamicSharedMemorySize, LDS_BYTES);
        (void)hipFuncSetAttribute((const void*)part_fwd<4>, hipFuncAttributeMaxDynamicSharedMemorySize, LDS_BYTES); (void)hipFuncSetAttribute((const void*)part_fwd<56>, hipFuncAttributeMaxDynamicSharedMemorySize, LDS_BYTES);
        (void)hipFuncSetAttribute((const void*)part_fwd<448>, hipFuncAttributeMaxDynamicSharedMemorySize, LDS_BYTES); (void)hipFuncSetAttribute((const void*)part_fwd<512>, hipFuncAttributeMaxDynamicSharedMemorySize, LDS_BYTES);
#endif
        if (hipOccupancyMaxActiveBlocksPerMultiprocessor(&per_cu, (const void*)MAIN_KERNEL, 512, LDS_BYTES) != hipSuccess || per_cu < 1) { fprintf(stderr, "kernel_launch: occupancy query says %d\n", per_cu); per_cu = 1; }
        (void)hipGetLastError();
        grid = cus;
    }
    if (grid < 0) return;
    hipMemsetAsync((char*)d_ws + WS_CTL, 0, 4096, stream);
    Args a{};
    for (int i = 0; i < 33; ++i) a.in[i] = (const float*)d_in[i];
    a.out = (float*)d_out; a.ws = (unsigned char*)d_ws;
#if MK_PER_PHASE
    for (int ph = 0; ph < NPHASE; ++ph) {
        a.ph_lo = ph; a.ph_hi = ph + 1;
        const int sp = (ph == 0 || ph == NPHASE - 1) ? -1 : (ph - 1) % 12;
        if (ph == 0) hipLaunchKernelGGL(part_fwd<1>, dim3(grid), dim3(512), LDS_BYTES, stream, a);
        else if (sp == -1 || sp == 0 || sp == 3 || sp == 9) hipLaunchKernelGGL(part_fwd<2>, dim3(grid), dim3(512), LDS_BYTES, stream, a);
        else if (sp == 5) hipLaunchKernelGGL(part_fwd<56>, dim3(grid), dim3(512), LDS_BYTES, stream, a);
        else if (sp == 6) hipLaunchKernelGGL(part_fwd<448>, dim3(grid), dim3(512), LDS_BYTES, stream, a);
        else if (sp == 7) hipLaunchKernelGGL(part_fwd<512>, dim3(grid), dim3(512), LDS_BYTES, stream, a);
        else hipLaunchKernelGGL(part_fwd<4>, dim3(grid), dim3(512), LDS_BYTES, stream, a);
    }
#else
    a.ph_lo = 0; a.ph_hi = NPHASE;
    void* args[] = {&a};
    hipError_t e = hipLaunchCooperativeKernel((const void*)mega_fwd, dim3(grid), dim3(512), args, LDS_BYTES, stream);
    if (e != hipSuccess) fprintf(stderr, "kernel_launch: cooperative launch failed: %s (grid %d)\n", hipGetErrorString(e), grid);
#endif
}
```

```cpp
#include <hip/hip_runtime.h>
#include <hip/hip_cooperative_groups.h>
#include <cstdio>
#include <cstdint>
namespace cg = cooperative_groups;
#define MK_PER_PHASE 0
namespace pg8 {
#define PG8_LAS __attribute__((address_space(3)))
typedef unsigned short bf16_t;
typedef short bf16x8 __attribute__((ext_vector_type(8)));
typedef float f32x4 __attribute__((ext_vector_type(4)));
typedef unsigned u32x4 __attribute__((ext_vector_type(4)));
constexpr int BM = 256, BK = 64, HALF = 128, HTB = HALF * BK * 2  , STAGE_BYTES = 8 * HTB, NXCD = 8, WGM = 8;

__host__ __device__ __forceinline__ int lds_byte(int r, int c) { const int st = (r >> 4) * 2 + (c >> 5), rr = r & 15, cc = c & 31, ob = rr * 64 + cc * 2; return st * 1024 + (ob ^ (((ob >> 9) & 1) << 5)); }
__host__ __device__ __forceinline__ void stage_rc(int b, int& R, int& C) { const int st = b / 1024, sb = b % 1024, swz = sb ^ (((sb >> 9) & 1) << 5); R = (st >> 1) * 16 + swz / 64; C = (st & 1) * 32 + (swz % 64) / 2; }
__host__ __device__ __forceinline__ int perm32(int rho) { const int n = rho >> 4, i = rho & 15; return 8 * (i >> 2) + 4 * n + (i & 3); }

struct Unit { int pm, pn; };
struct Gemm { const bf16_t* A; const bf16_t* Bt; int M, N, K; };

struct StaticOrder {
    int nM, nN, nwg, G, c;
    __host__ __device__ void init(int M, int N, int G_, int c_) { nM = M / BM; nN = N / BM; nwg = nM * nN; G = G_; c = c_; }
    __host__ __device__ bool next(int i, Unit& u) const {
        const long L = (long)i * G + c; if (L >= nwg) return false;
        int wgid = (int)L; { const int q = nwg / NXCD, r = nwg % NXCD, xcd = wgid % NXCD, off = wgid / NXCD; wgid = (xcd < r ? xcd * (q + 1) : r * (q + 1) + (xcd - r) * q) + off; }
        const int nig = WGM * nN, gid = wgid / nig, fm = gid * WGM, gsz = (nM - fm) < WGM ? (nM - fm) : WGM;
        u.pm = fm + ((wgid % nig) % gsz); u.pn = (wgid % nig) / gsz; return true;
    }
    __device__ __forceinline__ void a_ready(const Unit&) const {}
    __device__ __forceinline__ void done(const Unit&) const {}
};

__device__ __forceinline__ unsigned cvt_pk_bf16(float lo, float hi) { unsigned r; asm volatile("v_cvt_pk_bf16_f32 %0, %1, %2" : "=v"(r) : "v"(lo), "v"(hi)); return r; }
template <class Epi, class Sched, bool ALIGN_EPI = false, bool SP2 = false>
__device__ __forceinline__ void gemm_phase(PG8_LAS unsigned char* lds, const Gemm g, const Sched& S, const Epi& E) {
    int tid_l = threadIdx.x; asm volatile("" : "+v"(tid_l)); const int tid = tid_l, wid = __builtin_amdgcn_readfirstlane(tid >> 6), lane = tid & 63, wr = wid >> 2, wc = wid & 3, fr = lane & 15, fq = lane >> 4;
    const int K = g.K, nt = K / BK;
    unsigned voffA[2], voffB[2];
#pragma unroll
    for (int i = 0; i < 2; ++i) { int R, C; stage_rc(tid * 16 + i * 8192, R, C); const int Rb = Epi::PERM ? ((R & ~31) + perm32(R & 31)) : R;
        voffA[i] = (unsigned)(R * K + C) * 2u; voffB[i] = (unsigned)(Rb * K + C) * 2u; }
    const size_t kstep = (size_t)(BK * 2);
    const size_t hstep = (size_t)HALF * K * 2;
    const size_t tstep = 2 * hstep;
    const unsigned ldsw = (unsigned)wid * 1024u;
    const int aoff = lds_byte(wr * 64 + fr, fq * 8), boff = lds_byte(wc * 32 + fr, fq * 8);
#define PG8_SA(b, h) (((b) * 2 + (h)) * HTB)
#define PG8_SB(b, h) ((4 + (b) * 2 + (h)) * HTB)
#define PG8_STAGE(bufoff, gbase, voff) do { _Pragma("unroll") for (int _i = 0; _i < 2; ++_i) \
        __builtin_amdgcn_global_load_lds((const unsigned*)((const char*)(gbase) + (voff)[_i]), (PG8_LAS unsigned*)(lds + (bufoff) + ldsw + _i * 8192), 16, 0, 0); } while (0)
#define PG8_LDA(dst, b, h) do { _Pragma("unroll") for (int m = 0; m < 4; ++m) _Pragma("unroll") for (int k = 0; k < 2; ++k) dst[m][k] = *(const PG8_LAS bf16x8*)(lds + PG8_SA(b, h) + aoff + m * 2048 + k * 1024); } while (0)
#define PG8_LDB(dst, b, h) do { _Pragma("unroll") for (int n = 0; n < 2; ++n) _Pragma("unroll") for (int k = 0; k < 2; ++k) dst[n][k] = *(const PG8_LAS bf16x8*)(lds + PG8_SB(b, h) + boff + n * 2048 + k * 1024); } while (0)
#define PG8_MMA(ai, bj, At, Bt) do { __builtin_amdgcn_s_setprio(1); _Pragma("unroll") for (int m = 0; m < 4; ++m) _Pragma("unroll") for (int n = 0; n < 2; ++n) _Pragma("unroll") for (int k = 0; k < 2; ++k) \
        acc[ai][bj][m][n] = __builtin_amdgcn_mfma_f32_16x16x32_bf16(Bt[n][k], At[m][k], acc[ai][bj][m][n], 0, 0, 0); __builtin_amdgcn_s_setprio(0); } while (0)
#define PG8_WAIT_V(n) asm volatile("s_waitcnt vmcnt(" #n ")" ::: "memory")
#define PG8_WAIT_L(n) asm volatile("s_waitcnt lgkmcnt(" #n ")" ::: "memory")
#define PG8_BAR __builtin_amdgcn_s_barrier()
#define PG8_SCHED __builtin_amdgcn_sched_barrier(0)
    Unit cur, nxt; int ui = 0;
    if (!S.next(0, cur)) return;
    f32x4 acc[2][2][4][2];
#pragma unroll
    for (int a = 0; a < 2; ++a)
#pragma unroll
        for (int b = 0; b < 2; ++b)
#pragma unroll
            for (int m = 0; m < 4; ++m)
#pragma unroll
                for (int n = 0; n < 2; ++n) acc[a][b][m][n] = (f32x4){0.f, 0.f, 0.f, 0.f};
    bf16x8 At[4][2], B0[2][2], B1[2][2];
    const char* cA = (const char*)g.A + (size_t)cur.pm * tstep; const char* cB = (const char*)g.Bt + (size_t)cur.pn * tstep;
    S.a_ready(cur);
    if constexpr (SP2) {
        PG8_STAGE(PG8_SB(0, 0), cB, voffB); PG8_STAGE(PG8_SB(0, 1), cB + hstep, voffB); PG8_STAGE(PG8_SA(0, 0), cA, voffA); PG8_STAGE(PG8_SA(0, 1), cA + hstep, voffA);
        if (wr == 1) PG8_BAR;
        PG8_WAIT_V(2); PG8_BAR;
        PG8_STAGE(PG8_SB(1, 0), cB + kstep, voffB); PG8_STAGE(PG8_SA(1, 0), cA + kstep, voffA); PG8_STAGE(PG8_SB(1, 1), cB + hstep + kstep, voffB);
        PG8_WAIT_V(6); PG8_BAR;
    } else {
        PG8_STAGE(PG8_SB(0, 0), cB, voffB); PG8_STAGE(PG8_SA(0, 0), cA, voffA); PG8_STAGE(PG8_SB(0, 1), cB + hstep, voffB); PG8_STAGE(PG8_SA(0, 1), cA + hstep, voffA);
        if (wr == 1) PG8_BAR;
        PG8_WAIT_V(4); PG8_BAR;
        PG8_STAGE(PG8_SB(1, 0), cB + kstep, voffB); PG8_STAGE(PG8_SA(1, 0), cA + kstep, voffA); PG8_STAGE(PG8_SB(1, 1), cB + hstep + kstep, voffB);
        PG8_WAIT_V(6); PG8_BAR;
    }
    for (;;) {
        const bool has_next = S.next(ui + 1, nxt);
        const char* nA = has_next ? (const char*)g.A + (size_t)nxt.pm * tstep : cA; const char* nB = has_next ? (const char*)g.Bt + (size_t)nxt.pn * tstep : cB;
        for (int t = 0; t < nt; t += 2) {
            const bool last = (t == nt - 2);
            const char* a1 = cA + (size_t)(t + 1) * kstep;
            const char* a2 = last ? nA : cA + (size_t)(t + 2) * kstep; const char* b2 = last ? nB : cB + (size_t)(t + 2) * kstep;
            const char* a3 = a2 + kstep; const char* b3 = b2 + kstep;
            if (last && has_next) S.a_ready(nxt);
            if constexpr (SP2) {
            PG8_LDB(B0, 0, 0); PG8_LDB(B1, 0, 1); PG8_SCHED; PG8_LDA(At, 0, 0); PG8_STAGE(PG8_SA(1, 1), a1 + hstep, voffA);
            PG8_WAIT_V(8); PG8_WAIT_L(0); PG8_BAR; PG8_MMA(0, 0, At, B0); PG8_MMA(0, 1, At, B1); PG8_BAR; PG8_SCHED;
            PG8_LDA(At, 0, 1); PG8_STAGE(PG8_SB(0, 0), b2, voffB); PG8_STAGE(PG8_SB(0, 1), b2 + hstep, voffB); PG8_STAGE(PG8_SA(0, 0), a2, voffA);
            PG8_WAIT_V(8); PG8_WAIT_L(0); PG8_BAR; PG8_MMA(1, 0, At, B0); PG8_MMA(1, 1, At, B1); PG8_BAR; PG8_SCHED;
            PG8_LDB(B0, 1, 0); PG8_LDB(B1, 1, 1); PG8_SCHED; PG8_LDA(At, 1, 0); PG8_STAGE(PG8_SA(0, 1), a2 + hstep, voffA);
            PG8_WAIT_V(8); PG8_WAIT_L(0); PG8_BAR; PG8_MMA(0, 0, At, B0); PG8_MMA(0, 1, At, B1); PG8_BAR; PG8_SCHED;
            PG8_LDA(At, 1, 1); PG8_STAGE(PG8_SB(1, 0), b3, voffB); PG8_STAGE(PG8_SB(1, 1), b3 + hstep, voffB); PG8_STAGE(PG8_SA(1, 0), a3, voffA);
            PG8_WAIT_V(8); PG8_WAIT_L(0); PG8_BAR; PG8_MMA(1, 0, At, B0); PG8_MMA(1, 1, At, B1); PG8_BAR; PG8_SCHED;
            } else {
            PG8_LDB(B0, 0, 0); PG8_SCHED; PG8_LDA(At, 0, 0); PG8_STAGE(PG8_SA(1, 1), a1 + hstep, voffA);
            PG8_WAIT_L(8); PG8_BAR; PG8_WAIT_L(0); PG8_MMA(0, 0, At, B0); PG8_BAR; PG8_SCHED;
            PG8_LDB(B1, 0, 1); PG8_STAGE(PG8_SB(0, 0), b2, voffB);
            PG8_BAR; PG8_WAIT_L(0); PG8_MMA(0, 1, At, B1); PG8_BAR;
            PG8_LDA(At, 0, 1); PG8_STAGE(PG8_SA(0, 0), a2, voffA);
            PG8_BAR; PG8_WAIT_L(0); PG8_MMA(1, 0, At, B0); PG8_BAR; PG8_SCHED;
            PG8_STAGE(PG8_SB(0, 1), b2 + hstep, voffB);
            PG8_WAIT_V(6); PG8_BAR; PG8_MMA(1, 1, At, B1); PG8_BAR;
            PG8_LDB(B0, 1, 0); PG8_SCHED; PG8_LDA(At, 1, 0); PG8_STAGE(PG8_SA(0, 1), a2 + hstep, voffA);
            PG8_WAIT_L(8); PG8_BAR; PG8_WAIT_L(0); PG8_MMA(0, 0, At, B0); PG8_BAR; PG8_SCHED;
            PG8_LDB(B1, 1, 1); PG8_STAGE(PG8_SB(1, 0), b3, voffB);
            PG8_BAR; PG8_WAIT_L(0); PG8_MMA(0, 1, At, B1); PG8_BAR;
            PG8_LDA(At, 1, 1); PG8_STAGE(PG8_SA(1, 0), a3, voffA);
            PG8_BAR; PG8_WAIT_L(0); PG8_MMA(1, 0, At, B0); PG8_BAR; PG8_SCHED;
            PG8_STAGE(PG8_SB(1, 1), b3 + hstep, voffB);
            PG8_WAIT_V(6); PG8_BAR; PG8_MMA(1, 1, At, B1); PG8_BAR;
            }
        }
        if constexpr (ALIGN_EPI) { if (wr == 0) PG8_BAR; }
        if constexpr (!Epi::AFTER_DRAIN) { E(acc, cur, wr, wc, fr, fq); S.done(cur); }
        if (!has_next) break;
#pragma unroll
        for (int a = 0; a < 2; ++a)
#pragma unroll
            for (int b = 0; b < 2; ++b)
#pragma unroll
                for (int m = 0; m < 4; ++m)
#pragma unroll
                    for (int n = 0; n < 2; ++n) acc[a][b][m][n] = (f32x4){0.f, 0.f, 0.f, 0.f};
        cur = nxt; cA = nA; cB = nB; ++ui;
        if constexpr (ALIGN_EPI) { if (wr == 1) PG8_BAR; }
    }
    PG8_WAIT_V(0);
    if constexpr (!ALIGN_EPI) { if (wr == 0) PG8_BAR; }
    PG8_BAR;
    if constexpr (Epi::AFTER_DRAIN) { E.fused(acc, cur, wr, wc, fr, fq, lds, wid, lane); S.done(cur); }
#undef PG8_SA
#undef PG8_SB
#undef PG8_STAGE
#undef PG8_LDA
#undef PG8_LDB
#undef PG8_MMA
#undef PG8_WAIT_V
#undef PG8_WAIT_L
#undef PG8_BAR
#undef PG8_SCHED
}
}

#define LAS __attribute__((address_space(3)))
typedef unsigned short u16;
typedef unsigned char uchar;
typedef short bf16x8 __attribute__((ext_vector_type(8)));
typedef short s16x4 __attribute__((ext_vector_type(4)));
typedef float f32x4 __attribute__((ext_vector_type(4)));
typedef unsigned u32x4 __attribute__((ext_vector_type(4)));
typedef unsigned u32x2 __attribute__((ext_vector_type(2)));

constexpr int D = 1024, SEQ = 16384, CTXL = 256, DFF = 2816, DPROJ = 2848, NPROJ = 3072;
constexpr int MX = 2 * SEQ, MC = 2 * CTXL, MT = MX + MC;
constexpr int NKEY = CTXL + SEQ, NCH = NKEY / 64;
constexpr int C_GQ = 0, C_GK = 128, C_GV = 256, C_GG = 512, C_AF = 768, C_NQ = 800, C_NK = 1056, C_NV = 1312, C_DQ = 1568, C_DK = 1824, C_DV = 2080, C_CA = 2336, C_CG = 2592;
constexpr float LOG2E = 1.4426950408889634f;

constexpr size_t MiB = 1u << 20;
constexpr size_t WS_CTL = 0, WS_MOD = 1 * MiB, WS_MISC = 1 * MiB + 512 * 1024, WS_HC = 2 * MiB, WS_PWT = 4 * MiB, WS_W13 = 8 * MiB, WS_W2 = 52 * MiB, WS_WIN = 74 * MiB,
                 WS_WOUT = 86 * MiB, WS_A = 90 * MiB, WS_X = 155 * MiB, WS_VTD = 336 * MiB, WS_VTN = 353 * MiB, WS_U = 370 * MiB, WS_DEC = 403 * MiB, WS_BC = 404 * MiB, WS_END = 437 * MiB;
constexpr int LDS_BYTES = 131072 + 256;
constexpr int NPHASE = 26;

struct Args { const float* in[33]; float* out; unsigned char* ws; int ph_lo, ph_hi; };

enum { I_X = 0, I_C, I_CTX, I_CCTX, I_ADAW, I_ADAB, I_NF1, I_F1W13, I_F1W2, I_NMIX, I_WIN, I_WAF, I_BAF, I_WAB, I_BAB, I_GNORM, I_RPB, I_LQ1, I_LK1, I_LQ2, I_LK2, I_DNORM,
       I_CDW, I_CDWB, I_CLNG, I_CLNB, I_CPW, I_CPWB, I_WOUT, I_NF2, I_F2W13, I_F2W2, I_FNORM };

__device__ __forceinline__ float bf2f(unsigned short h) { return __uint_as_float(((unsigned)h) << 16); }
__device__ __forceinline__ unsigned short f2bf(float f) { unsigned u = __float_as_uint(f); return (unsigned short)((u + 0x7fffu + ((u >> 16) & 1u)) >> 16); }
__device__ __forceinline__ unsigned pk2(float lo, float hi) { return (unsigned)f2bf(lo) | ((unsigned)f2bf(hi) << 16); }
__device__ __forceinline__ float wave_sum(float v) {
#pragma unroll
    for (int o = 1; o < 64; o <<= 1) v += __shfl_xor(v, o);
    return v;
}
__device__ __forceinline__ float silu_f(float x) { return x * __builtin_amdgcn_rcpf(1.0f + __expf(-x)); }
#define WAVE_SYNC() do { asm volatile("s_waitcnt lgkmcnt(0)" ::: "memory"); __builtin_amdgcn_wave_barrier(); } while (0)
__device__ __forceinline__ int row_of(int b, int c, int tk) { return (c < 4) ? (MX + b * CTXL + c * 64 + tk) : (b * SEQ + (c - 4) * 64 + tk); }
__device__ __forceinline__ float* hrow(const Args& a, int row) { return (row < MX) ? (a.out + (size_t)row * D) : ((float*)(a.ws + WS_HC) + (size_t)(row - MX) * D); }
__device__ __forceinline__ const float* modp(const Args& a, int layer, int g, int j) { return (const float*)(a.ws + WS_MOD) + ((size_t)(layer * 3 + g) * 9 + j) * D; }

struct EpiSwiglu {
    static constexpr bool PERM = true, AFTER_DRAIN = false;
    u16* O;
    __device__ __forceinline__ void operator()(const f32x4 (&acc)[2][2][4][2], const pg8::Unit& u, int wr, int wc, int fr, int fq) const {
        const int row0 = u.pm * 256 + wr * 64 + fr, col0 = u.pn * 128 + wc * 32 + 8 * fq;
#pragma unroll
        for (int ai = 0; ai < 2; ++ai)
#pragma unroll
            for (int m = 0; m < 4; ++m) {
                u16* rowp = O + (size_t)(row0 + ai * 128 + m * 16) * DFF + col0;
                const f32x4 a0 = acc[ai][0][m][0], a1 = acc[ai][0][m][1], u0 = acc[ai][1][m][0], u1 = acc[ai][1][m][1];
                float h[8];
#pragma unroll
                for (int e = 0; e < 4; ++e) { h[e] = silu_f(a0[e]) * u0[e]; h[4 + e] = silu_f(a1[e]) * u1[e]; }
                u32x4 w; w.x = pg8::cvt_pk_bf16(h[0], h[1]); w.y = pg8::cvt_pk_bf16(h[2], h[3]); w.z = pg8::cvt_pk_bf16(h[4], h[5]); w.w = pg8::cvt_pk_bf16(h[6], h[7]);
                *(u32x4*)rowp = w;
            }
    }
};
struct EpiResid {
    static constexpr bool PERM = false, AFTER_DRAIN = false;
    float* hx; float* hc; const float* gate0;
    float coef;
    __device__ __forceinline__ void operator()(const f32x4 (&acc)[2][2][4][2], const pg8::Unit& u, int wr, int wc, int fr, int fq) const {
        const int g = u.pm < 64 ? 0 : (u.pm < 128 ? 1 : 2);
        float* base = (u.pm < 128) ? (hx + (size_t)u.pm * 256 * D) : (hc + (size_t)(u.pm - 128) * 256 * D);
        const int row0 = wr * 64 + fr, col0 = u.pn * 256 + wc * 32 + 4 * fq;
        const float* gate = gate0 + (size_t)g * 9 * D;
        f32x4 gv[2][2];
#pragma unroll
        for (int bj = 0; bj < 2; ++bj)
#pragma unroll
            for (int n = 0; n < 2; ++n) gv[bj][n] = *(const f32x4*)(gate + col0 + bj * 128 + n * 16) * coef;
#pragma unroll
        for (int ai = 0; ai < 2; ++ai)
#pragma unroll
            for (int m = 0; m < 4; ++m) {
                float* rowp = base + (size_t)(row0 + ai * 128 + m * 16) * D + col0;
#pragma unroll
                for (int bj = 0; bj < 2; ++bj)
#pragma unroll
                    for (int n = 0; n < 2; ++n) { f32x4* p = (f32x4*)(rowp + bj * 128 + n * 16); *p = *p + gv[bj][n] * acc[ai][bj][m][n]; }
            }
    }
};
struct EpiProj {
    static constexpr bool PERM = true, AFTER_DRAIN = false;
    u16* O;
    __device__ __forceinline__ void operator()(const f32x4 (&acc)[2][2][4][2], const pg8::Unit& u, int wr, int wc, int fr, int fq) const {
        const int row0 = u.pm * 256 + wr * 64 + fr, col0 = u.pn * 256 + wc * 32 + 8 * fq;
#pragma unroll
        for (int ai = 0; ai < 2; ++ai)
#pragma unroll
            for (int m = 0; m < 4; ++m) {
                u16* rowp = O + (size_t)(row0 + ai * 128 + m * 16) * DPROJ;
#pragma unroll
                for (int bj = 0; bj < 2; ++bj) {
                    const int col = col0 + bj * 128;
                    if (col < DPROJ) {
                        const f32x4 v0 = acc[ai][bj][m][0], v1 = acc[ai][bj][m][1];
                        u32x4 w; w.x = pg8::cvt_pk_bf16(v0[0], v0[1]); w.y = pg8::cvt_pk_bf16(v0[2], v0[3]); w.z = pg8::cvt_pk_bf16(v1[0], v1[1]); w.w = pg8::cvt_pk_bf16(v1[2], v1[3]);
                        *(u32x4*)(rowp + col) = w;
                    }
                }
            }
    }
};

__device__ __forceinline__ void transpose_item(const float* W, int N, u16* WT, int K, int k0, int n0, int drow0, float* scr, int lane) {
#pragma unroll 8
    for (int i = 0; i < 32; ++i) { const int kk = 2 * i + (lane >> 5); scr[kk * 33 + (lane & 31)] = W[(size_t)(k0 + kk) * N + n0 + (lane & 31)]; }
    WAVE_SYNC();
    const int c = lane & 7;
#pragma unroll
    for (int j = 0; j < 4; ++j) {
        const int n = (lane >> 3) + 8 * j; const float* s = scr + (8 * c) * 33 + n;
        u32x4 o; o.x = pk2(s[0 * 33], s[1 * 33]); o.y = pk2(s[2 * 33], s[3 * 33]); o.z = pk2(s[4 * 33], s[5 * 33]); o.w = pk2(s[6 * 33], s[7 * 33]);
        *(u32x4*)(WT + (size_t)(drow0 + n) * K + k0 + 8 * c) = o;
    }
    WAVE_SYNC();
}

__device__ __forceinline__ void phase_prep(const Args& a, uchar* lds) {
    int tid = threadIdx.x; asm volatile("" : "+v"(tid)); const int lane = tid & 63, wave = tid >> 6, G = gridDim.x, bid = blockIdx.x;
    {
        float* sc = (float*)lds;
        float* red = sc + 3 * D;
        float* mod = (float*)(a.ws + WS_MOD);
        for (int i = tid; i < 3 * D; i += 512) { const int g = i >> 10, k = i & 1023; const float v = (g < 2) ? a.in[I_C][g * D + k] : a.in[I_CCTX][k]; sc[i] = silu_f(v); }
        __syncthreads();
        for (int u = bid; u < 2 * 144; u += G) {
            const int l = u / 144, cgp = u % 144, kc = tid >> 6, col = tid & 63;
            const float* w = a.in[I_ADAW] + ((size_t)l * D + kc * 128) * 9216 + cgp * 64 + col;
            float a0 = 0.f, a1 = 0.f, a2 = 0.f;
#pragma unroll 8
            for (int kk = 0; kk < 128; ++kk) { const float wv = w[(size_t)kk * 9216]; const int k = kc * 128 + kk; a0 += sc[k] * wv; a1 += sc[D + k] * wv; a2 += sc[2 * D + k] * wv; }
            red[(kc * 3 + 0) * 64 + col] = a0; red[(kc * 3 + 1) * 64 + col] = a1; red[(kc * 3 + 2) * 64 + col] = a2;
            __syncthreads();
            if (tid < 192) {
                const int g = tid >> 6, cc = tid & 63; float s = a.in[I_ADAB][l * 9216 + cgp * 64 + cc];
#pragma unroll
                for (int k8 = 0; k8 < 8; ++k8) s += red[(k8 * 3 + g) * 64 + cc];
                mod[(size_t)(l * 3 + g) * 9216 + cgp * 64 + cc] = s;
            }
            __syncthreads();
        }
        __syncthreads();
    }
    if (bid == 0) {
        float* tr = (float*)(a.ws + WS_MISC);
        for (int i = tid; i < 2560; i += 512) {
            const int j = i & 7; const int pos = (i < 2048) ? (i >> 3) : ((i - 2048) >> 3);
            const double inv = ((j & 1) ? 0.31622776601683794 : 1.0) * ((j >> 1) == 0 ? 1.0 : ((j >> 1) == 1 ? 0.1 : ((j >> 1) == 2 ? 0.01 : 0.001))), ang = (double)pos * inv;
            float* dst = (i < 2048) ? (tr + (size_t)i * 2) : (tr + 4096 + (size_t)(i - 2048) * 2);
            dst[0] = (float)cos(ang); dst[1] = (float)sin(ang);
        }
    }
    if (bid == (1 % G) && wave < 2) {
        const float* rpb = a.in[I_RPB] + wave * 4 * 15 * 31; float m = 0.f;
        for (int i = lane; i < 4 * 15 * 31; i += 64) m = fmaxf(m, fabsf(rpb[i]));
#pragma unroll
        for (int o = 1; o < 64; o <<= 1) m = fmaxf(m, __shfl_xor(m, o));
        if (lane == 0) ((float*)(a.ws + WS_MISC))[8192 + wave] = m;
    }
    {
        const size_t gt = (size_t)bid * 512 + tid, GT = (size_t)G * 512;
        for (int l = 0; l < 2; ++l) { u32x4* z = (u32x4*)((u16*)(a.ws + WS_WIN) + ((size_t)l * NPROJ + DPROJ) * D);
            for (size_t i = gt; i < (size_t)(NPROJ - DPROJ) * D / 8; i += GT) z[i] = (u32x4){0u, 0u, 0u, 0u}; }
    }
    {
        float* scr = (float*)lds + wave * (64 * 33);
        const int gw = bid * 8 + wave, NGW = G * 8;
        constexpr int I13 = 16 * 176, I2 = 44 * 32, IIN = 16 * 89, IOUT = 16 * 32, IPW = 4 * 8;
        constexpr int NIT = 4 * I13 + 4 * I2 + 2 * IIN + 2 * IOUT + 2 * IPW;
        for (int it = gw; it < NIT; it += NGW) {
            int r = it;
            if (r < 4 * I13) { const int mi = r / I13; r -= mi * I13; const int l = mi >> 1, f = mi & 1, kb = r / 176, nb = r % 176, n0 = nb * 32;
                const int j = (n0 < DFF) ? n0 : n0 - DFF; const int drow0 = 256 * (j >> 7) + (j & 127) + ((n0 < DFF) ? 0 : 128);
                transpose_item(a.in[f ? I_F2W13 : I_F1W13] + (size_t)l * D * 2 * DFF, 2 * DFF, (u16*)(a.ws + WS_W13) + (size_t)mi * 2 * DFF * D, D, kb * 64, n0, drow0, scr, lane); continue; }
            r -= 4 * I13;
            if (r < 4 * I2) { const int mi = r / I2; r -= mi * I2; const int l = mi >> 1, f = mi & 1, kb = r / 32, nb = r % 32;
                transpose_item(a.in[f ? I_F2W2 : I_F1W2] + (size_t)l * DFF * D, D, (u16*)(a.ws + WS_W2) + (size_t)mi * D * DFF, DFF, kb * 64, nb * 32, nb * 32, scr, lane); continue; }
            r -= 4 * I2;
            if (r < 2 * IIN) { const int l = r / IIN; r -= l * IIN; const int kb = r / 89, nb = r % 89;
                transpose_item(a.in[I_WIN] + (size_t)l * D * DPROJ, DPROJ, (u16*)(a.ws + WS_WIN) + (size_t)l * NPROJ * D, D, kb * 64, nb * 32, nb * 32, scr, lane); continue; }
            r -= 2 * IIN;
            if (r < 2 * IOUT) { const int l = r / IOUT; r -= l * IOUT; const int kb = r / 32, nb = r % 32;
                transpose_item(a.in[I_WOUT] + (size_t)l * D * D, D, (u16*)(a.ws + WS_WOUT) + (size_t)l * D * D, D, kb * 64, nb * 32, nb * 32, scr, lane); continue; }
            r -= 2 * IOUT;
            { const int l = r / IPW; r -= l * IPW; const int kb = r / 8, nb = r % 8;
                transpose_item(a.in[I_CPW] + (size_t)l * 256 * 256, 256, (u16*)(a.ws + WS_PWT) + (size_t)l * 256 * 256, 256, kb * 64, nb * 32, nb * 32, scr, lane); }
        }
    }
}

__device__ __forceinline__ void phase_norm(const Args& a, int layer, int which, int M, bool first) {
    int tid = threadIdx.x; asm volatile("" : "+v"(tid)); const int lane = tid & 63, wave = tid >> 6;
    const float* nw = a.in[which == 0 ? I_NF1 : (which == 1 ? I_NMIX : I_NF2)] + (size_t)layer * D;
    u16* A = (u16*)(a.ws + WS_A);
    for (int row = blockIdx.x * 8 + wave; row < M; row += gridDim.x * 8) {
        const float* src = first ? ((row < MX) ? a.in[I_X] + (size_t)row * D : a.in[I_CTX] + (size_t)(row - MX) * D) : hrow(a, row);
        const int g = row < SEQ ? 0 : (row < MX ? 1 : 2);
        const float* sh = modp(a, layer, g, 3 * which), * scl = modp(a, layer, g, 3 * which + 1);
        f32x4 v[4]; float ss = 0.f;
#pragma unroll
        for (int j = 0; j < 4; ++j) { v[j] = ((const f32x4*)src)[lane + 64 * j]; ss += (v[j].x * v[j].x + v[j].y * v[j].y) + (v[j].z * v[j].z + v[j].w * v[j].w); }
        if (first) { f32x4* hd = (f32x4*)hrow(a, row);
#pragma unroll
            for (int j = 0; j < 4; ++j) hd[lane + 64 * j] = v[j]; }
        const float rstd = rsqrtf(wave_sum(ss) * (1.0f / D) + 1e-6f);
        u32x2* o = (u32x2*)(A + (size_t)row * D);
#pragma unroll
        for (int j = 0; j < 4; ++j) {
            const f32x4 w4 = ((const f32x4*)nw)[lane + 64 * j], s4 = ((const f32x4*)scl)[lane + 64 * j], b4 = ((const f32x4*)sh)[lane + 64 * j];
            const f32x4 y = (v[j] * rstd) * w4 * (s4 + 1.0f) + b4;
            u32x2 p; p.x = pk2(y.x, y.y); p.y = pk2(y.z, y.w); o[lane + 64 * j] = p;
        }
    }
}
__device__ __forceinline__ void phase_final(const Args& a) {
    int tid = threadIdx.x; asm volatile("" : "+v"(tid)); const int lane = tid & 63, wave = tid >> 6;
    const float* nw = a.in[I_FNORM];
    for (int row = blockIdx.x * 8 + wave; row < MX; row += gridDim.x * 8) {
        f32x4* p = (f32x4*)(a.out + (size_t)row * D);
        f32x4 v[4]; float ss = 0.f;
#pragma unroll
        for (int j = 0; j < 4; ++j) { v[j] = p[lane + 64 * j]; ss += (v[j].x * v[j].x + v[j].y * v[j].y) + (v[j].z * v[j].z + v[j].w * v[j].w); }
        const float rstd = rsqrtf(wave_sum(ss) * (1.0f / D) + 1e-6f);
#pragma unroll
        for (int j = 0; j < 4; ++j) p[lane + 64 * j] = (v[j] * rstd) * ((const f32x4*)nw)[lane + 64 * j];
    }
}

__device__ __forceinline__ void prep_unit(const Args& a, int layer, int unit, uchar* lds) {
    int tid = threadIdx.x; asm volatile("" : "+v"(tid)); const int b = unit / NCH, c = unit % NCH;
    u16* P = (u16*)(a.ws + WS_X);
    unsigned* ctl = (unsigned*)(a.ws + WS_CTL) + layer * 64;
    unsigned* lmax = (unsigned*)lds;
    u16* T = (u16*)(lds + 256);
    if (tid < 12) lmax[tid] = 0u;
    __syncthreads();
    const float* tr = (const float*)(a.ws + WS_MISC);
    {
        const int tk = tid >> 3, row = row_of(b, c, tk);
        const int t = (c - 4) * 64 + tk, gr = t >> 6, gc = t & 63;
#pragma unroll
        for (int e = 0; e < 2; ++e) {
            const int id = (tid & 7) * 2 + e, isk = id >> 3, h = (id >> 1) & 3, s = id & 1;
            u16* p = P + (size_t)row * DPROJ + C_DQ + isk * 256 + h * 64 + s * 32;
            bf16x8 raw[4];
#pragma unroll
            for (int q = 0; q < 4; ++q) raw[q] = ((const bf16x8*)p)[q];
            float x[32];
#pragma unroll
            for (int q = 0; q < 4; ++q)
#pragma unroll
                for (int i = 0; i < 8; ++i) x[q * 8 + i] = bf2f((u16)raw[q][i]);
            if (c >= 4) {
#pragma unroll
                for (int j = 0; j < 8; ++j) {
                    const float cr = tr[(gr * 8 + j) * 2], sr = tr[(gr * 8 + j) * 2 + 1], cc = tr[4096 + (gc * 8 + j) * 2], sc = tr[4096 + (gc * 8 + j) * 2 + 1];
                    const float x0 = x[j], x1 = x[j + 8], y0 = x[16 + j], y1 = x[24 + j];
                    x[j] = x0 * cr - x1 * sr; x[j + 8] = x1 * cr + x0 * sr;
                    x[16 + j] = y0 * cc - y1 * sc; x[24 + j] = y1 * cc + y0 * sc;
                }
                u32x4 o[4];
#pragma unroll
                for (int q = 0; q < 4; ++q) { o[q].x = pk2(x[q * 8], x[q * 8 + 1]); o[q].y = pk2(x[q * 8 + 2], x[q * 8 + 3]); o[q].z = pk2(x[q * 8 + 4], x[q * 8 + 5]); o[q].w = pk2(x[q * 8 + 6], x[q * 8 + 7]); }
#pragma unroll
                for (int q = 0; q < 4; ++q) ((u32x4*)p)[q] = o[q];
            }
            if (isk) {
                float n2 = 0.f;
#pragma unroll
                for (int i = 0; i < 32; ++i) { const float r = bf2f(f2bf(x[i])); n2 += r * r; }
                atomicMax(&lmax[h * 2 + s], __float_as_uint(n2));
            }
        }
    }
    {
        const int tk = tid >> 3, h = (tid & 7) >> 1, hf = tid & 1, row = row_of(b, c, tk);
        const u16* p = P + (size_t)row * DPROJ + C_NK + h * 64 + hf * 32;
        float n2 = 0.f;
#pragma unroll
        for (int q = 0; q < 4; ++q) { const bf16x8 r = ((const bf16x8*)p)[q];
#pragma unroll
            for (int i = 0; i < 8; ++i) { const float f = bf2f((u16)r[i]); n2 += f * f; } }
        n2 += __shfl_xor(n2, 1);
        if (hf == 0) atomicMax(&lmax[8 + h], __float_as_uint(n2));
    }
#pragma unroll 1
    for (int wh = 0; wh < 2; ++wh) {
        const int ccol = wh ? C_NV : C_DV;
        u16* VT = (u16*)(a.ws + (wh ? WS_VTN : WS_VTD));
        __syncthreads();
        for (int i = tid; i < 64 * 32; i += 512) { const int tk = i >> 5, pc = i & 31;
            *(bf16x8*)(T + tk * 264 + pc * 8) = *(const bf16x8*)(P + (size_t)row_of(b, c, tk) * DPROJ + ccol + pc * 8); }
        __syncthreads();
        {
            const int r = tid >> 1, hf = tid & 1, h = r >> 6, dv = r & 63;
            u16* dst = VT + ((size_t)(b * 4 + h) * 64 + dv) * NKEY + c * 64 + hf * 32;
#pragma unroll
            for (int q = 0; q < 4; ++q) {
                u32x4 o; unsigned w[4];
#pragma unroll
                for (int i = 0; i < 4; ++i) { const int t0 = hf * 32 + q * 8 + i * 2; w[i] = (unsigned)T[t0 * 264 + r] | ((unsigned)T[(t0 + 1) * 264 + r] << 16); }
                o.x = w[0]; o.y = w[1]; o.z = w[2]; o.w = w[3];
                ((u32x4*)dst)[q] = o;
            }
        }
    }
    __syncthreads();
    if (tid < 8) atomicMax(&ctl[(b * 4 + (tid >> 1)) * 2 + (tid & 1)], lmax[tid]);
    else if (tid < 12) atomicMax(&ctl[16 + b * 4 + (tid - 8)], lmax[tid]);
    __syncthreads();
}

__device__ __forceinline__ void gla_bcum(const Args& a, int layer, const u16* prow, int h, int dir, int lane, float (&bc)[32]) {
    const float* wa = a.in[dir ? I_WAB : I_WAF] + (size_t)layer * 16 * 128 + h * 32;
    const float* ba = a.in[dir ? I_BAB : I_BAF] + (size_t)layer * 128 + h * 32;
    const bf16x8 r0 = *(const bf16x8*)(prow + C_AF + dir * 16), r1 = *(const bf16x8*)(prow + C_AF + dir * 16 + 8);
    float av[16];
#pragma unroll
    for (int i = 0; i < 8; ++i) { av[i] = bf2f((u16)r0[i]); av[8 + i] = bf2f((u16)r1[i]); }
#pragma unroll
    for (int d = 0; d < 32; ++d) {
        float z = ba[d];
#pragma unroll
        for (int r = 0; r < 16; ++r) z += av[r] * wa[r * 128 + d];
        const float ls = fminf(z, 0.f) - __logf(1.0f + __expf(-fabsf(z)));
        bc[d] = ls * (1.0f / 16.0f);
        if ((d & 3) == 3) __builtin_amdgcn_sched_barrier(0);
    }
#pragma unroll
    for (int off = 1; off < 64; off <<= 1) {
#pragma unroll
        for (int d = 0; d < 32; ++d) {
            if (dir == 0) { const float t = __shfl_up(bc[d], off); if (lane >= off) bc[d] += t; }
            else { const float t = __shfl_down(bc[d], off); if (lane + off < 64) bc[d] += t; }
        }
    }
}
__device__ __forceinline__ int gla_scan_idx(int dir, int c) { return dir == 0 ? c : ((c < 4) ? 3 - c : 263 - c); }

__device__ __forceinline__ void gla_g1_wave(const Args& a, int layer, int b, int c, int h, int dir, uchar* wlds, int lane) {
    asm volatile("" : "+v"(lane));
    const int fr = lane & 15, fq = lane >> 4;
    const u16* P = (const u16*)(a.ws + WS_X);
    const u16* prow = P + (size_t)row_of(b, c, lane) * DPROJ;
    u16* VT = (u16*)wlds;
    u16* KT = (u16*)(wlds + 8192);
    float* U = (float*)(a.ws + WS_U); float* DEC = (float*)(a.ws + WS_DEC);
    {
        bf16x8 vr[8];
#pragma unroll
        for (int q = 0; q < 8; ++q) vr[q] = ((const bf16x8*)(prow + C_GV + h * 64))[q];
#pragma unroll
        for (int q = 0; q < 8; ++q)
#pragma unroll
            for (int i = 0; i < 8; ++i) VT[(q * 8 + i) * 64 + lane] = (u16)vr[q][i];
    }
    float bc[32];
    gla_bcum(a, layer, prow, h, dir, lane, bc);
    const int n = gla_scan_idx(dir, c);
    const size_t sidx = ((size_t)((b * 2 + dir) * 4 + h) * NCH + n);
    {
        f32x4* bcp = (f32x4*)((float*)(a.ws + WS_BC) + ((((size_t)((b * 2 + dir) * 4 + h) * NCH + c) * 64 + lane) * 32));
#pragma unroll
        for (int q = 0; q < 8; ++q) bcp[q] = (f32x4){bc[q * 4], bc[q * 4 + 1], bc[q * 4 + 2], bc[q * 4 + 3]};
    }
    {
        bf16x8 kr[4];
#pragma unroll
        for (int q = 0; q < 4; ++q) kr[q] = ((const bf16x8*)(prow + C_GK + h * 32))[q];
#pragma unroll
        for (int d = 0; d < 32; ++d) { const float bl = __shfl(bc[d], dir ? 0 : 63); KT[d * 64 + lane] = f2bf(bf2f((u16)kr[d >> 3][d & 7]) * __expf(bl - bc[d])); }
    }
    if (lane == (dir ? 0 : 63)) {
#pragma unroll
        for (int q = 0; q < 8; ++q) { f32x4 o;
#pragma unroll
            for (int e = 0; e < 4; ++e) o[e] = __expf(bc[q * 4 + e]);
            ((f32x4*)(DEC + sidx * 32))[q] = o; }
    }
    WAVE_SYNC();
    f32x4 acc[4][2];
#pragma unroll
    for (int dvb = 0; dvb < 4; ++dvb)
#pragma unroll
        for (int db = 0; db < 2; ++db) acc[dvb][db] = (f32x4){0.f, 0.f, 0.f, 0.f};
#pragma unroll
    for (int ks = 0; ks < 2; ++ks) {
        bf16x8 kf[2];
#pragma unroll
        for (int db = 0; db < 2; ++db) kf[db] = *(const bf16x8*)(KT + (db * 16 + fr) * 64 + ks * 32 + fq * 8);
#pragma unroll
        for (int dvb = 0; dvb < 4; ++dvb) {
            const bf16x8 vf = *(const bf16x8*)(VT + (dvb * 16 + fr) * 64 + ks * 32 + fq * 8);
#pragma unroll
            for (int db = 0; db < 2; ++db) acc[dvb][db] = __builtin_amdgcn_mfma_f32_16x16x32_bf16(vf, kf[db], acc[dvb][db], 0, 0, 0);
        }
    }
    float* ub = U + sidx * 2048;
#pragma unroll
    for (int dvb = 0; dvb < 4; ++dvb)
#pragma unroll
        for (int db = 0; db < 2; ++db) *(f32x4*)(ub + (db * 16 + fr) * 64 + dvb * 16 + fq * 4) = acc[dvb][db];
    WAVE_SYNC();
}
__device__ __forceinline__ void gla_scan(const Args& a, uchar* lds) {
    int tid = threadIdx.x; asm volatile("" : "+v"(tid));
    float* U = (float*)(a.ws + WS_U); const float* DEC = (const float*)(a.ws + WS_DEC);
    float* PL = (float*)lds;
    const int seg = tid >> 7, el = tid & 127;
    constexpr int SEGN = NCH / 4;
    for (int blk = blockIdx.x; blk < 16 * 16; blk += gridDim.x) {
        const int seq = blk >> 4, e = (blk & 15) * 128 + el, d = e >> 6;
        float* u = U + ((size_t)seq * NCH + seg * SEGN) * 2048 + e; const float* dc = DEC + ((size_t)seq * NCH + seg * SEGN) * 32 + d;
        float pr = 1.f, s = 0.f;
#pragma unroll 5
        for (int n = 0; n < SEGN; ++n) { const float un = u[(size_t)n * 2048], dn = dc[n * 32]; s = dn * s + un; pr *= dn; }
        __syncthreads();
        PL[(seg * 128 + el) * 2] = pr; PL[(seg * 128 + el) * 2 + 1] = s;
        __syncthreads();
        float s0 = 0.f;
        for (int k = 0; k < seg; ++k) s0 = PL[(k * 128 + el) * 2] * s0 + PL[(k * 128 + el) * 2 + 1];
        s = s0;
#pragma unroll 5
        for (int n = 0; n < SEGN; ++n) { const float un = u[(size_t)n * 2048], dn = dc[n * 32]; u[(size_t)n * 2048] = s; s = dn * s + un; }
    }
    __syncthreads();
}
__device__ __forceinline__ void gla_g3_wave(const Args& a, int layer, int wu, uchar* wlds, int lane) {
    asm volatile("" : "+v"(lane));
    const int h = __builtin_amdgcn_readfirstlane(wu & 3), bc_ = __builtin_amdgcn_readfirstlane(wu >> 2), b = bc_ / NCH, c = bc_ % NCH;
    const int fr = lane & 15, fq = lane >> 4;
    const u16* P = (const u16*)(a.ws + WS_X);
    const int row_l = row_of(b, c, lane);
    const u16* prow = P + (size_t)row_l * DPROJ;
    u16* R0 = (u16*)wlds;
    u16* ST = (u16*)(wlds + 4096);
    u16* VT = (u16*)(wlds + 8192);
    const float* U = (const float*)(a.ws + WS_U);
    {
        bf16x8 vr[8];
#pragma unroll
        for (int q = 0; q < 8; ++q) vr[q] = ((const bf16x8*)(prow + C_GV + h * 64))[q];
#pragma unroll
        for (int q = 0; q < 8; ++q)
#pragma unroll
            for (int i = 0; i < 8; ++i) VT[(q * 8 + i) * 64 + lane] = (u16)vr[q][i];
    }
    f32x4 O[4][4];
#pragma unroll
    for (int qb = 0; qb < 4; ++qb)
#pragma unroll
        for (int dvb = 0; dvb < 4; ++dvb) O[qb][dvb] = (f32x4){0.f, 0.f, 0.f, 0.f};
#pragma unroll 1
    for (int dir = 0; dir < 2; ++dir) {
        const int n = gla_scan_idx(dir, c);
        const float* sp = U + ((size_t)((b * 2 + dir) * 4 + h) * NCH + n) * 2048;
        u32x4 qpk[4], kpk[4];
        {
            const f32x4* bcp = (const f32x4*)((const float*)(a.ws + WS_BC) + ((((size_t)((b * 2 + dir) * 4 + h) * NCH + c) * 64 + lane) * 32));
#pragma unroll
            for (int q = 0; q < 4; ++q) {
                const bf16x8 qr = ((const bf16x8*)(prow + C_GQ + h * 32))[q], kr = ((const bf16x8*)(prow + C_GK + h * 32))[q];
                const f32x4 b0 = bcp[2 * q], b1 = bcp[2 * q + 1];
                float e[8];
#pragma unroll
                for (int i = 0; i < 4; ++i) { e[i] = __expf(b0[i]); e[4 + i] = __expf(b1[i]); }
                unsigned wq[4], wk[4];
#pragma unroll
                for (int i = 0; i < 4; ++i) {
                    wq[i] = pk2(bf2f((u16)qr[2 * i]) * 0.17677669529663687f * e[2 * i], bf2f((u16)qr[2 * i + 1]) * 0.17677669529663687f * e[2 * i + 1]);
                    wk[i] = pk2(bf2f((u16)kr[2 * i]) * __builtin_amdgcn_rcpf(e[2 * i]), bf2f((u16)kr[2 * i + 1]) * __builtin_amdgcn_rcpf(e[2 * i + 1]));
                }
                qpk[q] = (u32x4){wq[0], wq[1], wq[2], wq[3]}; kpk[q] = (u32x4){wk[0], wk[1], wk[2], wk[3]};
            }
        }
        WAVE_SYNC();
#pragma unroll
        for (int q = 0; q < 4; ++q) ((u32x4*)(R0 + lane * 32))[q] = qpk[q];
#pragma unroll
        for (int q = 0; q < 4; ++q) { u32x4 o; unsigned w[4];
#pragma unroll
            for (int i = 0; i < 4; ++i) { const int d = q * 8 + 2 * i; w[i] = pk2(sp[d * 64 + lane], sp[(d + 1) * 64 + lane]); }
            o.x = w[0]; o.y = w[1]; o.z = w[2]; o.w = w[3]; ((u32x4*)(ST + lane * 32))[q] = o; }
        WAVE_SYNC();
        bf16x8 qf[4];
#pragma unroll
        for (int qb = 0; qb < 4; ++qb) qf[qb] = *(const bf16x8*)(R0 + (qb * 16 + fr) * 32 + fq * 8);
        WAVE_SYNC();
#pragma unroll
        for (int q = 0; q < 4; ++q) ((u32x4*)(R0 + lane * 32))[q] = kpk[q];
        WAVE_SYNC();
#pragma unroll
        for (int dvb = 0; dvb < 4; ++dvb) {
            const bf16x8 sf = *(const bf16x8*)(ST + (dvb * 16 + fr) * 32 + fq * 8);
#pragma unroll
            for (int qb = 0; qb < 4; ++qb) O[qb][dvb] = __builtin_amdgcn_mfma_f32_16x16x32_bf16(sf, qf[qb], O[qb][dvb], 0, 0, 0);
        }
#pragma unroll
        for (int ip = 0; ip < 2; ++ip) {
            const bf16x8 kf0 = *(const bf16x8*)(R0 + ((2 * ip) * 16 + fr) * 32 + fq * 8), kf1 = *(const bf16x8*)(R0 + ((2 * ip + 1) * 16 + fr) * 32 + fq * 8);
            bf16x8 pf[4];
#pragma unroll
            for (int qb = 0; qb < 4; ++qb) {
                f32x4 a0 = (f32x4){0.f, 0.f, 0.f, 0.f}, a1 = a0;
                a0 = __builtin_amdgcn_mfma_f32_16x16x32_bf16(kf0, qf[qb], a0, 0, 0, 0);
                a1 = __builtin_amdgcn_mfma_f32_16x16x32_bf16(kf1, qf[qb], a1, 0, 0, 0);
                const int i = qb * 16 + fr;
                float p[8];
#pragma unroll
                for (int jj = 0; jj < 4; ++jj) {
                    const int j0 = (2 * ip) * 16 + fq * 4 + jj, j1 = j0 + 16;
                    p[jj] = (dir == 0 ? (j0 <= i) : (j0 >= i)) ? a0[jj] : 0.f;
                    p[4 + jj] = (dir == 0 ? (j1 <= i) : (j1 >= i)) ? a1[jj] : 0.f;
                }
                u32x4 w; w.x = pk2(p[0], p[1]); w.y = pk2(p[2], p[3]); w.z = pk2(p[4], p[5]); w.w = pk2(p[6], p[7]);
                pf[qb] = __builtin_bit_cast(bf16x8, w);
            }
#pragma unroll
            for (int dvb = 0; dvb < 4; ++dvb) {
                const u16* vp = VT + (dvb * 16 + fr) * 64 + (2 * ip) * 16 + fq * 4;
                const s16x4 lo = *(const s16x4*)vp, hi = *(const s16x4*)(vp + 16);
                const bf16x8 vf = __builtin_shufflevector(lo, hi, 0, 1, 2, 3, 4, 5, 6, 7);
#pragma unroll
                for (int qb = 0; qb < 4; ++qb) O[qb][dvb] = __builtin_amdgcn_mfma_f32_16x16x32_bf16(vf, pf[qb], O[qb][dvb], 0, 0, 0);
            }
        }
    }
    const float* gnw = a.in[I_GNORM] + layer * 64;
    u16* MIX = (u16*)(a.ws + WS_A);
#pragma unroll
    for (int qb = 0; qb < 4; ++qb) {
        float ss = 0.f;
#pragma unroll
        for (int dvb = 0; dvb < 4; ++dvb)
#pragma unroll
            for (int jj = 0; jj < 4; ++jj) ss += O[qb][dvb][jj] * O[qb][dvb][jj];
        ss += __shfl_xor(ss, 16); ss += __shfl_xor(ss, 32);
        const float r = rsqrtf(ss * (1.0f / 64.0f) + 1e-6f);
        const int row = row_of(b, c, qb * 16 + fr);
#pragma unroll
        for (int dvb = 0; dvb < 4; ++dvb) {
            const int v0 = dvb * 16 + fq * 4;
            const s16x4 g4 = *(const s16x4*)(P + (size_t)row * DPROJ + C_GG + h * 64 + v0);
            const f32x4 nw = *(const f32x4*)(gnw + v0);
            float o[4];
#pragma unroll
            for (int jj = 0; jj < 4; ++jj) o[jj] = O[qb][dvb][jj] * r * nw[jj] * silu_f(bf2f((u16)g4[jj]));
            u32x2 w; w.x = pk2(o[0], o[1]); w.y = pk2(o[2], o[3]);
            *(u32x2*)(MIX + (size_t)row * D + h * 64 + v0) = w;
        }
    }
    WAVE_SYNC();
}

__device__ __forceinline__ void conv_unit(const Args& a, int layer, int unit, uchar* lds, const bf16x8 (&wf)[2][8]) {
    int tid = threadIdx.x; asm volatile("" : "+v"(tid)); const int lane = tid & 63, wave = tid >> 6, fr = lane & 15, fq = lane >> 4;
    int t0, L, rowbase;
    if (unit < 1024) { const int b = unit >> 9; t0 = (unit & 511) * 32; L = SEQ; rowbase = b * SEQ; }
    else { const int uu = unit - 1024, b = uu >> 3; t0 = (uu & 7) * 32; L = CTXL; rowbase = MX + b * CTXL; }
    const u16* P = (const u16*)(a.ws + WS_X);
    float* Ub = (float*)lds;
    float* Y = (float*)(lds + 65536);
    u16* Z = (u16*)(lds + 98304);
    for (int i = tid; i < 62 * 64; i += 512) {
        const int p = i >> 6, c4 = (i & 63) * 4, t = t0 - 15 + p;
        f32x4 u = (f32x4){0.f, 0.f, 0.f, 0.f};
        if (t >= 0 && t < L) {
            const u16* pr = P + (size_t)(rowbase + t) * DPROJ;
            const s16x4 av = *(const s16x4*)(pr + C_CA + c4), gv = *(const s16x4*)(pr + C_CG + c4);
#pragma unroll
            for (int e = 0; e < 4; ++e) { const float g = bf2f((u16)gv[e]); u[e] = bf2f((u16)av[e]) / (1.0f + __expf(-g)); }
        }
        *(f32x4*)(Ub + p * 256 + c4) = u;
    }
    __syncthreads();
    {
        const int c = tid & 255, th = tid >> 8;
        const float* dw = a.in[I_CDW] + (size_t)layer * 31 * 256 + c;
        float w[31];
#pragma unroll
        for (int k = 0; k < 31; ++k) w[k] = dw[k * 256];
        const float bias = a.in[I_CDWB][layer * 256 + c];
        float uw[46];
#pragma unroll
        for (int i = 0; i < 46; ++i) uw[i] = Ub[(th * 16 + i) * 256 + c];
#pragma unroll
        for (int tt = 0; tt < 16; ++tt) {
            float acc = bias;
#pragma unroll
            for (int k = 0; k < 31; ++k) acc += w[k] * uw[tt + k];
            Y[(th * 16 + tt) * 256 + c] = acc;
        }
    }
    __syncthreads();
    {
        const f32x4 g4 = *(const f32x4*)(a.in[I_CLNG] + layer * 256 + lane * 4), b4 = *(const f32x4*)(a.in[I_CLNB] + layer * 256 + lane * 4);
#pragma unroll
        for (int q = 0; q < 4; ++q) {
            const int t = wave * 4 + q;
            const f32x4 v = *(const f32x4*)(Y + t * 256 + lane * 4);
            const float mu = wave_sum((v.x + v.y) + (v.z + v.w)) * (1.0f / 256.0f);
            const f32x4 dlt = v - mu;
            const float var = wave_sum((dlt.x * dlt.x + dlt.y * dlt.y) + (dlt.z * dlt.z + dlt.w * dlt.w)) * (1.0f / 256.0f);
            const float rs = rsqrtf(var + 1e-5f);
            float z[4];
#pragma unroll
            for (int e = 0; e < 4; ++e) z[e] = silu_f(dlt[e] * rs * g4[e] + b4[e]);
            u32x2 w; w.x = pk2(z[0], z[1]); w.y = pk2(z[2], z[3]);
            *(u32x2*)(Z + t * 264 + lane * 4) = w;
        }
    }
    __syncthreads();
    {
        f32x4 acc[2][2];
#pragma unroll
        for (int i = 0; i < 2; ++i)
#pragma unroll
            for (int j = 0; j < 2; ++j) acc[i][j] = (f32x4){0.f, 0.f, 0.f, 0.f};
#pragma unroll
        for (int ks = 0; ks < 8; ++ks) {
            bf16x8 zf[2];
#pragma unroll
            for (int tb = 0; tb < 2; ++tb) zf[tb] = *(const bf16x8*)(Z + (tb * 16 + fr) * 264 + ks * 32 + fq * 8);
#pragma unroll
            for (int nbi = 0; nbi < 2; ++nbi)
#pragma unroll
                for (int tb = 0; tb < 2; ++tb) acc[nbi][tb] = __builtin_amdgcn_mfma_f32_16x16x32_bf16(wf[nbi][ks], zf[tb], acc[nbi][tb], 0, 0, 0);
        }
        u16* MIX = (u16*)(a.ws + WS_A);
#pragma unroll
        for (int nbi = 0; nbi < 2; ++nbi) {
            const int n0 = (wave * 2 + nbi) * 16 + fq * 4;
            const f32x4 pb = *(const f32x4*)(a.in[I_CPWB] + layer * 256 + n0);
#pragma unroll
            for (int tb = 0; tb < 2; ++tb) {
                const int row = rowbase + t0 + tb * 16 + fr;
                u32x2 w; w.x = pk2(acc[nbi][tb][0] + pb[0], acc[nbi][tb][1] + pb[1]); w.y = pk2(acc[nbi][tb][2] + pb[2], acc[nbi][tb][3] + pb[3]);
                *(u32x2*)(MIX + (size_t)row * D + 768 + n0) = w;
            }
        }
    }
    __syncthreads();
}
#define XB_TMO      128
#define XB_XCNT(j)  (256  + 64 * (j))
#define XB_XSUB(j)  (1280 + 64 * (j))
#define XB_XGEN(j)  (2304 + 64 * (j))
#define XB_TOP      3328
#define XB_TOPGEN   3392
#define XCD_BAR_WORDS 3456
#define XB_SPIN_CAP (1u << 18)

__device__ __forceinline__ unsigned xb_ld(unsigned* p)              { return __hip_atomic_load(p, __ATOMIC_RELAXED, __HIP_MEMORY_SCOPE_AGENT); }
__device__ __forceinline__ unsigned xb_add(unsigned* p, unsigned v) { return __hip_atomic_fetch_add(p, v, __ATOMIC_RELAXED, __HIP_MEMORY_SCOPE_AGENT); }
__device__ __forceinline__ unsigned xb_xcc_id() { return (unsigned)__builtin_amdgcn_s_getreg((3 << 11) | 20) & 0xFu; }
#define XB_SPIN(cond, bar) do { unsigned _sp = 0; while (cond) { __builtin_amdgcn_s_sleep(1); \
    if ((++_sp & 255u) == 0u) { if (xb_ld(&(bar)[XB_TMO])) break; if (_sp > XB_SPIN_CAP) { atomicAdd(&(bar)[XB_TMO], 1u); break; } } } } while (0)

struct XcdBarrier {
    unsigned* bar; unsigned x;
    volatile LAS unsigned* st;
};

__device__ __forceinline__ XcdBarrier xcd_barrier_post(unsigned* bar, volatile LAS unsigned* st) {
    XcdBarrier b; b.bar = bar; b.x = xb_xcc_id(); b.st = st;
    if (threadIdx.x == 0) (void)xb_add(&bar[XB_XCNT(b.x)], 1u);
    return b;
}
__device__ __forceinline__ void xcd_barrier_complete(unsigned* bar, unsigned x, unsigned& nloc, unsigned& nx) {
    const unsigned G = gridDim.x * gridDim.y * gridDim.z;
    unsigned sum, cnt, mine, sp = 0u;
    for (;;) {
        sum = 0u; cnt = 0u; mine = 0u;
#pragma unroll
        for (unsigned j = 0; j < 16; ++j) { const unsigned c = xb_ld(&bar[XB_XCNT(j)]); sum += c; cnt += (c > 0u) ? 1u : 0u; mine = (j == x) ? c : mine; }
        if (sum == G) break;
        __builtin_amdgcn_s_sleep(1);
        if ((++sp & 255u) == 0u) { if (xb_ld(&bar[XB_TMO])) break; if (sp > XB_SPIN_CAP) { atomicAdd(&bar[XB_TMO], 1u); break; } }
    }
    nloc = mine > 0u ? mine : 1u; nx = cnt > 0u ? cnt : 1u;
}

__device__ __forceinline__ void xcd_barrier(const XcdBarrier& b) {
    asm volatile("s_waitcnt vmcnt(0)" ::: "memory");
    __syncthreads();
    if (threadIdx.x == 0) {
        unsigned* bar = b.bar;
        __builtin_amdgcn_s_waitcnt(0);
        unsigned nloc = b.st[0], nx = b.st[1];
        if (nloc == 0u) { xcd_barrier_complete(bar, b.x, nloc, nx); b.st[0] = nloc; b.st[1] = nx; }
        const unsigned old = xb_add(&bar[XB_XSUB(b.x)], 1u);
        const unsigned gen = old / nloc;
        if (old + 1u == (gen + 1u) * nloc) {
            __builtin_amdgcn_fence(__ATOMIC_RELEASE, "agent");
            asm volatile("s_waitcnt vmcnt(0)" ::: "memory");
            const unsigned og = xb_add(&bar[XB_TOP], 1u);
            const unsigned tg = og / nx;
            if (og + 1u == (tg + 1u) * nx) xb_add(&bar[XB_TOPGEN], 1u);
            else XB_SPIN(xb_ld(&bar[XB_TOPGEN]) == tg, bar);
            __builtin_amdgcn_fence(__ATOMIC_ACQUIRE, "agent");
            xb_add(&bar[XB_XGEN(b.x)], 1u);
            asm volatile("s_waitcnt vmcnt(0)" ::: "memory");
        } else {
            XB_SPIN(xb_ld(&bar[XB_XGEN(b.x)]) == gen, bar);
            __builtin_amdgcn_fence(__ATOMIC_ACQUIRE, "agent");
            asm volatile("s_waitcnt vmcnt(0)" ::: "memory");
        }
    }
    __syncthreads();
}

typedef float f32x2_t __attribute__((ext_vector_type(2)));
typedef __bf16 bf16x2_t __attribute__((ext_vector_type(2)));
__device__ __forceinline__ unsigned cvtpk_s(float lo, float hi) { f32x2_t v = {lo, hi}; bf16x2_t b = __builtin_convertvector(v, bf16x2_t); return __builtin_bit_cast(unsigned, b); }
__device__ __forceinline__ bf16x8 pack8(const f32x4& p0, const f32x4& p1) {
    u32x4 w; w.x = cvtpk_s(p0[0], p0[1]); w.y = cvtpk_s(p0[2], p0[3]); w.z = cvtpk_s(p1[0], p1[1]); w.w = cvtpk_s(p1[2], p1[3]);
    return __builtin_bit_cast(bf16x8, w);
}
__device__ __forceinline__ bf16x8 load_scaled8(const u16* p, float sc, float& n2) {
    const bf16x8 raw = *(const bf16x8*)p; bf16x8 o;
#pragma unroll
    for (int i = 0; i < 8; ++i) { const u16 r = f2bf(bf2f((u16)raw[i]) * sc); const float f = bf2f(r); n2 += f * f; o[i] = (short)r; }
    return o;
}

__device__ __forceinline__ void diff_unit(const Args& a, int layer, int b, int h, int q0row, int ntiles, uchar* lds) {
    int tid = threadIdx.x; asm volatile("" : "+v"(tid)); const int lane = tid & 63, wave = tid >> 6, fr = lane & 15, fq = lane >> 4;
    const u16* P = (const u16*)(a.ws + WS_X);
    const u16* VTD = (const u16*)(a.ws + WS_VTD) + (size_t)(b * 4 + h) * 64 * NKEY;
    const unsigned* ctl = (const unsigned*)(a.ws + WS_CTL) + layer * 64;
    u16* Ks = (u16*)lds;
    u16* Vs = (u16*)(lds + 2 * 64 * 64 * 2);
    const float C2 = 0.17677669529663687f * LOG2E;
    bf16x8 qf[2][2]; float negb[2][2];
#pragma unroll
    for (int qb = 0; qb < 2; ++qb)
#pragma unroll
        for (int s = 0; s < 2; ++s) {
            const int row = q0row + wave * 32 + qb * 16 + fr; float n2 = 0.f;
            qf[qb][s] = load_scaled8(P + (size_t)row * DPROJ + C_DQ + h * 64 + s * 32 + fq * 8, C2, n2);
            n2 += __shfl_xor(n2, 16); n2 += __shfl_xor(n2, 32);
            const float km = __uint_as_float(ctl[(b * 4 + h) * 2 + s]);
            negb[qb][s] = -sqrtf(n2 * km);
        }
    f32x4 O[2][2][4], Ls[2][2];
    const bf16x8 ones = (bf16x8){(short)0x3F80, (short)0x3F80, (short)0x3F80, (short)0x3F80, (short)0x3F80, (short)0x3F80, (short)0x3F80, (short)0x3F80};
#pragma unroll
    for (int qb = 0; qb < 2; ++qb)
#pragma unroll
        for (int s = 0; s < 2; ++s) { Ls[qb][s] = (f32x4){0.f, 0.f, 0.f, 0.f};
#pragma unroll
            for (int dvb = 0; dvb < 4; ++dvb) O[qb][s][dvb] = (f32x4){0.f, 0.f, 0.f, 0.f}; }
    const int sr = tid >> 3, pc = tid & 7;
    auto kaddr = [&](int t) -> const u16* { const int krow = (t < 4) ? (MX + b * CTXL + t * 64 + sr) : (b * SEQ + (t - 4) * 64 + sr); return P + (size_t)krow * DPROJ + C_DK + h * 64 + pc * 8; };
    auto vaddr = [&](int t) -> const u16* { return VTD + (size_t)sr * NKEY + t * 64 + pc * 8; };
    auto compute_tile = [&](const u16* Kb, const u16* Vb) {
        f32x4 S0[2][2], S1[2][2];
        bf16x8 pfr[2][2];
        bf16x8 vfr[4];
#define DIFF_QK(g) do { const int i_ = (g) >> 1, s_ = (g) & 1; \
            const bf16x8 kf0 = *(const bf16x8*)(Kb + ((2 * i_) * 16 + fr) * 64 + (((s_ * 4 + fq) ^ (fr >> 1)) * 8)), kf1 = *(const bf16x8*)(Kb + ((2 * i_ + 1) * 16 + fr) * 64 + (((s_ * 4 + fq) ^ (fr >> 1)) * 8)); \
            _Pragma("unroll") for (int qb = 0; qb < 2; ++qb) { const float nb = negb[qb][s_]; const f32x4 c0 = (f32x4){nb, nb, nb, nb}; \
                S0[(g) & 1][qb] = __builtin_amdgcn_mfma_f32_16x16x32_bf16(kf0, qf[qb][s_], c0, 0, 0, 0); \
                S1[(g) & 1][qb] = __builtin_amdgcn_mfma_f32_16x16x32_bf16(kf1, qf[qb][s_], c0, 0, 0, 0); } } while (0)
#define DIFF_EXP(g) do { _Pragma("unroll") for (int qb = 0; qb < 2; ++qb) { f32x4 e0, e1; \
                _Pragma("unroll") for (int j = 0; j < 4; ++j) { e0[j] = __builtin_amdgcn_exp2f(S0[(g) & 1][qb][j]); e1[j] = __builtin_amdgcn_exp2f(S1[(g) & 1][qb][j]); } \
                pfr[(g) & 1][qb] = pack8(e0, e1); } } while (0)
#define DIFF_VLOAD(i_) do { _Pragma("unroll") for (int dvb = 0; dvb < 4; ++dvb) { const u16* vp = Vb + (dvb * 16 + fr) * 72 + (2 * (i_)) * 16 + fq * 4; \
                const s16x4 lo = *(const s16x4*)vp, hi = *(const s16x4*)(vp + 16); vfr[dvb] = __builtin_shufflevector(lo, hi, 0, 1, 2, 3, 4, 5, 6, 7); } } while (0)
#define DIFF_PV(g) do { const int s_ = (g) & 1; \
            _Pragma("unroll") for (int qb = 0; qb < 2; ++qb) Ls[qb][s_] = __builtin_amdgcn_mfma_f32_16x16x32_bf16(ones, pfr[(g) & 1][qb], Ls[qb][s_], 0, 0, 0); \
            _Pragma("unroll") for (int dvb = 0; dvb < 4; ++dvb) _Pragma("unroll") for (int qb = 0; qb < 2; ++qb) \
                O[qb][s_][dvb] = __builtin_amdgcn_mfma_f32_16x16x32_bf16(vfr[dvb], pfr[(g) & 1][qb], O[qb][s_][dvb], 0, 0, 0); } while (0)
        DIFF_QK(0); DIFF_VLOAD(0);
        DIFF_QK(1); DIFF_EXP(0);
        DIFF_QK(2); DIFF_EXP(1); DIFF_PV(0);
        DIFF_QK(3); DIFF_EXP(2); DIFF_PV(1); DIFF_VLOAD(1);
        DIFF_EXP(3); DIFF_PV(2);
        DIFF_PV(3);
#undef DIFF_QK
#undef DIFF_EXP
#undef DIFF_VLOAD
#undef DIFF_PV
    };
    bf16x8 kA = *(const bf16x8*)kaddr(0), vA = *(const bf16x8*)vaddr(0), kB = *(const bf16x8*)kaddr(1), vB = *(const bf16x8*)vaddr(1);
    __syncthreads();
#pragma unroll 1
    for (int t = 0; t < ntiles; t += 2) {
        *(bf16x8*)(Ks + sr * 64 + ((pc ^ ((sr >> 1) & 7)) * 8)) = kA; *(bf16x8*)(Vs + sr * 72 + pc * 8) = vA;
        __syncthreads();
        if (t + 2 < ntiles) { kA = *(const bf16x8*)kaddr(t + 2); vA = *(const bf16x8*)vaddr(t + 2); }
        compute_tile(Ks, Vs);
        *(bf16x8*)(Ks + 64 * 64 + sr * 64 + ((pc ^ ((sr >> 1) & 7)) * 8)) = kB; *(bf16x8*)(Vs + 64 * 72 + sr * 72 + pc * 8) = vB;
        __syncthreads();
        if (t + 3 < ntiles) { kB = *(const bf16x8*)kaddr(t + 3); vB = *(const bf16x8*)vaddr(t + 3); }
        compute_tile(Ks + 64 * 64, Vs + 64 * 72);
    }
    const float lam_init = (layer == 0) ? 0.2f : (0.8f - 0.6f * 0.7408182206817179f);
    float d1 = 0.f, d2 = 0.f;
    if (lane < 32) { d1 = a.in[I_LQ1][layer * 32 + lane] * a.in[I_LK1][layer * 32 + lane]; d2 = a.in[I_LQ2][layer * 32 + lane] * a.in[I_LK2][layer * 32 + lane]; }
    const float lam = expf(wave_sum(d1)) - expf(wave_sum(d2)) + lam_init;
    const float* dnw = a.in[I_DNORM] + layer * 64;
    u16* MIX = (u16*)(a.ws + WS_A);
#pragma unroll
    for (int qb = 0; qb < 2; ++qb) {
        const float l1 = Ls[qb][0][0], l2 = Ls[qb][1][0];
        const float i1 = 1.0f / l1, i2 = lam / l2;
        f32x4 o[4]; float ss = 0.f;
#pragma unroll
        for (int dvb = 0; dvb < 4; ++dvb) { o[dvb] = O[qb][0][dvb] * i1 - O[qb][1][dvb] * i2; ss += (o[dvb][0] * o[dvb][0] + o[dvb][1] * o[dvb][1]) + (o[dvb][2] * o[dvb][2] + o[dvb][3] * o[dvb][3]); }
        ss += __shfl_xor(ss, 16); ss += __shfl_xor(ss, 32);
        const float r = rsqrtf(ss * (1.0f / 64.0f) + 1e-6f) * (1.0f - lam_init);
        const int row = q0row + wave * 32 + qb * 16 + fr;
#pragma unroll
        for (int dvb = 0; dvb < 4; ++dvb) {
            const int v0 = dvb * 16 + fq * 4; const f32x4 nw = *(const f32x4*)(dnw + v0);
            u32x2 w; w.x = pk2(o[dvb][0] * r * nw[0], o[dvb][1] * r * nw[1]); w.y = pk2(o[dvb][2] * r * nw[2], o[dvb][3] * r * nw[3]);
            *(u32x2*)(MIX + (size_t)row * D + 512 + h * 64 + v0) = w;
        }
    }
}

__device__ __forceinline__ void na_wave(const Args& a, int layer, bool ctxq, int wu, int lane) {
    asm volatile("" : "+v"(lane));
    const int fr = lane & 15, fq = lane >> 4;
    const u16* P = (const u16*)(a.ws + WS_X);
    int b, h, r, qblk, qrow;
    if (!ctxq) { qblk = wu & 3; h = (wu >> 2) & 3; r = (wu >> 4) & 255; b = wu >> 12; qrow = b * SEQ + r * 64 + qblk * 16 + fr; }
    else { qblk = wu & 15; h = (wu >> 4) & 3; b = wu >> 6; r = 0; qrow = MX + b * CTXL + qblk * 16 + fr; }
    const int c = qblk * 16 + fr;
    const u16* VTN = (const u16*)(a.ws + WS_VTN) + (size_t)(b * 4 + h) * 64 * NKEY;
    const float C2 = 0.125f * LOG2E;
    bf16x8 qf[2]; float n2 = 0.f;
#pragma unroll
    for (int ks = 0; ks < 2; ++ks) qf[ks] = load_scaled8(P + (size_t)qrow * DPROJ + C_NQ + h * 64 + ks * 32 + fq * 8, C2, n2);
    n2 += __shfl_xor(n2, 16); n2 += __shfl_xor(n2, 32);
    const float km = __uint_as_float(((const unsigned*)(a.ws + WS_CTL))[layer * 64 + 16 + b * 4 + h]);
    const float bmax = ((const float*)(a.ws + WS_MISC))[8192 + layer];
    const float negb = -(sqrtf(n2 * km) + bmax * LOG2E);
    const float* rpb = a.in[I_RPB] + (size_t)(layer * 4 + h) * 15 * 31;
    const int rs = min(max(r - 4, 0), 248), cs = min(max(c - 8, 0), 48);
    f32x4 O[4]; float ls = 0.f;
#pragma unroll
    for (int dvb = 0; dvb < 4; ++dvb) O[dvb] = (f32x4){0.f, 0.f, 0.f, 0.f};
    const int nwh = (qblk == 0 || qblk == 3) ? 1 : 2, nwin = ctxq ? 0 : 8 * nwh, nsteps = nwin + 8;
    struct NaStep { bf16x8 kf[2][2]; s16x4 vlo[4], vhi[4]; float iv[2][4]; };
    auto load_step = [&](int st, NaStep& S) {
        int t, i; bool win;
        if (st < nwin) { win = true; if (nwh == 2) { t = st >> 1; i = st & 1; } else { t = st; i = (qblk == 3) ? 1 : 0; } }
        else { win = false; const int s2 = st - nwin; t = s2 >> 1; i = s2 & 1; }
        const int kr = rs + t;
        const int krow0 = win ? (b * SEQ + kr * 64) : (MX + b * CTXL + t * 64);
        const int key0 = win ? (CTXL + kr * 64) : (t * 64);
#pragma unroll
        for (int kbb = 0; kbb < 2; ++kbb) {
            const int kb = 2 * i + kbb;
#pragma unroll
            for (int ks = 0; ks < 2; ++ks) S.kf[kbb][ks] = *(const bf16x8*)(P + (size_t)(krow0 + kb * 16 + fr) * DPROJ + C_NK + h * 64 + ks * 32 + fq * 8);
#pragma unroll
            for (int j = 0; j < 4; ++j) {
                float iv = negb;
                if (win) { const int kc = kb * 16 + fq * 4 + j; const bool inw = (kc >= cs) && (kc < cs + 16);
                    const int co = min(max(kc - c + 15, 0), 30);
                    const float bias = rpb[(kr - r + 7) * 31 + co];
                    iv = inw ? (bias * LOG2E + negb) : -1e30f; }
                S.iv[kbb][j] = iv;
            }
        }
#pragma unroll
        for (int dvb = 0; dvb < 4; ++dvb) {
            const u16* vp = VTN + (size_t)(dvb * 16 + fr) * NKEY + key0 + (2 * i) * 16 + fq * 4;
            S.vlo[dvb] = *(const s16x4*)vp; S.vhi[dvb] = *(const s16x4*)(vp + 16);
        }
    };
    auto compute_step = [&](const NaStep& S) {
        f32x4 acc[2];
#pragma unroll
        for (int kbb = 0; kbb < 2; ++kbb) {
            acc[kbb] = (f32x4){S.iv[kbb][0], S.iv[kbb][1], S.iv[kbb][2], S.iv[kbb][3]};
#pragma unroll
            for (int ks = 0; ks < 2; ++ks) acc[kbb] = __builtin_amdgcn_mfma_f32_16x16x32_bf16(S.kf[kbb][ks], qf[ks], acc[kbb], 0, 0, 0);
#pragma unroll
            for (int j = 0; j < 4; ++j) acc[kbb][j] = __builtin_amdgcn_exp2f(acc[kbb][j]);
            ls += (acc[kbb][0] + acc[kbb][1]) + (acc[kbb][2] + acc[kbb][3]);
        }
        const bf16x8 pf = pack8(acc[0], acc[1]);
#pragma unroll
        for (int dvb = 0; dvb < 4; ++dvb) {
            const bf16x8 vf = __builtin_shufflevector(S.vlo[dvb], S.vhi[dvb], 0, 1, 2, 3, 4, 5, 6, 7);
            O[dvb] = __builtin_amdgcn_mfma_f32_16x16x32_bf16(vf, pf, O[dvb], 0, 0, 0);
        }
    };
    {
        NaStep SA, SB;
        load_step(0, SA);
#pragma unroll 1
        for (int st = 0; st < nsteps; st += 2) {
            load_step(st + 1, SB);
            compute_step(SA);
            if (st + 2 < nsteps) load_step(st + 2, SA);
            compute_step(SB);
        }
    }
    ls += __shfl_xor(ls, 16); ls += __shfl_xor(ls, 32);
    const float il = 1.0f / ls;
    u16* MIX = (u16*)(a.ws + WS_A);
#pragma unroll
    for (int dvb = 0; dvb < 4; ++dvb) {
        u32x2 w; w.x = pk2(O[dvb][0] * il, O[dvb][1] * il); w.y = pk2(O[dvb][2] * il, O[dvb][3] * il);
        *(u32x2*)(MIX + (size_t)qrow * D + 256 + h * 64 + dvb * 16 + fq * 4) = w;
    }
}


template <int QH> __device__ __forceinline__ void na_unit(const Args& a, int layer, int b, int h, int g, uchar* lds) {
    int tid = threadIdx.x; asm volatile("" : "+v"(tid)); const int lane = tid & 63, wave = __builtin_amdgcn_readfirstlane(tid >> 6), fr = lane & 15, fq = lane >> 4;
    const u16* P = (const u16*)(a.ws + WS_X);
    const u16* VTN = (const u16*)(a.ws + WS_VTN) + (size_t)(b * 4 + h) * 64 * NKEY;
    u16* Ks = (u16*)lds;
    u16* Vs = (u16*)(lds + 2 * 64 * 64 * 2);
    const int r = 8 * g + wave, rsw = min(max(r - 4, 0), 248);
    const float C2 = 0.125f * LOG2E;
    const float km = __uint_as_float(((const unsigned*)(a.ws + WS_CTL))[layer * 64 + 16 + b * 4 + h]);
    const float bmax = ((const float*)(a.ws + WS_MISC))[8192 + layer];
    const float* rpb = a.in[I_RPB] + (size_t)(layer * 4 + h) * 15 * 31;
    bf16x8 qf[2][2]; float negb[2], ls[2];
    unsigned mlo = 0u;
#pragma unroll
    for (int qq = 0; qq < 2; ++qq) {
        const int qblk = 2 * QH + qq;
        const int qrow = b * SEQ + r * 64 + qblk * 16 + fr; float n2 = 0.f;
#pragma unroll
        for (int ks = 0; ks < 2; ++ks) qf[qq][ks] = load_scaled8(P + (size_t)qrow * DPROJ + C_NQ + h * 64 + ks * 32 + fq * 8, C2, n2);
        n2 += __shfl_xor(n2, 16); n2 += __shfl_xor(n2, 32);
        negb[qq] = -(sqrtf(n2 * km) + bmax * LOG2E); ls[qq] = 0.f;
        const int c = qblk * 16 + fr, cs = min(max(c - 8, 0), 48);
#pragma unroll
        for (int kb = 0; kb < 4; ++kb)
#pragma unroll
            for (int j = 0; j < 4; ++j) { const int kc = kb * 16 + fq * 4 + j; const unsigned bit = (kc >= cs && kc < cs + 16) ? 1u : 0u; const int idx = (qq * 4 + kb) * 4 + j;
                mlo |= bit << idx; }
    }
    f32x4 O[2][4];
#pragma unroll
    for (int qq = 0; qq < 2; ++qq)
#pragma unroll
        for (int dvb = 0; dvb < 4; ++dvb) O[qq][dvb] = (f32x4){0.f, 0.f, 0.f, 0.f};
    const int lo = min(max(8 * g - 4, 0), 248), hi = min(max(8 * g + 3, 0), 248) + 7, nwin = hi - lo + 1, ntiles = nwin + 4;
    const int sr = tid >> 3, pc = tid & 7;
    auto kaddr = [&](int t) -> const u16* { const int krow = (t < nwin) ? (b * SEQ + (lo + t) * 64 + sr) : (MX + b * CTXL + (t - nwin) * 64 + sr); return P + (size_t)krow * DPROJ + C_NK + h * 64 + pc * 8; };
    auto vaddr = [&](int t) -> const u16* { const int key0 = (t < nwin) ? (CTXL + (lo + t) * 64) : ((t - nwin) * 64); return VTN + (size_t)sr * NKEY + key0 + pc * 8; };
    bf16x8 kreg = *(const bf16x8*)kaddr(0), vreg = *(const bf16x8*)vaddr(0);
    __syncthreads();
#pragma unroll 1
    for (int t = 0; t < ntiles; ++t) {
        u16* Kb = Ks + (t & 1) * 64 * 64; u16* Vb = Vs + (t & 1) * 64 * 72;
        *(bf16x8*)(Kb + sr * 64 + ((pc ^ ((sr >> 1) & 7)) * 8)) = kreg; *(bf16x8*)(Vb + sr * 72 + pc * 8) = vreg;
        __syncthreads();
        if (t + 1 < ntiles) { kreg = *(const bf16x8*)kaddr(t + 1); vreg = *(const bf16x8*)vaddr(t + 1); }
        const bool win = t < nwin; const int kr = lo + t;
        if (win && (kr < rsw || kr > rsw + 7)) continue;
        float bl[3][4];
        if (win) {
#pragma unroll
            for (int dl = 0; dl < 3; ++dl)
#pragma unroll
                for (int j = 0; j < 4; ++j) { const int co = min(max(16 * (dl - 1) + fq * 4 + j - fr + 15, 0), 30); bl[dl][j] = rpb[(kr - r + 7) * 31 + co] * LOG2E; }
        }
#pragma unroll
        for (int i = 0; i < 2; ++i) {
            bf16x8 kf[2][2], vf[4];
#pragma unroll
            for (int kbb = 0; kbb < 2; ++kbb)
#pragma unroll
                for (int ks = 0; ks < 2; ++ks) kf[kbb][ks] = *(const bf16x8*)(Kb + ((2 * i + kbb) * 16 + fr) * 64 + (((ks * 4 + fq) ^ (fr >> 1)) * 8));
#pragma unroll
            for (int dvb = 0; dvb < 4; ++dvb) { const u16* vp = Vb + (dvb * 16 + fr) * 72 + (2 * i) * 16 + fq * 4;
                const s16x4 vlo = *(const s16x4*)vp, vhi = *(const s16x4*)(vp + 16); vf[dvb] = __builtin_shufflevector(vlo, vhi, 0, 1, 2, 3, 4, 5, 6, 7); }
#pragma unroll
            for (int qq = 0; qq < 2; ++qq) {
                const int qblk = 2 * QH + qq;
                if (win && ((qblk == 0 && i == 1) || (qblk == 3 && i == 0))) continue;
                f32x4 p[2];
#pragma unroll
                for (int kbb = 0; kbb < 2; ++kbb) {
                    const int kb = 2 * i + kbb, dl = kb - qblk;
                    if (win && (dl < -1 || dl > 1)) { p[kbb] = (f32x4){0.f, 0.f, 0.f, 0.f}; continue; }
                    f32x4 acc;
#pragma unroll
                    for (int j = 0; j < 4; ++j) {
                        float iv = negb[qq];
                        if (win) { const int idx = (qq * 4 + kb) * 4 + j; const bool inw = (mlo >> idx) & 1u;
                            iv = inw ? (bl[(dl + 1) < 0 ? 0 : ((dl + 1) > 2 ? 2 : (dl + 1))][j] + negb[qq]) : -1e30f; }
                        acc[j] = iv;
                    }
#pragma unroll
                    for (int ks = 0; ks < 2; ++ks) acc = __builtin_amdgcn_mfma_f32_16x16x32_bf16(kf[kbb][ks], qf[qq][ks], acc, 0, 0, 0);
#pragma unroll
                    for (int j = 0; j < 4; ++j) acc[j] = __builtin_amdgcn_exp2f(acc[j]);
                    ls[qq] += (acc[0] + acc[1]) + (acc[2] + acc[3]);
                    p[kbb] = acc;
                }
                const bf16x8 pf = pack8(p[0], p[1]);
#pragma unroll
                for (int dvb = 0; dvb < 4; ++dvb) O[qq][dvb] = __builtin_amdgcn_mfma_f32_16x16x32_bf16(vf[dvb], pf, O[qq][dvb], 0, 0, 0);
            }
        }
    }
    u16* MIX = (u16*)(a.ws + WS_A);
#pragma unroll
    for (int qq = 0; qq < 2; ++qq) {
        const int qblk = 2 * QH + qq;
        float l = ls[qq]; l += __shfl_xor(l, 16); l += __shfl_xor(l, 32);
        const float il = 1.0f / l; const int qrow = b * SEQ + r * 64 + qblk * 16 + fr;
#pragma unroll
        for (int dvb = 0; dvb < 4; ++dvb) {
            u32x2 w; w.x = pk2(O[qq][dvb][0] * il, O[qq][dvb][1] * il); w.y = pk2(O[qq][dvb][2] * il, O[qq][dvb][3] * il);
            *(u32x2*)(MIX + (size_t)qrow * D + 256 + h * 64 + dvb * 16 + fq * 4) = w;
        }
    }
}


#ifndef PROBE_DIFF
#define PROBE_DIFF 1
#endif
#ifndef PROBE_NA
#define PROBE_NA 1
#endif
#ifndef PROBE_G13
#define PROBE_G13 1
#endif
#ifndef PROBE_G1
#define PROBE_G1 1
#endif
#ifndef PROBE_PREP
#define PROBE_PREP 1
#endif
#ifndef PROBE_SYNC
#define PROBE_SYNC 0
#endif
#ifndef PROBE_CONV
#define PROBE_CONV 1
#endif
#ifndef PROBE_G3
#define PROBE_G3 1
#endif
#ifndef PROBE_NORM
#define PROBE_NORM 1
#endif
template <int PHMASK, int PH> __device__ __forceinline__ void phase_body(const Args& a, unsigned char* lds) {
    int tid = threadIdx.x; asm volatile("" : "+v"(tid)); const int lane = tid & 63, wave = __builtin_amdgcn_readfirstlane(tid >> 6), G = gridDim.x, bid = blockIdx.x;
    u16* const Abuf = (u16*)(a.ws + WS_A);
    u16* const Xbuf = (u16*)(a.ws + WS_X);
    if constexpr (PH == 0) { if constexpr ((PHMASK & 1) != 0) for (int rep = 0; rep < PROBE_PREP; ++rep) phase_prep(a, lds); }
    else if constexpr (PH == NPHASE - 1) { if constexpr ((PHMASK & 2) != 0) phase_final(a); }
    else {
        constexpr int layer = (PH - 1) / 12, sp = (PH - 1) % 12;
        constexpr bool last = (layer == 1);
        constexpr int Mpost = last ? MX : MT;
        if constexpr (sp == 0) { if constexpr ((PHMASK & 2) != 0) for (int rep = 0; rep < PROBE_NORM; ++rep) phase_norm(a, layer, 0, MT, layer == 0); }
        if constexpr (sp == 3) { if constexpr ((PHMASK & 2) != 0) for (int rep = 0; rep < PROBE_NORM; ++rep) phase_norm(a, layer, 1, MT, false); }
        if constexpr (sp == 9) { if constexpr ((PHMASK & 2) != 0) for (int rep = 0; rep < PROBE_NORM; ++rep) phase_norm(a, layer, 2, Mpost, false); }
        if constexpr ((sp == 1 || sp == 10) && (PHMASK & 4)) {
            const int M = (sp == 1) ? MT : Mpost;
            pg8::Gemm g{Abuf, (const u16*)(a.ws + WS_W13) + (size_t)(layer * 2 + (sp == 1 ? 0 : 1)) * 2 * DFF * D, M, 2 * DFF, D};
            pg8::StaticOrder S; S.init(M, 2 * DFF, G, bid);
            EpiSwiglu E{Xbuf};
            for (int rep = 0; rep < PROBE_G13; ++rep) pg8::gemm_phase<EpiSwiglu, pg8::StaticOrder, true, true>((LAS unsigned char*)lds, g, S, E);
        }
        if constexpr ((sp == 2 || sp == 11) && (PHMASK & 4)) {
            const int M = (sp == 2) ? MT : Mpost;
            pg8::Gemm g{Xbuf, (const u16*)(a.ws + WS_W2) + (size_t)(layer * 2 + (sp == 2 ? 0 : 1)) * D * DFF, M, D, DFF};
            pg8::StaticOrder S; S.init(M, D, G, bid);
            EpiResid E{a.out, (float*)(a.ws + WS_HC), modp(a, layer, 0, sp == 2 ? 2 : 8), 0.5f};
            pg8::gemm_phase<EpiResid, pg8::StaticOrder, true, true>((LAS unsigned char*)lds, g, S, E);
        }
        if constexpr (sp == 4 && (PHMASK & 4)) {
            pg8::Gemm g{Abuf, (const u16*)(a.ws + WS_WIN) + (size_t)layer * NPROJ * D, MT, NPROJ, D};
            pg8::StaticOrder S; S.init(MT, NPROJ, G, bid);
            EpiProj E{Xbuf};
            pg8::gemm_phase<EpiProj, pg8::StaticOrder, true, true>((LAS unsigned char*)lds, g, S, E);
        }
        if constexpr (sp == 5) {
            if constexpr ((PHMASK & 8) != 0) for (int u = bid; u < 2 * NCH; u += G) prep_unit(a, layer, u, lds);
            __syncthreads();
            if constexpr ((PHMASK & 16) != 0) for (int rep = 0; rep < PROBE_G1; ++rep) {
                const int gw = bid * 8 + wave, NGW = G * 8;
                for (int wu = gw; wu < 4096; wu += NGW) {
                    const int dir = wu & 1, h = (wu >> 1) & 3, xc = (wu >> 3) & 255, b = wu >> 11;
                    gla_g1_wave(a, layer, b, xc + 4, h, dir, lds + wave * 16384, lane);
                }
                for (int j = 0; j < 64; ++j) if ((j * 32) % NGW == gw) {
                    const int dir = j & 1, h = (j >> 1) & 3, c = (j >> 3) & 3, b = j >> 5;
                    gla_g1_wave(a, layer, b, c, h, dir, lds + wave * 16384, lane);
                }
            }
            __syncthreads();
            const int ncu = last ? 1024 : 1040;
            if constexpr ((PHMASK & 32) != 0) {
                bf16x8 wf[2][8];
                { const u16* PWT = (const u16*)(a.ws + WS_PWT) + (size_t)layer * 256 * 256; const int fr = lane & 15, fq = lane >> 4;
#pragma unroll
                  for (int nbi = 0; nbi < 2; ++nbi)
#pragma unroll
                    for (int ks = 0; ks < 8; ++ks) wf[nbi][ks] = *(const bf16x8*)(PWT + (size_t)((wave * 2 + nbi) * 16 + fr) * 256 + ks * 32 + fq * 8); }
                for (int rep = 0; rep < PROBE_CONV; ++rep) for (int u = bid; u < ncu; u += G) conv_unit(a, layer, u, lds, wf);
            }
        }
        if constexpr (sp == 6) {
            if constexpr ((PHMASK & 64) != 0) gla_scan(a, lds);
            if constexpr ((PHMASK & 128) != 0) for (int rep = 0; rep < PROBE_NA; ++rep) for (int u = bid; u < 512; u += G) { const int uu = u >> 1; if (u & 1) na_unit<1>(a, layer, uu >> 7, (uu >> 5) & 3, uu & 31, lds); else na_unit<0>(a, layer, uu >> 7, (uu >> 5) & 3, uu & 31, lds); }
            if constexpr ((PHMASK & 128) != 0 && !last) for (int wu = bid * 8 + wave; wu < 2 * 4 * 16; wu += G * 8) na_wave(a, layer, true, wu, lane);
            if constexpr ((PHMASK & 256) != 0) for (int rep = 0; rep < PROBE_DIFF; ++rep) for (int u = bid; u < 512; u += G) { const int b = u >> 8, h = (u >> 6) & 3, qb = u & 63; diff_unit(a, layer, b, h, b * SEQ + qb * 256, NCH, lds); }
            if constexpr ((PHMASK & 256) != 0 && !last) for (int u = bid; u < 8; u += G) { const int b = u >> 2, h = u & 3; diff_unit(a, layer, b, h, MX + b * CTXL, 4, lds); }
        }
        if constexpr (sp == 7) {
            __syncthreads();
            if constexpr ((PHMASK & 512) != 0) for (int rep = 0; rep < PROBE_G3; ++rep) for (int wu = bid * 8 + wave; wu < 2 * NCH * 4; wu += G * 8) { const int c = (wu >> 2) % NCH; if (last && c < 4) continue; gla_g3_wave(a, layer, wu, lds + wave * 16384, lane); }
        }
        if constexpr (sp == 8 && (PHMASK & 4)) {
            pg8::Gemm g{Abuf, (const u16*)(a.ws + WS_WOUT) + (size_t)layer * D * D, Mpost, D, D};
            pg8::StaticOrder S; S.init(Mpost, D, G, bid);
            EpiResid E{a.out, (float*)(a.ws + WS_HC), modp(a, layer, 0, 5), 1.0f};
            pg8::gemm_phase<EpiResid, pg8::StaticOrder, true, true>((LAS unsigned char*)lds, g, S, E);
        }
    }
}
template <int PHMASK, int PH> __device__ __forceinline__ void run_phase(const Args& a, int lo, int hi, unsigned char* lds, cg::grid_group& grid, const XcdBarrier& bar) {
    if (lo <= PH && PH < hi) { if (PH > lo) { if (PH == lo + 1) grid.sync(); else xcd_barrier(bar); } phase_body<PHMASK, PH>(a, lds); }
}
template <int PHMASK> __device__ __forceinline__ void run_phases(const Args& a, unsigned char* lds) {
    cg::grid_group grid = cg::this_grid();
    const int lo = a.ph_lo, hi = a.ph_hi;
    volatile LAS unsigned* st = (volatile LAS unsigned*)((LAS unsigned char*)lds + 131072);
    if (threadIdx.x < 2) st[threadIdx.x] = 0u;
    __syncthreads();
    const XcdBarrier bar = xcd_barrier_post((unsigned*)(a.ws + WS_CTL) + 16384, st);
#define RP(k) run_phase<PHMASK, k>(a, lo, hi, lds, grid, bar);
    RP(0) RP(1) RP(2) RP(3) RP(4) RP(5) RP(6) RP(7) RP(8) RP(9) RP(10) RP(11) RP(12) RP(13) RP(14) RP(15) RP(16) RP(17) RP(18) RP(19) RP(20) RP(21) RP(22) RP(23) RP(24) RP(25)
#undef RP
}
extern __shared__ __attribute__((aligned(16))) unsigned char dyn_lds[];
template <int PM> __global__ void __launch_bounds__(512, 2) part_fwd(Args a) { run_phases<PM>(a, dyn_lds); }
#ifndef MK_PER_PHASE
#define MK_PER_PHASE 0
#endif
#if !MK_PER_PHASE
__global__ void __launch_bounds__(512, 2) mega_fwd(Args a) { run_phases<0xFFFF>(a, dyn_lds); }
#define MAIN_KERNEL mega_fwd
#else
#define MAIN_KERNEL part_fwd<4>
#endif
#ifndef MK_PER_PHASE
#define MK_PER_PHASE 0
#endif
extern "C" void kernel_launch(void* const* d_in, const int* in_sizes, int n_in, void* d_out, int out_size, void* d_ws, size_t ws_size, hipStream_t stream) {
    static int grid = 0;
    if (grid == 0) {
        if (n_in != 33 || ws_size < WS_END) { fprintf(stderr, "kernel_launch: unexpected n_in %d / ws_size %zu (need %zu)\n", n_in, ws_size, (size_t)WS_END); grid = -1; return; }
        int dev = 0, cus = 0, per_cu = 0;
        hipGetDevice(&dev); hipDeviceGetAttribute(&cus, hipDeviceAttributeMultiprocessorCount, dev);
        if (hipFuncSetAttribute((const void*)MAIN_KERNEL, hipFuncAttributeMaxDynamicSharedMemorySize, LDS_BYTES) != hipSuccess) { fprintf(stderr, "kernel_launch: hipFuncSetAttribute failed\n"); grid = -1; return; }
#if MK_PER_PHASE
        (void)hipFuncSetAttribute((const void*)part_fwd<1>, hipFuncAttributeMaxDynamicSharedMemorySize, LDS_BYTES); (void)hipFuncSetAttribute((const void*)part_fwd<2>, hipFuncAttributeMaxDynamicSharedMemorySize, LDS_BYTES);
        (void)hipFuncSetAttribute((const void*)part_fwd<4>, hipFuncAttributeMaxDynamicSharedMemorySize, LDS_BYTES); (void)hipFuncSetAttribute((const void*)part_fwd<56>, hipFuncAttributeMaxDynamicSharedMemorySize, LDS_BYTES);
        (void)hipFuncSetAttribute((const void*)part_fwd<448>, hipFuncAttributeMaxDynamicSharedMemorySize, LDS_BYTES); (void)hipFuncSetAttribute((const void*)part_fwd<512>, hipFuncAttributeMaxDynamicSharedMemorySize, LDS_BYTES);
#endif
        if (hipOccupancyMaxActiveBlocksPerMultiprocessor(&per_cu, (const void*)MAIN_KERNEL, 512, LDS_BYTES) != hipSuccess || per_cu < 1) { fprintf(stderr, "kernel_launch: occupancy query says %d\n", per_cu); per_cu = 1; }
        (void)hipGetLastError();
        grid = cus;
    }
    if (grid < 0) return;
    (void)hipMemsetAsync((char*)d_ws + WS_CTL, 0, 131072, stream);
    Args a{};
    for (int i = 0; i < 33; ++i) a.in[i] = (const float*)d_in[i];
    a.out = (float*)d_out; a.ws = (unsigned char*)d_ws;
#if MK_PER_PHASE
    for (int ph = 0; ph < NPHASE; ++ph) {
        a.ph_lo = ph; a.ph_hi = ph + 1;
        const int sp = (ph == 0 || ph == NPHASE - 1) ? -1 : (ph - 1) % 12;
        if (ph == 0) hipLaunchKernelGGL(part_fwd<1>, dim3(grid), dim3(512), LDS_BYTES, stream, a);
        else if (sp == -1 || sp == 0 || sp == 3 || sp == 9) hipLaunchKernelGGL(part_fwd<2>, dim3(grid), dim3(512), LDS_BYTES, stream, a);
        else if (sp == 5) hipLaunchKernelGGL(part_fwd<56>, dim3(grid), dim3(512), LDS_BYTES, stream, a);
        else if (sp == 6) hipLaunchKernelGGL(part_fwd<448>, dim3(grid), dim3(512), LDS_BYTES, stream, a);
        else if (sp == 7) hipLaunchKernelGGL(part_fwd<512>, dim3(grid), dim3(512), LDS_BYTES, stream, a);
        else hipLaunchKernelGGL(part_fwd<4>, dim3(grid), dim3(512), LDS_BYTES, stream, a);
    }
#else
    a.ph_lo = 0; a.ph_hi = NPHASE;
    void* args[] = {&a};
    hipError_t e = hipLaunchCooperativeKernel((const void*)mega_fwd, dim3(grid), dim3(512), args, LDS_BYTES, stream);
    if (e != hipSuccess) fprintf(stderr, "kernel_launch: cooperative launch failed: %s (grid %d)\n", hipGetErrorString(e), grid);
#endif
}
```

```cpp
#include <hip/hip_runtime.h>
#include <hip/hip_cooperative_groups.h>
#include <cstdio>
#include <cstdint>
namespace cg = cooperative_groups;
#define MK_PER_PHASE 0
namespace pg8 {
#define PG8_LAS __attribute__((address_space(3)))
typedef unsigned short bf16_t;
typedef short bf16x8 __attribute__((ext_vector_type(8)));
typedef float f32x4 __attribute__((ext_vector_type(4)));
typedef unsigned u32x4 __attribute__((ext_vector_type(4)));
constexpr int BM = 256, BK = 64, HALF = 128, HTB = HALF * BK * 2  , STAGE_BYTES = 8 * HTB, NXCD = 8, WGM = 8;

__host__ __device__ __forceinline__ int lds_byte(int r, int c) { const int st = (r >> 4) * 2 + (c >> 5), rr = r & 15, cc = c & 31, ob = rr * 64 + cc * 2; return st * 1024 + (ob ^ (((ob >> 9) & 1) << 5)); }
__host__ __device__ __forceinline__ void stage_rc(int b, int& R, int& C) { const int st = b / 1024, sb = b % 1024, swz = sb ^ (((sb >> 9) & 1) << 5); R = (st >> 1) * 16 + swz / 64; C = (st & 1) * 32 + (swz % 64) / 2; }
__host__ __device__ __forceinline__ int perm32(int rho) { const int n = rho >> 4, i = rho & 15; return 8 * (i >> 2) + 4 * n + (i & 3); }

struct Unit { int pm, pn; };
struct Gemm { const bf16_t* A; const bf16_t* Bt; int M, N, K; };

struct StaticOrder {
    int nM, nN, nwg, G, c;
    __host__ __device__ void init(int M, int N, int G_, int c_) { nM = M / BM; nN = N / BM; nwg = nM * nN; G = G_; c = c_; }
    __host__ __device__ bool next(int i, Unit& u) const {
        const long L = (long)i * G + c; if (L >= nwg) return false;
        int wgid = (int)L; { const int q = nwg / NXCD, r = nwg % NXCD, xcd = wgid % NXCD, off = wgid / NXCD; wgid = (xcd < r ? xcd * (q + 1) : r * (q + 1) + (xcd - r) * q) + off; }
        const int nig = WGM * nN, gid = wgid / nig, fm = gid * WGM, gsz = (nM - fm) < WGM ? (nM - fm) : WGM;
        u.pm = fm + ((wgid % nig) % gsz); u.pn = (wgid % nig) / gsz; return true;
    }
    __device__ __forceinline__ void a_ready(const Unit&) const {}
    __device__ __forceinline__ void done(const Unit&) const {}
};

__device__ __forceinline__ unsigned cvt_pk_bf16(float lo, float hi) { unsigned r; asm volatile("v_cvt_pk_bf16_f32 %0, %1, %2" : "=v"(r) : "v"(lo), "v"(hi)); return r; }
template <class Epi, class Sched, bool ALIGN_EPI = false, bool SP2 = false>
__device__ __forceinline__ void gemm_phase(PG8_LAS unsigned char* lds, const Gemm g, const Sched& S, const Epi& E) {
    int tid_l = threadIdx.x; asm volatile("" : "+v"(tid_l)); const int tid = tid_l, wid = __builtin_amdgcn_readfirstlane(tid >> 6), lane = tid & 63, wr = wid >> 2, wc = wid & 3, fr = lane & 15, fq = lane >> 4;
    const int K = g.K, nt = K / BK;
    unsigned voffA[2], voffB[2];
#pragma unroll
    for (int i = 0; i < 2; ++i) { int R, C; stage_rc(tid * 16 + i * 8192, R, C); const int Rb = Epi::PERM ? ((R & ~31) + perm32(R & 31)) : R;
        voffA[i] = (unsigned)(R * K + C) * 2u; voffB[i] = (unsigned)(Rb * K + C) * 2u; }
    const size_t kstep = (size_t)(BK * 2);
    const size_t hstep = (size_t)HALF * K * 2;
    const size_t tstep = 2 * hstep;
    const unsigned ldsw = (unsigned)wid * 1024u;
    const int aoff = lds_byte(wr * 64 + fr, fq * 8), boff = lds_byte(wc * 32 + fr, fq * 8);
#define PG8_SA(b, h) (((b) * 2 + (h)) * HTB)
#define PG8_SB(b, h) ((4 + (b) * 2 + (h)) * HTB)
#define PG8_STAGE(bufoff, gbase, voff) do { _Pragma("unroll") for (int _i = 0; _i < 2; ++_i) \
        __builtin_amdgcn_global_load_lds((const unsigned*)((const char*)(gbase) + (voff)[_i]), (PG8_LAS unsigned*)(lds + (bufoff) + ldsw + _i * 8192), 16, 0, 0); } while (0)
#define PG8_LDA(dst, b, h) do { _Pragma("unroll") for (int m = 0; m < 4; ++m) _Pragma("unroll") for (int k = 0; k < 2; ++k) dst[m][k] = *(const PG8_LAS bf16x8*)(lds + PG8_SA(b, h) + aoff + m * 2048 + k * 1024); } while (0)
#define PG8_LDB(dst, b, h) do { _Pragma("unroll") for (int n = 0; n < 2; ++n) _Pragma("unroll") for (int k = 0; k < 2; ++k) dst[n][k] = *(const PG8_LAS bf16x8*)(lds + PG8_SB(b, h) + boff + n * 2048 + k * 1024); } while (0)
#define PG8_MMA(ai, bj, At, Bt) do { __builtin_amdgcn_s_setprio(1); _Pragma("unroll") for (int m = 0; m < 4; ++m) _Pragma("unroll") for (int n = 0; n < 2; ++n) _Pragma("unroll") for (int k = 0; k < 2; ++k) \
        acc[ai][bj][m][n] = __builtin_amdgcn_mfma_f32_16x16x32_bf16(Bt[n][k], At[m][k], acc[ai][bj][m][n], 0, 0, 0); __builtin_amdgcn_s_setprio(0); } while (0)
#define PG8_WAIT_V(n) asm volatile("s_waitcnt vmcnt(" #n ")" ::: "memory")
#define PG8_WAIT_L(n) asm volatile("s_waitcnt lgkmcnt(" #n ")" ::: "memory")
#define PG8_BAR __builtin_amdgcn_s_barrier()
#define PG8_SCHED __builtin_amdgcn_sched_barrier(0)
    Unit cur, nxt; int ui = 0;
    if (!S.next(0, cur)) return;
    f32x4 acc[2][2][4][2];
#pragma unroll
    for (int a = 0; a < 2; ++a)
#pragma unroll
        for (int b = 0; b < 2; ++b)
#pragma unroll
            for (int m = 0; m < 4; ++m)
#pragma unroll
                for (int n = 0; n < 2; ++n) acc[a][b][m][n] = (f32x4){0.f, 0.f, 0.f, 0.f};
    bf16x8 At[4][2], B0[2][2], B1[2][2];
    const char* cA = (const char*)g.A + (size_t)cur.pm * tstep; const char* cB = (const char*)g.Bt + (size_t)cur.pn * tstep;
    S.a_ready(cur);
    if constexpr (SP2) {
        PG8_STAGE(PG8_SB(0, 0), cB, voffB); PG8_STAGE(PG8_SB(0, 1), cB + hstep, voffB); PG8_STAGE(PG8_SA(0, 0), cA, voffA); PG8_STAGE(PG8_SA(0, 1), cA + hstep, voffA);
        if (wr == 1) PG8_BAR;
        PG8_WAIT_V(2); PG8_BAR;
        PG8_STAGE(PG8_SB(1, 0), cB + kstep, voffB); PG8_STAGE(PG8_SA(1, 0), cA + kstep, voffA); PG8_STAGE(PG8_SB(1, 1), cB + hstep + kstep, voffB);
        PG8_WAIT_V(6); PG8_BAR;
    } else {
        PG8_STAGE(PG8_SB(0, 0), cB, voffB); PG8_STAGE(PG8_SA(0, 0), cA, voffA); PG8_STAGE(PG8_SB(0, 1), cB + hstep, voffB); PG8_STAGE(PG8_SA(0, 1), cA + hstep, voffA);
        if (wr == 1) PG8_BAR;
        PG8_WAIT_V(4); PG8_BAR;
        PG8_STAGE(PG8_SB(1, 0), cB + kstep, voffB); PG8_STAGE(PG8_SA(1, 0), cA + kstep, voffA); PG8_STAGE(PG8_SB(1, 1), cB + hstep + kstep, voffB);
        PG8_WAIT_V(6); PG8_BAR;
    }
    for (;;) {
        const bool has_next = S.next(ui + 1, nxt);
        const char* nA = has_next ? (const char*)g.A + (size_t)nxt.pm * tstep : cA; const char* nB = has_next ? (const char*)g.Bt + (size_t)nxt.pn * tstep : cB;
        for (int t = 0; t < nt; t += 2) {
            const bool last = (t == nt - 2);
            const char* a1 = cA + (size_t)(t + 1) * kstep;
            const char* a2 = last ? nA : cA + (size_t)(t + 2) * kstep; const char* b2 = last ? nB : cB + (size_t)(t + 2) * kstep;
            const char* a3 = a2 + kstep; const char* b3 = b2 + kstep;
            if (last && has_next) S.a_ready(nxt);
            if constexpr (SP2) {
            PG8_LDB(B0, 0, 0); PG8_LDB(B1, 0, 1); PG8_SCHED; PG8_LDA(At, 0, 0); PG8_STAGE(PG8_SA(1, 1), a1 + hstep, voffA);
            PG8_WAIT_V(8); PG8_WAIT_L(0); PG8_BAR; PG8_MMA(0, 0, At, B0); PG8_MMA(0, 1, At, B1); PG8_BAR; PG8_SCHED;
            PG8_LDA(At, 0, 1); PG8_STAGE(PG8_SB(0, 0), b2, voffB); PG8_STAGE(PG8_SB(0, 1), b2 + hstep, voffB); PG8_STAGE(PG8_SA(0, 0), a2, voffA);
            PG8_WAIT_V(8); PG8_WAIT_L(0); PG8_BAR; PG8_MMA(1, 0, At, B0); PG8_MMA(1, 1, At, B1); PG8_BAR; PG8_SCHED;
            PG8_LDB(B0, 1, 0); PG8_LDB(B1, 1, 1); PG8_SCHED; PG8_LDA(At, 1, 0); PG8_STAGE(PG8_SA(0, 1), a2 + hstep, voffA);
            PG8_WAIT_V(8); PG8_WAIT_L(0); PG8_BAR; PG8_MMA(0, 0, At, B0); PG8_MMA(0, 1, At, B1); PG8_BAR; PG8_SCHED;
            PG8_LDA(At, 1, 1); PG8_STAGE(PG8_SB(1, 0), b3, voffB); PG8_STAGE(PG8_SB(1, 1), b3 + hstep, voffB); PG8_STAGE(PG8_SA(1, 0), a3, voffA);
            PG8_WAIT_V(8); PG8_WAIT_L(0); PG8_BAR; PG8_MMA(1, 0, At, B0); PG8_MMA(1, 1, At, B1); PG8_BAR; PG8_SCHED;
            } else {
            PG8_LDB(B0, 0, 0); PG8_SCHED; PG8_LDA(At, 0, 0); PG8_STAGE(PG8_SA(1, 1), a1 + hstep, voffA);
            PG8_WAIT_L(8); PG8_BAR; PG8_WAIT_L(0); PG8_MMA(0, 0, At, B0); PG8_BAR; PG8_SCHED;
            PG8_LDB(B1, 0, 1); PG8_STAGE(PG8_SB(0, 0), b2, voffB);
            PG8_BAR; PG8_WAIT_L(0); PG8_MMA(0, 1, At, B1); PG8_BAR;
            PG8_LDA(At, 0, 1); PG8_STAGE(PG8_SA(0, 0), a2, voffA);
            PG8_BAR; PG8_WAIT_L(0); PG8_MMA(1, 0, At, B0); PG8_BAR; PG8_SCHED;
            PG8_STAGE(PG8_SB(0, 1), b2 + hstep, voffB);
            PG8_WAIT_V(6); PG8_BAR; PG8_MMA(1, 1, At, B1); PG8_BAR;
            PG8_LDB(B0, 1, 0); PG8_SCHED; PG8_LDA(At, 1, 0); PG8_STAGE(PG8_SA(0, 1), a2 + hstep, voffA);
            PG8_WAIT_L(8); PG8_BAR; PG8_WAIT_L(0); PG8_MMA(0, 0, At, B0); PG8_BAR; PG8_SCHED;
            PG8_LDB(B1, 1, 1); PG8_STAGE(PG8_SB(1, 0), b3, voffB);
            PG8_BAR; PG8_WAIT_L(0); PG8_MMA(0, 1, At, B1); PG8_BAR;
            PG8_LDA(At, 1, 1); PG8_STAGE(PG8_SA(1, 0), a3, voffA);
            PG8_BAR; PG8_WAIT_L(0); PG8_MMA(1, 0, At, B0); PG8_BAR; PG8_SCHED;
            PG8_STAGE(PG8_SB(1, 1), b3 + hstep, voffB);
            PG8_WAIT_V(6); PG8_BAR; PG8_MMA(1, 1, At, B1); PG8_BAR;
            }
        }
        if constexpr (ALIGN_EPI) { if (wr == 0) PG8_BAR; }
        if constexpr (!Epi::AFTER_DRAIN) { E(acc, cur, wr, wc, fr, fq); S.done(cur); }
        if (!has_next) break;
#pragma unroll
        for (int a = 0; a < 2; ++a)
#pragma unroll
            for (int b = 0; b < 2; ++b)
#pragma unroll
                for (int m = 0; m < 4; ++m)
#pragma unroll
                    for (int n = 0; n < 2; ++n) acc[a][b][m][n] = (f32x4){0.f, 0.f, 0.f, 0.f};
        cur = nxt; cA = nA; cB = nB; ++ui;
        if constexpr (ALIGN_EPI) { if (wr == 1) PG8_BAR; }
    }
    PG8_WAIT_V(0);
    if constexpr (!ALIGN_EPI) { if (wr == 0) PG8_BAR; }
    PG8_BAR;
    if constexpr (Epi::AFTER_DRAIN) { E.fused(acc, cur, wr, wc, fr, fq, lds, wid, lane); S.done(cur); }
#undef PG8_SA
#undef PG8_SB
#undef PG8_STAGE
#undef PG8_LDA
#undef PG8_LDB
#undef PG8_MMA
#undef PG8_WAIT_V
#undef PG8_WAIT_L
#undef PG8_BAR
#undef PG8_SCHED
}
}

#define LAS __attribute__((address_space(3)))
typedef unsigned short u16;
typedef unsigned char uchar;
typedef short bf16x8 __attribute__((ext_vector_type(8)));
typedef short s16x4 __attribute__((ext_vector_type(4)));
typedef float f32x4 __attribute__((ext_vector_type(4)));
typedef unsigned u32x4 __attribute__((ext_vector_type(4)));
typedef unsigned u32x2 __attribute__((ext_vector_type(2)));

constexpr int D = 1024, SEQ = 16384, CTXL = 256, DFF = 2816, DPROJ = 2848, NPROJ = 3072;
constexpr int MX = 2 * SEQ, MC = 2 * CTXL, MT = MX + MC;
constexpr int NKEY = CTXL + SEQ, NCH = NKEY / 64;
constexpr int C_GQ = 0, C_GK = 128, C_GV = 256, C_GG = 512, C_AF = 768, C_NQ = 800, C_NK = 1056, C_NV = 1312, C_DQ = 1568, C_DK = 1824, C_DV = 2080, C_CA = 2336, C_CG = 2592;
constexpr float LOG2E = 1.4426950408889634f;

constexpr size_t MiB = 1u << 20;
constexpr size_t WS_CTL = 0, WS_MOD = 1 * MiB, WS_MISC = 1 * MiB + 512 * 1024, WS_HC = 2 * MiB, WS_PWT = 4 * MiB, WS_W13 = 8 * MiB, WS_W2 = 52 * MiB, WS_WIN = 74 * MiB,
                 WS_WOUT = 86 * MiB, WS_A = 90 * MiB, WS_X = 155 * MiB, WS_VTD = 336 * MiB, WS_VTN = 353 * MiB, WS_U = 370 * MiB, WS_DEC = 403 * MiB, WS_BC = 404 * MiB, WS_END = 437 * MiB;
constexpr int LDS_BYTES = 131072 + 256;
constexpr int NPHASE = 26;

struct Args { const float* in[33]; float* out; unsigned char* ws; int ph_lo, ph_hi; };

enum { I_X = 0, I_C, I_CTX, I_CCTX, I_ADAW, I_ADAB, I_NF1, I_F1W13, I_F1W2, I_NMIX, I_WIN, I_WAF, I_BAF, I_WAB, I_BAB, I_GNORM, I_RPB, I_LQ1, I_LK1, I_LQ2, I_LK2, I_DNORM,
       I_CDW, I_CDWB, I_CLNG, I_CLNB, I_CPW, I_CPWB, I_WOUT, I_NF2, I_F2W13, I_F2W2, I_FNORM };

__device__ __forceinline__ float bf2f(unsigned short h) { return __uint_as_float(((unsigned)h) << 16); }
__device__ __forceinline__ unsigned short f2bf(float f) { unsigned u = __float_as_uint(f); return (unsigned short)((u + 0x7fffu + ((u >> 16) & 1u)) >> 16); }
__device__ __forceinline__ unsigned pk2(float lo, float hi) { return (unsigned)f2bf(lo) | ((unsigned)f2bf(hi) << 16); }
__device__ __forceinline__ float wave_sum(float v) {
#pragma unroll
    for (int o = 1; o < 64; o <<= 1) v += __shfl_xor(v, o);
    return v;
}
__device__ __forceinline__ float silu_f(float x) { return x * __builtin_amdgcn_rcpf(1.0f + __expf(-x)); }
#define WAVE_SYNC() do { asm volatile("s_waitcnt lgkmcnt(0)" ::: "memory"); __builtin_amdgcn_wave_barrier(); } while (0)
__device__ __forceinline__ int row_of(int b, int c, int tk) { return (c < 4) ? (MX + b * CTXL + c * 64 + tk) : (b * SEQ + (c - 4) * 64 + tk); }
__device__ __forceinline__ float* hrow(const Args& a, int row) { return (row < MX) ? (a.out + (size_t)row * D) : ((float*)(a.ws + WS_HC) + (size_t)(row - MX) * D); }
__device__ __forceinline__ const float* modp(const Args& a, int layer, int g, int j) { return (const float*)(a.ws + WS_MOD) + ((size_t)(layer * 3 + g) * 9 + j) * D; }

struct EpiSwiglu {
    static constexpr bool PERM = true, AFTER_DRAIN = false;
    u16* O;
    __device__ __forceinline__ void operator()(const f32x4 (&acc)[2][2][4][2], const pg8::Unit& u, int wr, int wc, int fr, int fq) const {
        const int row0 = u.pm * 256 + wr * 64 + fr, col0 = u.pn * 128 + wc * 32 + 8 * fq;
#pragma unroll
        for (int ai = 0; ai < 2; ++ai)
#pragma unroll
            for (int m = 0; m < 4; ++m) {
                u16* rowp = O + (size_t)(row0 + ai * 128 + m * 16) * DFF + col0;
                const f32x4 a0 = acc[ai][0][m][0], a1 = acc[ai][0][m][1], u0 = acc[ai][1][m][0], u1 = acc[ai][1][m][1];
                float h[8];
#pragma unroll
                for (int e = 0; e < 4; ++e) { h[e] = silu_f(a0[e]) * u0[e]; h[4 + e] = silu_f(a1[e]) * u1[e]; }
                u32x4 w; w.x = pg8::cvt_pk_bf16(h[0], h[1]); w.y = pg8::cvt_pk_bf16(h[2], h[3]); w.z = pg8::cvt_pk_bf16(h[4], h[5]); w.w = pg8::cvt_pk_bf16(h[6], h[7]);
                *(u32x4*)rowp = w;
            }
    }
};
struct EpiResid {
    static constexpr bool PERM = false, AFTER_DRAIN = false;
    float* hx; float* hc; const float* gate0;
    float coef;
    __device__ __forceinline__ void operator()(const f32x4 (&acc)[2][2][4][2], const pg8::Unit& u, int wr, int wc, int fr, int fq) const {
        const int g = u.pm < 64 ? 0 : (u.pm < 128 ? 1 : 2);
        float* base = (u.pm < 128) ? (hx + (size_t)u.pm * 256 * D) : (hc + (size_t)(u.pm - 128) * 256 * D);
        const int row0 = wr * 64 + fr, col0 = u.pn * 256 + wc * 32 + 4 * fq;
        const float* gate = gate0 + (size_t)g * 9 * D;
        f32x4 gv[2][2];
#pragma unroll
        for (int bj = 0; bj < 2; ++bj)
#pragma unroll
            for (int n = 0; n < 2; ++n) gv[bj][n] = *(const f32x4*)(gate + col0 + bj * 128 + n * 16) * coef;
#pragma unroll
        for (int ai = 0; ai < 2; ++ai)
#pragma unroll
            for (int m = 0; m < 4; ++m) {
                float* rowp = base + (size_t)(row0 + ai * 128 + m * 16) * D + col0;
#pragma unroll
                for (int bj = 0; bj < 2; ++bj)
#pragma unroll
                    for (int n = 0; n < 2; ++n) { f32x4* p = (f32x4*)(rowp + bj * 128 + n * 16); *p = *p + gv[bj][n] * acc[ai][bj][m][n]; }
            }
    }
};
struct EpiProj {
    static constexpr bool PERM = true, AFTER_DRAIN = false;
    u16* O;
    __device__ __forceinline__ void operator()(const f32x4 (&acc)[2][2][4][2], const pg8::Unit& u, int wr, int wc, int fr, int fq) const {
        const int row0 = u.pm * 256 + wr * 64 + fr, col0 = u.pn * 256 + wc * 32 + 8 * fq;
#pragma unroll
        for (int ai = 0; ai < 2; ++ai)
#pragma unroll
            for (int m = 0; m < 4; ++m) {
                u16* rowp = O + (size_t)(row0 + ai * 128 + m * 16) * DPROJ;
#pragma unroll
                for (int bj = 0; bj < 2; ++bj) {
                    const int col = col0 + bj * 128;
                    if (col < DPROJ) {
                        const f32x4 v0 = acc[ai][bj][m][0], v1 = acc[ai][bj][m][1];
                        u32x4 w; w.x = pg8::cvt_pk_bf16(v0[0], v0[1]); w.y = pg8::cvt_pk_bf16(v0[2], v0[3]); w.z = pg8::cvt_pk_bf16(v1[0], v1[1]); w.w = pg8::cvt_pk_bf16(v1[2], v1[3]);
                        *(u32x4*)(rowp + col) = w;
                    }
                }
            }
    }
};

__device__ __forceinline__ void transpose_item(const float* W, int N, u16* WT, int K, int k0, int n0, int drow0, float* scr, int lane) {
    float wv[32];
#pragma unroll
    for (int i = 0; i < 32; ++i) { const int kk = 2 * i + (lane >> 5); wv[i] = W[(size_t)(k0 + kk) * N + n0 + (lane & 31)]; }
#pragma unroll
    for (int i = 0; i < 32; ++i) { const int kk = 2 * i + (lane >> 5); scr[kk * 33 + (lane & 31)] = wv[i]; }
    WAVE_SYNC();
    const int c = lane & 7;
#pragma unroll
    for (int j = 0; j < 4; ++j) {
        const int n = (lane >> 3) + 8 * j; const float* s = scr + (8 * c) * 33 + n;
        u32x4 o; o.x = pk2(s[0 * 33], s[1 * 33]); o.y = pk2(s[2 * 33], s[3 * 33]); o.z = pk2(s[4 * 33], s[5 * 33]); o.w = pk2(s[6 * 33], s[7 * 33]);
        *(u32x4*)(WT + (size_t)(drow0 + n) * K + k0 + 8 * c) = o;
    }
    WAVE_SYNC();
}

__device__ __forceinline__ void phase_prep(const Args& a, uchar* lds) {
    int tid = threadIdx.x; asm volatile("" : "+v"(tid)); const int lane = tid & 63, wave = tid >> 6, G = gridDim.x, bid = blockIdx.x;
    {
        float* sc = (float*)lds;
        float* red = sc + 3 * D;
        float* mod = (float*)(a.ws + WS_MOD);
        for (int i = tid; i < 3 * D; i += 512) { const int g = i >> 10, k = i & 1023; const float v = (g < 2) ? a.in[I_C][g * D + k] : a.in[I_CCTX][k]; sc[i] = silu_f(v); }
        __syncthreads();
        for (int u = bid; u < 2 * 144; u += G) {
            const int l = u / 144, cgp = u % 144, kc = tid >> 6, col = tid & 63;
            const float* w = a.in[I_ADAW] + ((size_t)l * D + kc * 128) * 9216 + cgp * 64 + col;
            float a0 = 0.f, a1 = 0.f, a2 = 0.f;
#pragma unroll 32
            for (int kk = 0; kk < 128; ++kk) { const float wv = w[(size_t)kk * 9216]; const int k = kc * 128 + kk; a0 += sc[k] * wv; a1 += sc[D + k] * wv; a2 += sc[2 * D + k] * wv; }
            red[(kc * 3 + 0) * 64 + col] = a0; red[(kc * 3 + 1) * 64 + col] = a1; red[(kc * 3 + 2) * 64 + col] = a2;
            __syncthreads();
            if (tid < 192) {
                const int g = tid >> 6, cc = tid & 63; float s = a.in[I_ADAB][l * 9216 + cgp * 64 + cc];
#pragma unroll
                for (int k8 = 0; k8 < 8; ++k8) s += red[(k8 * 3 + g) * 64 + cc];
                mod[(size_t)(l * 3 + g) * 9216 + cgp * 64 + cc] = s;
            }
            __syncthreads();
        }
        __syncthreads();
    }
    if (bid == 0) {
        float* tr = (float*)(a.ws + WS_MISC);
        for (int i = tid; i < 2560; i += 512) {
            const int j = i & 7; const int pos = (i < 2048) ? (i >> 3) : ((i - 2048) >> 3);
            const double inv = ((j & 1) ? 0.31622776601683794 : 1.0) * ((j >> 1) == 0 ? 1.0 : ((j >> 1) == 1 ? 0.1 : ((j >> 1) == 2 ? 0.01 : 0.001))), ang = (double)pos * inv;
            float* dst = (i < 2048) ? (tr + (size_t)i * 2) : (tr + 4096 + (size_t)(i - 2048) * 2);
            dst[0] = (float)cos(ang); dst[1] = (float)sin(ang);
        }
    }
    if (bid == (1 % G) && wave < 2) {
        const float* rpb = a.in[I_RPB] + wave * 4 * 15 * 31; float m = 0.f;
        for (int i = lane; i < 4 * 15 * 31; i += 64) m = fmaxf(m, fabsf(rpb[i]));
#pragma unroll
        for (int o = 1; o < 64; o <<= 1) m = fmaxf(m, __shfl_xor(m, o));
        if (lane == 0) ((float*)(a.ws + WS_MISC))[8192 + wave] = m;
    }
    {
        const size_t gt = (size_t)bid * 512 + tid, GT = (size_t)G * 512;
        for (int l = 0; l < 2; ++l) { u32x4* z = (u32x4*)((u16*)(a.ws + WS_WIN) + ((size_t)l * NPROJ + DPROJ) * D);
            for (size_t i = gt; i < (size_t)(NPROJ - DPROJ) * D / 8; i += GT) z[i] = (u32x4){0u, 0u, 0u, 0u}; }
    }
    {
        float* scr = (float*)lds + wave * (64 * 33);
        const int gw = bid * 8 + wave, NGW = G * 8;
        constexpr int I13 = 16 * 176, I2 = 44 * 32, IIN = 16 * 89, IOUT = 16 * 32, IPW = 4 * 8;
        constexpr int NIT = 4 * I13 + 4 * I2 + 2 * IIN + 2 * IOUT + 2 * IPW;
        for (int it = gw; it < NIT; it += NGW) {
            int r = it;
            if (r < 4 * I13) { const int mi = r / I13; r -= mi * I13; const int l = mi >> 1, f = mi & 1, kb = r / 176, nb = r % 176, n0 = nb * 32;
                const int j = (n0 < DFF) ? n0 : n0 - DFF; const int drow0 = 256 * (j >> 7) + (j & 127) + ((n0 < DFF) ? 0 : 128);
                transpose_item(a.in[f ? I_F2W13 : I_F1W13] + (size_t)l * D * 2 * DFF, 2 * DFF, (u16*)(a.ws + WS_W13) + (size_t)mi * 2 * DFF * D, D, kb * 64, n0, drow0, scr, lane); continue; }
            r -= 4 * I13;
            if (r < 4 * I2) { const int mi = r / I2; r -= mi * I2; const int l = mi >> 1, f = mi & 1, kb = r / 32, nb = r % 32;
                transpose_item(a.in[f ? I_F2W2 : I_F1W2] + (size_t)l * DFF * D, D, (u16*)(a.ws + WS_W2) + (size_t)mi * D * DFF, DFF, kb * 64, nb * 32, nb * 32, scr, lane); continue; }
            r -= 4 * I2;
            if (r < 2 * IIN) { const int l = r / IIN; r -= l * IIN; const int kb = r / 89, nb = r % 89;
                transpose_item(a.in[I_WIN] + (size_t)l * D * DPROJ, DPROJ, (u16*)(a.ws + WS_WIN) + (size_t)l * NPROJ * D, D, kb * 64, nb * 32, nb * 32, scr, lane); continue; }
            r -= 2 * IIN;
            if (r < 2 * IOUT) { const int l = r / IOUT; r -= l * IOUT; const int kb = r / 32, nb = r % 32;
                transpose_item(a.in[I_WOUT] + (size_t)l * D * D, D, (u16*)(a.ws + WS_WOUT) + (size_t)l * D * D, D, kb * 64, nb * 32, nb * 32, scr, lane); continue; }
            r -= 2 * IOUT;
            { const int l = r / IPW; r -= l * IPW; const int kb = r / 8, nb = r % 8;
                transpose_item(a.in[I_CPW] + (size_t)l * 256 * 256, 256, (u16*)(a.ws + WS_PWT) + (size_t)l * 256 * 256, 256, kb * 64, nb * 32, nb * 32, scr, lane); }
        }
    }
}

__device__ __forceinline__ void phase_norm(const Args& a, int layer, int which, int M, bool first) {
    int tid = threadIdx.x; asm volatile("" : "+v"(tid)); const int lane = tid & 63, wave = tid >> 6;
    const float* nw = a.in[which == 0 ? I_NF1 : (which == 1 ? I_NMIX : I_NF2)] + (size_t)layer * D;
    u16* A = (u16*)(a.ws + WS_A);
    for (int row = blockIdx.x * 8 + wave; row < M; row += gridDim.x * 8) {
        const float* src = first ? ((row < MX) ? a.in[I_X] + (size_t)row * D : a.in[I_CTX] + (size_t)(row - MX) * D) : hrow(a, row);
        const int g = row < SEQ ? 0 : (row < MX ? 1 : 2);
        const float* sh = modp(a, layer, g, 3 * which), * scl = modp(a, layer, g, 3 * which + 1);
        f32x4 v[4]; float ss = 0.f;
#pragma unroll
        for (int j = 0; j < 4; ++j) { v[j] = ((const f32x4*)src)[lane + 64 * j]; ss += (v[j].x * v[j].x + v[j].y * v[j].y) + (v[j].z * v[j].z + v[j].w * v[j].w); }
        if (first) { f32x4* hd = (f32x4*)hrow(a, row);
#pragma unroll
            for (int j = 0; j < 4; ++j) hd[lane + 64 * j] = v[j]; }
        const float rstd = rsqrtf(wave_sum(ss) * (1.0f / D) + 1e-6f);
        u32x2* o = (u32x2*)(A + (size_t)row * D);
#pragma unroll
        for (int j = 0; j < 4; ++j) {
            const f32x4 w4 = ((const f32x4*)nw)[lane + 64 * j], s4 = ((const f32x4*)scl)[lane + 64 * j], b4 = ((const f32x4*)sh)[lane + 64 * j];
            const f32x4 y = (v[j] * rstd) * w4 * (s4 + 1.0f) + b4;
            u32x2 p; p.x = pk2(y.x, y.y); p.y = pk2(y.z, y.w); o[lane + 64 * j] = p;
        }
    }
}
__device__ __forceinline__ void phase_final(const Args& a) {
    int tid = threadIdx.x; asm volatile("" : "+v"(tid)); const int lane = tid & 63, wave = tid >> 6;
    const float* nw = a.in[I_FNORM];
    for (int row = blockIdx.x * 8 + wave; row < MX; row += gridDim.x * 8) {
        f32x4* p = (f32x4*)(a.out + (size_t)row * D);
        f32x4 v[4]; float ss = 0.f;
#pragma unroll
        for (int j = 0; j < 4; ++j) { v[j] = p[lane + 64 * j]; ss += (v[j].x * v[j].x + v[j].y * v[j].y) + (v[j].z * v[j].z + v[j].w * v[j].w); }
        const float rstd = rsqrtf(wave_sum(ss) * (1.0f / D) + 1e-6f);
#pragma unroll
        for (int j = 0; j < 4; ++j) p[lane + 64 * j] = (v[j] * rstd) * ((const f32x4*)nw)[lane + 64 * j];
    }
}

__device__ __forceinline__ void prep_unit(const Args& a, int layer, int unit, uchar* lds) {
    int tid = threadIdx.x; asm volatile("" : "+v"(tid)); const int b = unit / NCH, c = unit % NCH;
    u16* P = (u16*)(a.ws + WS_X);
    unsigned* ctl = (unsigned*)(a.ws + WS_CTL) + layer * 64;
    unsigned* lmax = (unsigned*)lds;
    u16* T = (u16*)(lds + 256);
    if (tid < 12) lmax[tid] = 0u;
    __syncthreads();
    const float* tr = (const float*)(a.ws + WS_MISC);
    {
        const int tk = tid >> 3, row = row_of(b, c, tk);
        const int t = (c - 4) * 64 + tk, gr = t >> 6, gc = t & 63;
#pragma unroll
        for (int e = 0; e < 2; ++e) {
            const int id = (tid & 7) * 2 + e, isk = id >> 3, h = (id >> 1) & 3, s = id & 1;
            u16* p = P + (size_t)row * DPROJ + C_DQ + isk * 256 + h * 64 + s * 32;
            bf16x8 raw[4];
#pragma unroll
            for (int q = 0; q < 4; ++q) raw[q] = ((const bf16x8*)p)[q];
            float x[32];
#pragma unroll
            for (int q = 0; q < 4; ++q)
#pragma unroll
                for (int i = 0; i < 8; ++i) x[q * 8 + i] = bf2f((u16)raw[q][i]);
            if (c >= 4) {
#pragma unroll
                for (int j = 0; j < 8; ++j) {
                    const float cr = tr[(gr * 8 + j) * 2], sr = tr[(gr * 8 + j) * 2 + 1], cc = tr[4096 + (gc * 8 + j) * 2], sc = tr[4096 + (gc * 8 + j) * 2 + 1];
                    const float x0 = x[j], x1 = x[j + 8], y0 = x[16 + j], y1 = x[24 + j];
                    x[j] = x0 * cr - x1 * sr; x[j + 8] = x1 * cr + x0 * sr;
                    x[16 + j] = y0 * cc - y1 * sc; x[24 + j] = y1 * cc + y0 * sc;
                }
                u32x4 o[4];
#pragma unroll
                for (int q = 0; q < 4; ++q) { o[q].x = pk2(x[q * 8], x[q * 8 + 1]); o[q].y = pk2(x[q * 8 + 2], x[q * 8 + 3]); o[q].z = pk2(x[q * 8 + 4], x[q * 8 + 5]); o[q].w = pk2(x[q * 8 + 6], x[q * 8 + 7]); }
#pragma unroll
                for (int q = 0; q < 4; ++q) ((u32x4*)p)[q] = o[q];
            }
            if (isk) {
                float n2 = 0.f;
#pragma unroll
                for (int i = 0; i < 32; ++i) { const float r = bf2f(f2bf(x[i])); n2 += r * r; }
                atomicMax(&lmax[h * 2 + s], __float_as_uint(n2));
            }
        }
    }
    {
        const int tk = tid >> 3, h = (tid & 7) >> 1, hf = tid & 1, row = row_of(b, c, tk);
        const u16* p = P + (size_t)row * DPROJ + C_NK + h * 64 + hf * 32;
        float n2 = 0.f;
#pragma unroll
        for (int q = 0; q < 4; ++q) { const bf16x8 r = ((const bf16x8*)p)[q];
#pragma unroll
            for (int i = 0; i < 8; ++i) { const float f = bf2f((u16)r[i]); n2 += f * f; } }
        n2 += __shfl_xor(n2, 1);
        if (hf == 0) atomicMax(&lmax[8 + h], __float_as_uint(n2));
    }
#pragma unroll 1
    for (int wh = 0; wh < 2; ++wh) {
        const int ccol = wh ? C_NV : C_DV;
        u16* VT = (u16*)(a.ws + (wh ? WS_VTN : WS_VTD));
        __syncthreads();
        for (int i = tid; i < 64 * 32; i += 512) { const int tk = i >> 5, pc = i & 31;
            *(bf16x8*)(T + tk * 264 + pc * 8) = *(const bf16x8*)(P + (size_t)row_of(b, c, tk) * DPROJ + ccol + pc * 8); }
        __syncthreads();
        {
            const int r = tid >> 1, hf = tid & 1, h = r >> 6, dv = r & 63;
            u16* dst = VT + ((size_t)(b * 4 + h) * 64 + dv) * NKEY + c * 64 + hf * 32;
#pragma unroll
            for (int q = 0; q < 4; ++q) {
                u32x4 o; unsigned w[4];
#pragma unroll
                for (int i = 0; i < 4; ++i) { const int t0 = hf * 32 + q * 8 + i * 2; w[i] = (unsigned)T[t0 * 264 + r] | ((unsigned)T[(t0 + 1) * 264 + r] << 16); }
                o.x = w[0]; o.y = w[1]; o.z = w[2]; o.w = w[3];
                ((u32x4*)dst)[q] = o;
            }
        }
    }
    __syncthreads();
    if (tid < 8) atomicMax(&ctl[(b * 4 + (tid >> 1)) * 2 + (tid & 1)], lmax[tid]);
    else if (tid < 12) atomicMax(&ctl[16 + b * 4 + (tid - 8)], lmax[tid]);
    __syncthreads();
}

__device__ __forceinline__ void gla_bcum(const Args& a, int layer, const u16* prow, int h, int dir, int lane, float (&bc)[32]) {
    const float* wa = a.in[dir ? I_WAB : I_WAF] + (size_t)layer * 16 * 128 + h * 32;
    const float* ba = a.in[dir ? I_BAB : I_BAF] + (size_t)layer * 128 + h * 32;
    const bf16x8 r0 = *(const bf16x8*)(prow + C_AF + dir * 16), r1 = *(const bf16x8*)(prow + C_AF + dir * 16 + 8);
    float av[16];
#pragma unroll
    for (int i = 0; i < 8; ++i) { av[i] = bf2f((u16)r0[i]); av[8 + i] = bf2f((u16)r1[i]); }
#pragma unroll
    for (int d = 0; d < 32; ++d) {
        float z = ba[d];
#pragma unroll
        for (int r = 0; r < 16; ++r) z += av[r] * wa[r * 128 + d];
        const float ls = fminf(z, 0.f) - __logf(1.0f + __expf(-fabsf(z)));
        bc[d] = ls * (1.0f / 16.0f);
        if ((d & 3) == 3) __builtin_amdgcn_sched_barrier(0);
    }
#pragma unroll
    for (int off = 1; off < 64; off <<= 1) {
#pragma unroll
        for (int d = 0; d < 32; ++d) {
            if (dir == 0) { const float t = __shfl_up(bc[d], off); if (lane >= off) bc[d] += t; }
            else { const float t = __shfl_down(bc[d], off); if (lane + off < 64) bc[d] += t; }
        }
    }
}
__device__ __forceinline__ int gla_scan_idx(int dir, int c) { return dir == 0 ? c : ((c < 4) ? 3 - c : 263 - c); }

__device__ __forceinline__ void gla_g1_wave(const Args& a, int layer, int b, int c, int h, int dir, uchar* wlds, int lane) {
    asm volatile("" : "+v"(lane));
    const int fr = lane & 15, fq = lane >> 4;
    const u16* P = (const u16*)(a.ws + WS_X);
    const u16* prow = P + (size_t)row_of(b, c, lane) * DPROJ;
    u16* VT = (u16*)wlds;
    u16* KT = (u16*)(wlds + 8192);
    float* U = (float*)(a.ws + WS_U); float* DEC = (float*)(a.ws + WS_DEC);
    {
        bf16x8 vr[8];
#pragma unroll
        for (int q = 0; q < 8; ++q) vr[q] = ((const bf16x8*)(prow + C_GV + h * 64))[q];
#pragma unroll
        for (int q = 0; q < 8; ++q)
#pragma unroll
            for (int i = 0; i < 8; ++i) VT[(q * 8 + i) * 64 + lane] = (u16)vr[q][i];
    }
    float bc[32];
    gla_bcum(a, layer, prow, h, dir, lane, bc);
    const int n = gla_scan_idx(dir, c);
    const size_t sidx = ((size_t)((b * 2 + dir) * 4 + h) * NCH + n);
    {
        f32x4* bcp = (f32x4*)((float*)(a.ws + WS_BC) + ((((size_t)((b * 2 + dir) * 4 + h) * NCH + c) * 64 + lane) * 32));
#pragma unroll
        for (int q = 0; q < 8; ++q) bcp[q] = (f32x4){bc[q * 4], bc[q * 4 + 1], bc[q * 4 + 2], bc[q * 4 + 3]};
    }
    {
        bf16x8 kr[4];
#pragma unroll
        for (int q = 0; q < 4; ++q) kr[q] = ((const bf16x8*)(prow + C_GK + h * 32))[q];
#pragma unroll
        for (int d = 0; d < 32; ++d) { const float bl = __shfl(bc[d], dir ? 0 : 63); KT[d * 64 + lane] = f2bf(bf2f((u16)kr[d >> 3][d & 7]) * __expf(bl - bc[d])); }
    }
    if (lane == (dir ? 0 : 63)) {
#pragma unroll
        for (int q = 0; q < 8; ++q) { f32x4 o;
#pragma unroll
            for (int e = 0; e < 4; ++e) o[e] = __expf(bc[q * 4 + e]);
            ((f32x4*)(DEC + sidx * 32))[q] = o; }
    }
    WAVE_SYNC();
    f32x4 acc[4][2];
#pragma unroll
    for (int dvb = 0; dvb < 4; ++dvb)
#pragma unroll
        for (int db = 0; db < 2; ++db) acc[dvb][db] = (f32x4){0.f, 0.f, 0.f, 0.f};
#pragma unroll
    for (int ks = 0; ks < 2; ++ks) {
        bf16x8 kf[2];
#pragma unroll
        for (int db = 0; db < 2; ++db) kf[db] = *(const bf16x8*)(KT + (db * 16 + fr) * 64 + ks * 32 + fq * 8);
#pragma unroll
        for (int dvb = 0; dvb < 4; ++dvb) {
            const bf16x8 vf = *(const bf16x8*)(VT + (dvb * 16 + fr) * 64 + ks * 32 + fq * 8);
#pragma unroll
            for (int db = 0; db < 2; ++db) acc[dvb][db] = __builtin_amdgcn_mfma_f32_16x16x32_bf16(vf, kf[db], acc[dvb][db], 0, 0, 0);
        }
    }
    float* ub = U + sidx * 2048;
#pragma unroll
    for (int dvb = 0; dvb < 4; ++dvb)
#pragma unroll
        for (int db = 0; db < 2; ++db) *(f32x4*)(ub + (db * 16 + fr) * 64 + dvb * 16 + fq * 4) = acc[dvb][db];
    WAVE_SYNC();
}
__device__ __forceinline__ void gla_scan(const Args& a, uchar* lds) {
    int tid = threadIdx.x; asm volatile("" : "+v"(tid));
    float* U = (float*)(a.ws + WS_U); const float* DEC = (const float*)(a.ws + WS_DEC);
    float* PL = (float*)lds;
    const int seg = tid >> 7, el = tid & 127;
    constexpr int SEGN = NCH / 4;
    for (int blk = blockIdx.x; blk < 16 * 16; blk += gridDim.x) {
        const int seq = blk >> 4, e = (blk & 15) * 128 + el, d = e >> 6;
        float* u = U + ((size_t)seq * NCH + seg * SEGN) * 2048 + e; const float* dc = DEC + ((size_t)seq * NCH + seg * SEGN) * 32 + d;
        float pr = 1.f, s = 0.f;
#pragma unroll 13
        for (int n = 0; n < SEGN; ++n) { const float un = u[(size_t)n * 2048], dn = dc[n * 32]; s = dn * s + un; pr *= dn; }
        __syncthreads();
        PL[(seg * 128 + el) * 2] = pr; PL[(seg * 128 + el) * 2 + 1] = s;
        __syncthreads();
        float s0 = 0.f;
        for (int k = 0; k < seg; ++k) s0 = PL[(k * 128 + el) * 2] * s0 + PL[(k * 128 + el) * 2 + 1];
        s = s0;
#pragma unroll 13
        for (int n = 0; n < SEGN; ++n) { const float un = u[(size_t)n * 2048], dn = dc[n * 32]; u[(size_t)n * 2048] = s; s = dn * s + un; }
    }
    __syncthreads();
}
__device__ __forceinline__ void gla_g3_wave(const Args& a, int layer, int wu, uchar* wlds, int lane) {
    asm volatile("" : "+v"(lane));
    const int h = __builtin_amdgcn_readfirstlane(wu & 3), bc_ = __builtin_amdgcn_readfirstlane(wu >> 2), b = bc_ / NCH, c = bc_ % NCH;
    const int fr = lane & 15, fq = lane >> 4;
    const u16* P = (const u16*)(a.ws + WS_X);
    const int row_l = row_of(b, c, lane);
    const u16* prow = P + (size_t)row_l * DPROJ;
    u16* R0 = (u16*)wlds;
    u16* ST = (u16*)(wlds + 4096);
    u16* VT = (u16*)(wlds + 8192);
    const float* U = (const float*)(a.ws + WS_U);
    {
        bf16x8 vr[8];
#pragma unroll
        for (int q = 0; q < 8; ++q) vr[q] = ((const bf16x8*)(prow + C_GV + h * 64))[q];
#pragma unroll
        for (int q = 0; q < 8; ++q)
#pragma unroll
            for (int i = 0; i < 8; ++i) VT[(q * 8 + i) * 64 + lane] = (u16)vr[q][i];
    }
    f32x4 O[4][4];
#pragma unroll
    for (int qb = 0; qb < 4; ++qb)
#pragma unroll
        for (int dvb = 0; dvb < 4; ++dvb) O[qb][dvb] = (f32x4){0.f, 0.f, 0.f, 0.f};
#pragma unroll 1
    for (int dir = 0; dir < 2; ++dir) {
        const int n = gla_scan_idx(dir, c);
        const float* sp = U + ((size_t)((b * 2 + dir) * 4 + h) * NCH + n) * 2048;
        u32x4 qpk[4], kpk[4];
        {
            const f32x4* bcp = (const f32x4*)((const float*)(a.ws + WS_BC) + ((((size_t)((b * 2 + dir) * 4 + h) * NCH + c) * 64 + lane) * 32));
#pragma unroll
            for (int q = 0; q < 4; ++q) {
                const bf16x8 qr = ((const bf16x8*)(prow + C_GQ + h * 32))[q], kr = ((const bf16x8*)(prow + C_GK + h * 32))[q];
                const f32x4 b0 = bcp[2 * q], b1 = bcp[2 * q + 1];
                float e[8];
#pragma unroll
                for (int i = 0; i < 4; ++i) { e[i] = __expf(b0[i]); e[4 + i] = __expf(b1[i]); }
                unsigned wq[4], wk[4];
#pragma unroll
                for (int i = 0; i < 4; ++i) {
                    wq[i] = pk2(bf2f((u16)qr[2 * i]) * 0.17677669529663687f * e[2 * i], bf2f((u16)qr[2 * i + 1]) * 0.17677669529663687f * e[2 * i + 1]);
                    wk[i] = pk2(bf2f((u16)kr[2 * i]) * __builtin_amdgcn_rcpf(e[2 * i]), bf2f((u16)kr[2 * i + 1]) * __builtin_amdgcn_rcpf(e[2 * i + 1]));
                }
                qpk[q] = (u32x4){wq[0], wq[1], wq[2], wq[3]}; kpk[q] = (u32x4){wk[0], wk[1], wk[2], wk[3]};
            }
        }
        WAVE_SYNC();
#pragma unroll
        for (int q = 0; q < 4; ++q) ((u32x4*)(R0 + lane * 32))[q] = qpk[q];
#pragma unroll
        for (int q = 0; q < 4; ++q) { u32x4 o; unsigned w[4];
#pragma unroll
            for (int i = 0; i < 4; ++i) { const int d = q * 8 + 2 * i; w[i] = pk2(sp[d * 64 + lane], sp[(d + 1) * 64 + lane]); }
            o.x = w[0]; o.y = w[1]; o.z = w[2]; o.w = w[3]; ((u32x4*)(ST + lane * 32))[q] = o; }
        WAVE_SYNC();
        bf16x8 qf[4];
#pragma unroll
        for (int qb = 0; qb < 4; ++qb) qf[qb] = *(const bf16x8*)(R0 + (qb * 16 + fr) * 32 + fq * 8);
        WAVE_SYNC();
#pragma unroll
        for (int q = 0; q < 4; ++q) ((u32x4*)(R0 + lane * 32))[q] = kpk[q];
        WAVE_SYNC();
#pragma unroll
        for (int dvb = 0; dvb < 4; ++dvb) {
            const bf16x8 sf = *(const bf16x8*)(ST + (dvb * 16 + fr) * 32 + fq * 8);
#pragma unroll
            for (int qb = 0; qb < 4; ++qb) O[qb][dvb] = __builtin_amdgcn_mfma_f32_16x16x32_bf16(sf, qf[qb], O[qb][dvb], 0, 0, 0);
        }
#pragma unroll
        for (int ip = 0; ip < 2; ++ip) {
            const bf16x8 kf0 = *(const bf16x8*)(R0 + ((2 * ip) * 16 + fr) * 32 + fq * 8), kf1 = *(const bf16x8*)(R0 + ((2 * ip + 1) * 16 + fr) * 32 + fq * 8);
            bf16x8 pf[4];
#pragma unroll
            for (int qb = 0; qb < 4; ++qb) {
                f32x4 a0 = (f32x4){0.f, 0.f, 0.f, 0.f}, a1 = a0;
                a0 = __builtin_amdgcn_mfma_f32_16x16x32_bf16(kf0, qf[qb], a0, 0, 0, 0);
                a1 = __builtin_amdgcn_mfma_f32_16x16x32_bf16(kf1, qf[qb], a1, 0, 0, 0);
                const int i = qb * 16 + fr;
                float p[8];
#pragma unroll
                for (int jj = 0; jj < 4; ++jj) {
                    const int j0 = (2 * ip) * 16 + fq * 4 + jj, j1 = j0 + 16;
                    p[jj] = (dir == 0 ? (j0 <= i) : (j0 >= i)) ? a0[jj] : 0.f;
                    p[4 + jj] = (dir == 0 ? (j1 <= i) : (j1 >= i)) ? a1[jj] : 0.f;
                }
                u32x4 w; w.x = pk2(p[0], p[1]); w.y = pk2(p[2], p[3]); w.z = pk2(p[4], p[5]); w.w = pk2(p[6], p[7]);
                pf[qb] = __builtin_bit_cast(bf16x8, w);
            }
#pragma unroll
            for (int dvb = 0; dvb < 4; ++dvb) {
                const u16* vp = VT + (dvb * 16 + fr) * 64 + (2 * ip) * 16 + fq * 4;
                const s16x4 lo = *(const s16x4*)vp, hi = *(const s16x4*)(vp + 16);
                const bf16x8 vf = __builtin_shufflevector(lo, hi, 0, 1, 2, 3, 4, 5, 6, 7);
#pragma unroll
                for (int qb = 0; qb < 4; ++qb) O[qb][dvb] = __builtin_amdgcn_mfma_f32_16x16x32_bf16(vf, pf[qb], O[qb][dvb], 0, 0, 0);
            }
        }
    }
    const float* gnw = a.in[I_GNORM] + layer * 64;
    u16* MIX = (u16*)(a.ws + WS_A);
#pragma unroll
    for (int qb = 0; qb < 4; ++qb) {
        float ss = 0.f;
#pragma unroll
        for (int dvb = 0; dvb < 4; ++dvb)
#pragma unroll
            for (int jj = 0; jj < 4; ++jj) ss += O[qb][dvb][jj] * O[qb][dvb][jj];
        ss += __shfl_xor(ss, 16); ss += __shfl_xor(ss, 32);
        const float r = rsqrtf(ss * (1.0f / 64.0f) + 1e-6f);
        const int row = row_of(b, c, qb * 16 + fr);
#pragma unroll
        for (int dvb = 0; dvb < 4; ++dvb) {
            const int v0 = dvb * 16 + fq * 4;
            const s16x4 g4 = *(const s16x4*)(P + (size_t)row * DPROJ + C_GG + h * 64 + v0);
            const f32x4 nw = *(const f32x4*)(gnw + v0);
            float o[4];
#pragma unroll
            for (int jj = 0; jj < 4; ++jj) o[jj] = O[qb][dvb][jj] * r * nw[jj] * silu_f(bf2f((u16)g4[jj]));
            u32x2 w; w.x = pk2(o[0], o[1]); w.y = pk2(o[2], o[3]);
            *(u32x2*)(MIX + (size_t)row * D + h * 64 + v0) = w;
        }
    }
    WAVE_SYNC();
}

__device__ __forceinline__ void conv_unit(const Args& a, int layer, int unit, uchar* lds, const bf16x8 (&wf)[2][8]) {
    int tid = threadIdx.x; asm volatile("" : "+v"(tid)); const int lane = tid & 63, wave = tid >> 6, fr = lane & 15, fq = lane >> 4;
    int t0, L, rowbase;
    if (unit < 1024) { const int b = unit >> 9; t0 = (unit & 511) * 32; L = SEQ; rowbase = b * SEQ; }
    else { const int uu = unit - 1024, b = uu >> 3; t0 = (uu & 7) * 32; L = CTXL; rowbase = MX + b * CTXL; }
    const u16* P = (const u16*)(a.ws + WS_X);
    float* Ub = (float*)lds;
    float* Y = (float*)(lds + 65536);
    u16* Z = (u16*)(lds + 98304);
    for (int i = tid; i < 62 * 64; i += 512) {
        const int p = i >> 6, c4 = (i & 63) * 4, t = t0 - 15 + p;
        f32x4 u = (f32x4){0.f, 0.f, 0.f, 0.f};
        if (t >= 0 && t < L) {
            const u16* pr = P + (size_t)(rowbase + t) * DPROJ;
            const s16x4 av = *(const s16x4*)(pr + C_CA + c4), gv = *(const s16x4*)(pr + C_CG + c4);
#pragma unroll
            for (int e = 0; e < 4; ++e) { const float g = bf2f((u16)gv[e]); u[e] = bf2f((u16)av[e]) / (1.0f + __expf(-g)); }
        }
        *(f32x4*)(Ub + p * 256 + c4) = u;
    }
    __syncthreads();
    {
        const int c = tid & 255, th = tid >> 8;
        const float* dw = a.in[I_CDW] + (size_t)layer * 31 * 256 + c;
        float w[31];
#pragma unroll
        for (int k = 0; k < 31; ++k) w[k] = dw[k * 256];
        const float bias = a.in[I_CDWB][layer * 256 + c];
        float uw[46];
#pragma unroll
        for (int i = 0; i < 46; ++i) uw[i] = Ub[(th * 16 + i) * 256 + c];
#pragma unroll
        for (int tt = 0; tt < 16; ++tt) {
            float acc = bias;
#pragma unroll
            for (int k = 0; k < 31; ++k) acc += w[k] * uw[tt + k];
            Y[(th * 16 + tt) * 256 + c] = acc;
        }
    }
    __syncthreads();
    {
        const f32x4 g4 = *(const f32x4*)(a.in[I_CLNG] + layer * 256 + lane * 4), b4 = *(const f32x4*)(a.in[I_CLNB] + layer * 256 + lane * 4);
#pragma unroll
        for (int q = 0; q < 4; ++q) {
            const int t = wave * 4 + q;
            const f32x4 v = *(const f32x4*)(Y + t * 256 + lane * 4);
            const float mu = wave_sum((v.x + v.y) + (v.z + v.w)) * (1.0f / 256.0f);
            const f32x4 dlt = v - mu;
            const float var = wave_sum((dlt.x * dlt.x + dlt.y * dlt.y) + (dlt.z * dlt.z + dlt.w * dlt.w)) * (1.0f / 256.0f);
            const float rs = rsqrtf(var + 1e-5f);
            float z[4];
#pragma unroll
            for (int e = 0; e < 4; ++e) z[e] = silu_f(dlt[e] * rs * g4[e] + b4[e]);
            u32x2 w; w.x = pk2(z[0], z[1]); w.y = pk2(z[2], z[3]);
            *(u32x2*)(Z + t * 264 + lane * 4) = w;
        }
    }
    __syncthreads();
    {
        f32x4 acc[2][2];
#pragma unroll
        for (int i = 0; i < 2; ++i)
#pragma unroll
            for (int j = 0; j < 2; ++j) acc[i][j] = (f32x4){0.f, 0.f, 0.f, 0.f};
#pragma unroll
        for (int ks = 0; ks < 8; ++ks) {
            bf16x8 zf[2];
#pragma unroll
            for (int tb = 0; tb < 2; ++tb) zf[tb] = *(const bf16x8*)(Z + (tb * 16 + fr) * 264 + ks * 32 + fq * 8);
#pragma unroll
            for (int nbi = 0; nbi < 2; ++nbi)
#pragma unroll
                for (int tb = 0; tb < 2; ++tb) acc[nbi][tb] = __builtin_amdgcn_mfma_f32_16x16x32_bf16(wf[nbi][ks], zf[tb], acc[nbi][tb], 0, 0, 0);
        }
        u16* MIX = (u16*)(a.ws + WS_A);
#pragma unroll
        for (int nbi = 0; nbi < 2; ++nbi) {
            const int n0 = (wave * 2 + nbi) * 16 + fq * 4;
            const f32x4 pb = *(const f32x4*)(a.in[I_CPWB] + layer * 256 + n0);
#pragma unroll
            for (int tb = 0; tb < 2; ++tb) {
                const int row = rowbase + t0 + tb * 16 + fr;
                u32x2 w; w.x = pk2(acc[nbi][tb][0] + pb[0], acc[nbi][tb][1] + pb[1]); w.y = pk2(acc[nbi][tb][2] + pb[2], acc[nbi][tb][3] + pb[3]);
                *(u32x2*)(MIX + (size_t)row * D + 768 + n0) = w;
            }
        }
    }
    __syncthreads();
}
#define XB_TMO      128
#define XB_XCNT(j)  (256  + 64 * (j))
#define XB_XSUB(j)  (1280 + 64 * (j))
#define XB_XGEN(j)  (2304 + 64 * (j))
#define XB_TOP      3328
#define XB_TOPGEN   3392
#define XCD_BAR_WORDS 3456
#define XB_SPIN_CAP (1u << 18)

__device__ __forceinline__ unsigned xb_ld(unsigned* p)              { return __hip_atomic_load(p, __ATOMIC_RELAXED, __HIP_MEMORY_SCOPE_AGENT); }
__device__ __forceinline__ unsigned xb_add(unsigned* p, unsigned v) { return __hip_atomic_fetch_add(p, v, __ATOMIC_RELAXED, __HIP_MEMORY_SCOPE_AGENT); }
__device__ __forceinline__ unsigned xb_xcc_id() { return (unsigned)__builtin_amdgcn_s_getreg((3 << 11) | 20) & 0xFu; }
#define XB_SPIN(cond, bar) do { unsigned _sp = 0; while (cond) { __builtin_amdgcn_s_sleep(1); \
    if ((++_sp & 255u) == 0u) { if (xb_ld(&(bar)[XB_TMO])) break; if (_sp > XB_SPIN_CAP) { atomicAdd(&(bar)[XB_TMO], 1u); break; } } } } while (0)

struct XcdBarrier {
    unsigned* bar; unsigned x;
    volatile LAS unsigned* st;
};

__device__ __forceinline__ XcdBarrier xcd_barrier_post(unsigned* bar, volatile LAS unsigned* st) {
    XcdBarrier b; b.bar = bar; b.x = xb_xcc_id(); b.st = st;
    if (threadIdx.x == 0) (void)xb_add(&bar[XB_XCNT(b.x)], 1u);
    return b;
}
__device__ __forceinline__ void xcd_barrier_complete(unsigned* bar, unsigned x, unsigned& nloc, unsigned& nx) {
    const unsigned G = gridDim.x * gridDim.y * gridDim.z;
    unsigned sum, cnt, mine, sp = 0u;
    for (;;) {
        sum = 0u; cnt = 0u; mine = 0u;
#pragma unroll
        for (unsigned j = 0; j < 16; ++j) { const unsigned c = xb_ld(&bar[XB_XCNT(j)]); sum += c; cnt += (c > 0u) ? 1u : 0u; mine = (j == x) ? c : mine; }
        if (sum == G) break;
        __builtin_amdgcn_s_sleep(1);
        if ((++sp & 255u) == 0u) { if (xb_ld(&bar[XB_TMO])) break; if (sp > XB_SPIN_CAP) { atomicAdd(&bar[XB_TMO], 1u); break; } }
    }
    nloc = mine > 0u ? mine : 1u; nx = cnt > 0u ? cnt : 1u;
}

__device__ __forceinline__ void xcd_barrier(const XcdBarrier& b) {
    asm volatile("s_waitcnt vmcnt(0)" ::: "memory");
    __syncthreads();
    if (threadIdx.x == 0) {
        unsigned* bar = b.bar;
        __builtin_amdgcn_s_waitcnt(0);
        unsigned nloc = b.st[0], nx = b.st[1];
        if (nloc == 0u) { xcd_barrier_complete(bar, b.x, nloc, nx); b.st[0] = nloc; b.st[1] = nx; }
        const unsigned old = xb_add(&bar[XB_XSUB(b.x)], 1u);
        const unsigned gen = old / nloc;
        if (old + 1u == (gen + 1u) * nloc) {
            __builtin_amdgcn_fence(__ATOMIC_RELEASE, "agent");
            asm volatile("s_waitcnt vmcnt(0)" ::: "memory");
            const unsigned og = xb_add(&bar[XB_TOP], 1u);
            const unsigned tg = og / nx;
            if (og + 1u == (tg + 1u) * nx) xb_add(&bar[XB_TOPGEN], 1u);
            else XB_SPIN(xb_ld(&bar[XB_TOPGEN]) == tg, bar);
            __builtin_amdgcn_fence(__ATOMIC_ACQUIRE, "agent");
            xb_add(&bar[XB_XGEN(b.x)], 1u);
            asm volatile("s_waitcnt vmcnt(0)" ::: "memory");
        } else {
            XB_SPIN(xb_ld(&bar[XB_XGEN(b.x)]) == gen, bar);
            __builtin_amdgcn_fence(__ATOMIC_ACQUIRE, "agent");
            asm volatile("s_waitcnt vmcnt(0)" ::: "memory");
        }
    }
    __syncthreads();
}

typedef float f32x2_t __attribute__((ext_vector_type(2)));
typedef __bf16 bf16x2_t __attribute__((ext_vector_type(2)));
__device__ __forceinline__ unsigned cvtpk_s(float lo, float hi) { f32x2_t v = {lo, hi}; bf16x2_t b = __builtin_convertvector(v, bf16x2_t); return __builtin_bit_cast(unsigned, b); }
__device__ __forceinline__ bf16x8 pack8(const f32x4& p0, const f32x4& p1) {
    u32x4 w; w.x = cvtpk_s(p0[0], p0[1]); w.y = cvtpk_s(p0[2], p0[3]); w.z = cvtpk_s(p1[0], p1[1]); w.w = cvtpk_s(p1[2], p1[3]);
    return __builtin_bit_cast(bf16x8, w);
}
__device__ __forceinline__ bf16x8 load_scaled8(const u16* p, float sc, float& n2) {
    const bf16x8 raw = *(const bf16x8*)p; bf16x8 o;
#pragma unroll
    for (int i = 0; i < 8; ++i) { const u16 r = f2bf(bf2f((u16)raw[i]) * sc); const float f = bf2f(r); n2 += f * f; o[i] = (short)r; }
    return o;
}

__device__ __forceinline__ void diff_unit(const Args& a, int layer, int b, int h, int q0row, int ntiles, uchar* lds) {
    int tid = threadIdx.x; asm volatile("" : "+v"(tid)); const int lane = tid & 63, wave = tid >> 6, fr = lane & 15, fq = lane >> 4;
    const u16* P = (const u16*)(a.ws + WS_X);
    const u16* VTD = (const u16*)(a.ws + WS_VTD) + (size_t)(b * 4 + h) * 64 * NKEY;
    const unsigned* ctl = (const unsigned*)(a.ws + WS_CTL) + layer * 64;
    u16* Ks = (u16*)lds;
    u16* Vs = (u16*)(lds + 2 * 64 * 64 * 2);
    const float C2 = 0.17677669529663687f * LOG2E;
    bf16x8 qf[2][2]; float negb[2][2];
#pragma unroll
    for (int qb = 0; qb < 2; ++qb)
#pragma unroll
        for (int s = 0; s < 2; ++s) {
            const int row = q0row + wave * 32 + qb * 16 + fr; float n2 = 0.f;
            qf[qb][s] = load_scaled8(P + (size_t)row * DPROJ + C_DQ + h * 64 + s * 32 + fq * 8, C2, n2);
            n2 += __shfl_xor(n2, 16); n2 += __shfl_xor(n2, 32);
            const float km = __uint_as_float(ctl[(b * 4 + h) * 2 + s]);
            negb[qb][s] = -sqrtf(n2 * km);
        }
    f32x4 O[2][2][4], Ls[2][2];
    const bf16x8 ones = (bf16x8){(short)0x3F80, (short)0x3F80, (short)0x3F80, (short)0x3F80, (short)0x3F80, (short)0x3F80, (short)0x3F80, (short)0x3F80};
#pragma unroll
    for (int qb = 0; qb < 2; ++qb)
#pragma unroll
        for (int s = 0; s < 2; ++s) { Ls[qb][s] = (f32x4){0.f, 0.f, 0.f, 0.f};
#pragma unroll
            for (int dvb = 0; dvb < 4; ++dvb) O[qb][s][dvb] = (f32x4){0.f, 0.f, 0.f, 0.f}; }
    const int sr = tid >> 3, pc = tid & 7;
    auto kaddr = [&](int t) -> const u16* { const int krow = (t < 4) ? (MX + b * CTXL + t * 64 + sr) : (b * SEQ + (t - 4) * 64 + sr); return P + (size_t)krow * DPROJ + C_DK + h * 64 + pc * 8; };
    auto vaddr = [&](int t) -> const u16* { return VTD + (size_t)sr * NKEY + t * 64 + pc * 8; };
    auto compute_tile = [&](const u16* Kb, const u16* Vb) {
        f32x4 S0[2][2], S1[2][2];
        bf16x8 pfr[2][2];
        bf16x8 vfr[4];
#define DIFF_QK(g) do { const int i_ = (g) >> 1, s_ = (g) & 1; \
            const bf16x8 kf0 = *(const bf16x8*)(Kb + ((2 * i_) * 16 + fr) * 64 + (((s_ * 4 + fq) ^ (fr >> 1)) * 8)), kf1 = *(const bf16x8*)(Kb + ((2 * i_ + 1) * 16 + fr) * 64 + (((s_ * 4 + fq) ^ (fr >> 1)) * 8)); \
            _Pragma("unroll") for (int qb = 0; qb < 2; ++qb) { const float nb = negb[qb][s_]; const f32x4 c0 = (f32x4){nb, nb, nb, nb}; \
                S0[(g) & 1][qb] = __builtin_amdgcn_mfma_f32_16x16x32_bf16(kf0, qf[qb][s_], c0, 0, 0, 0); \
                S1[(g) & 1][qb] = __builtin_amdgcn_mfma_f32_16x16x32_bf16(kf1, qf[qb][s_], c0, 0, 0, 0); } } while (0)
#define DIFF_EXP(g) do { _Pragma("unroll") for (int qb = 0; qb < 2; ++qb) { f32x4 e0, e1; \
                _Pragma("unroll") for (int j = 0; j < 4; ++j) { e0[j] = __builtin_amdgcn_exp2f(S0[(g) & 1][qb][j]); e1[j] = __builtin_amdgcn_exp2f(S1[(g) & 1][qb][j]); } \
                pfr[(g) & 1][qb] = pack8(e0, e1); } } while (0)
#define DIFF_VLOAD(i_) do { _Pragma("unroll") for (int dvb = 0; dvb < 4; ++dvb) { const u16* vp = Vb + (dvb * 16 + fr) * 72 + (2 * (i_)) * 16 + fq * 4; \
                const s16x4 lo = *(const s16x4*)vp, hi = *(const s16x4*)(vp + 16); vfr[dvb] = __builtin_shufflevector(lo, hi, 0, 1, 2, 3, 4, 5, 6, 7); } } while (0)
#define DIFF_PV(g) do { const int s_ = (g) & 1; \
            _Pragma("unroll") for (int qb = 0; qb < 2; ++qb) Ls[qb][s_] = __builtin_amdgcn_mfma_f32_16x16x32_bf16(ones, pfr[(g) & 1][qb], Ls[qb][s_], 0, 0, 0); \
            _Pragma("unroll") for (int dvb = 0; dvb < 4; ++dvb) _Pragma("unroll") for (int qb = 0; qb < 2; ++qb) \
                O[qb][s_][dvb] = __builtin_amdgcn_mfma_f32_16x16x32_bf16(vfr[dvb], pfr[(g) & 1][qb], O[qb][s_][dvb], 0, 0, 0); } while (0)
        DIFF_QK(0); DIFF_VLOAD(0);
        DIFF_QK(1); DIFF_EXP(0);
        DIFF_QK(2); DIFF_EXP(1); DIFF_PV(0);
        DIFF_QK(3); DIFF_EXP(2); DIFF_PV(1); DIFF_VLOAD(1);
        DIFF_EXP(3); DIFF_PV(2);
        DIFF_PV(3);
#undef DIFF_QK
#undef DIFF_EXP
#undef DIFF_VLOAD
#undef DIFF_PV
    };
    bf16x8 kA = *(const bf16x8*)kaddr(0), vA = *(const bf16x8*)vaddr(0), kB = *(const bf16x8*)kaddr(1), vB = *(const bf16x8*)vaddr(1);
    __syncthreads();
#pragma unroll 1
    for (int t = 0; t < ntiles; t += 2) {
        *(bf16x8*)(Ks + sr * 64 + ((pc ^ ((sr >> 1) & 7)) * 8)) = kA; *(bf16x8*)(Vs + sr * 72 + pc * 8) = vA;
        __syncthreads();
        if (t + 2 < ntiles) { kA = *(const bf16x8*)kaddr(t + 2); vA = *(const bf16x8*)vaddr(t + 2); }
        compute_tile(Ks, Vs);
        *(bf16x8*)(Ks + 64 * 64 + sr * 64 + ((pc ^ ((sr >> 1) & 7)) * 8)) = kB; *(bf16x8*)(Vs + 64 * 72 + sr * 72 + pc * 8) = vB;
        __syncthreads();
        if (t + 3 < ntiles) { kB = *(const bf16x8*)kaddr(t + 3); vB = *(const bf16x8*)vaddr(t + 3); }
        compute_tile(Ks + 64 * 64, Vs + 64 * 72);
    }
    const float lam_init = (layer == 0) ? 0.2f : (0.8f - 0.6f * 0.7408182206817179f);
    float d1 = 0.f, d2 = 0.f;
    if (lane < 32) { d1 = a.in[I_LQ1][layer * 32 + lane] * a.in[I_LK1][layer * 32 + lane]; d2 = a.in[I_LQ2][layer * 32 + lane] * a.in[I_LK2][layer * 32 + lane]; }
    const float lam = expf(wave_sum(d1)) - expf(wave_sum(d2)) + lam_init;
    const float* dnw = a.in[I_DNORM] + layer * 64;
    u16* MIX = (u16*)(a.ws + WS_A);
#pragma unroll
    for (int qb = 0; qb < 2; ++qb) {
        const float l1 = Ls[qb][0][0], l2 = Ls[qb][1][0];
        const float i1 = 1.0f / l1, i2 = lam / l2;
        f32x4 o[4]; float ss = 0.f;
#pragma unroll
        for (int dvb = 0; dvb < 4; ++dvb) { o[dvb] = O[qb][0][dvb] * i1 - O[qb][1][dvb] * i2; ss += (o[dvb][0] * o[dvb][0] + o[dvb][1] * o[dvb][1]) + (o[dvb][2] * o[dvb][2] + o[dvb][3] * o[dvb][3]); }
        ss += __shfl_xor(ss, 16); ss += __shfl_xor(ss, 32);
        const float r = rsqrtf(ss * (1.0f / 64.0f) + 1e-6f) * (1.0f - lam_init);
        const int row = q0row + wave * 32 + qb * 16 + fr;
#pragma unroll
        for (int dvb = 0; dvb < 4; ++dvb) {
            const int v0 = dvb * 16 + fq * 4; const f32x4 nw = *(const f32x4*)(dnw + v0);
            u32x2 w; w.x = pk2(o[dvb][0] * r * nw[0], o[dvb][1] * r * nw[1]); w.y = pk2(o[dvb][2] * r * nw[2], o[dvb][3] * r * nw[3]);
            *(u32x2*)(MIX + (size_t)row * D + 512 + h * 64 + v0) = w;
        }
    }
}

__device__ __forceinline__ void na_wave(const Args& a, int layer, bool ctxq, int wu, int lane) {
    asm volatile("" : "+v"(lane));
    const int fr = lane & 15, fq = lane >> 4;
    const u16* P = (const u16*)(a.ws + WS_X);
    int b, h, r, qblk, qrow;
    if (!ctxq) { qblk = wu & 3; h = (wu >> 2) & 3; r = (wu >> 4) & 255; b = wu >> 12; qrow = b * SEQ + r * 64 + qblk * 16 + fr; }
    else { qblk = wu & 15; h = (wu >> 4) & 3; b = wu >> 6; r = 0; qrow = MX + b * CTXL + qblk * 16 + fr; }
    const int c = qblk * 16 + fr;
    const u16* VTN = (const u16*)(a.ws + WS_VTN) + (size_t)(b * 4 + h) * 64 * NKEY;
    const float C2 = 0.125f * LOG2E;
    bf16x8 qf[2]; float n2 = 0.f;
#pragma unroll
    for (int ks = 0; ks < 2; ++ks) qf[ks] = load_scaled8(P + (size_t)qrow * DPROJ + C_NQ + h * 64 + ks * 32 + fq * 8, C2, n2);
    n2 += __shfl_xor(n2, 16); n2 += __shfl_xor(n2, 32);
    const float km = __uint_as_float(((const unsigned*)(a.ws + WS_CTL))[layer * 64 + 16 + b * 4 + h]);
    const float bmax = ((const float*)(a.ws + WS_MISC))[8192 + layer];
    const float negb = -(sqrtf(n2 * km) + bmax * LOG2E);
    const float* rpb = a.in[I_RPB] + (size_t)(layer * 4 + h) * 15 * 31;
    const int rs = min(max(r - 4, 0), 248), cs = min(max(c - 8, 0), 48);
    f32x4 O[4]; float ls = 0.f;
#pragma unroll
    for (int dvb = 0; dvb < 4; ++dvb) O[dvb] = (f32x4){0.f, 0.f, 0.f, 0.f};
    const int nwh = (qblk == 0 || qblk == 3) ? 1 : 2, nwin = ctxq ? 0 : 8 * nwh, nsteps = nwin + 8;
    struct NaStep { bf16x8 kf[2][2]; s16x4 vlo[4], vhi[4]; float iv[2][4]; };
    auto load_step = [&](int st, NaStep& S) {
        int t, i; bool win;
        if (st < nwin) { win = true; if (nwh == 2) { t = st >> 1; i = st & 1; } else { t = st; i = (qblk == 3) ? 1 : 0; } }
        else { win = false; const int s2 = st - nwin; t = s2 >> 1; i = s2 & 1; }
        const int kr = rs + t;
        const int krow0 = win ? (b * SEQ + kr * 64) : (MX + b * CTXL + t * 64);
        const int key0 = win ? (CTXL + kr * 64) : (t * 64);
#pragma unroll
        for (int kbb = 0; kbb < 2; ++kbb) {
            const int kb = 2 * i + kbb;
#pragma unroll
            for (int ks = 0; ks < 2; ++ks) S.kf[kbb][ks] = *(const bf16x8*)(P + (size_t)(krow0 + kb * 16 + fr) * DPROJ + C_NK + h * 64 + ks * 32 + fq * 8);
#pragma unroll
            for (int j = 0; j < 4; ++j) {
                float iv = negb;
                if (win) { const int kc = kb * 16 + fq * 4 + j; const bool inw = (kc >= cs) && (kc < cs + 16);
                    const int co = min(max(kc - c + 15, 0), 30);
                    const float bias = rpb[(kr - r + 7) * 31 + co];
                    iv = inw ? (bias * LOG2E + negb) : -1e30f; }
                S.iv[kbb][j] = iv;
            }
        }
#pragma unroll
        for (int dvb = 0; dvb < 4; ++dvb) {
            const u16* vp = VTN + (size_t)(dvb * 16 + fr) * NKEY + key0 + (2 * i) * 16 + fq * 4;
            S.vlo[dvb] = *(const s16x4*)vp; S.vhi[dvb] = *(const s16x4*)(vp + 16);
        }
    };
    auto compute_step = [&](const NaStep& S) {
        f32x4 acc[2];
#pragma unroll
        for (int kbb = 0; kbb < 2; ++kbb) {
            acc[kbb] = (f32x4){S.iv[kbb][0], S.iv[kbb][1], S.iv[kbb][2], S.iv[kbb][3]};
#pragma unroll
            for (int ks = 0; ks < 2; ++ks) acc[kbb] = __builtin_amdgcn_mfma_f32_16x16x32_bf16(S.kf[kbb][ks], qf[ks], acc[kbb], 0, 0, 0);
#pragma unroll
            for (int j = 0; j < 4; ++j) acc[kbb][j] = __builtin_amdgcn_exp2f(acc[kbb][j]);
            ls += (acc[kbb][0] + acc[kbb][1]) + (acc[kbb][2] + acc[kbb][3]);
        }
        const bf16x8 pf = pack8(acc[0], acc[1]);
#pragma unroll
        for (int dvb = 0; dvb < 4; ++dvb) {
            const bf16x8 vf = __builtin_shufflevector(S.vlo[dvb], S.vhi[dvb], 0, 1, 2, 3, 4, 5, 6, 7);
            O[dvb] = __builtin_amdgcn_mfma_f32_16x16x32_bf16(vf, pf, O[dvb], 0, 0, 0);
        }
    };
    {
        NaStep SA, SB;
        load_step(0, SA);
#pragma unroll 1
        for (int st = 0; st < nsteps; st += 2) {
            load_step(st + 1, SB);
            compute_step(SA);
            if (st + 2 < nsteps) load_step(st + 2, SA);
            compute_step(SB);
        }
    }
    ls += __shfl_xor(ls, 16); ls += __shfl_xor(ls, 32);
    const float il = 1.0f / ls;
    u16* MIX = (u16*)(a.ws + WS_A);
#pragma unroll
    for (int dvb = 0; dvb < 4; ++dvb) {
        u32x2 w; w.x = pk2(O[dvb][0] * il, O[dvb][1] * il); w.y = pk2(O[dvb][2] * il, O[dvb][3] * il);
        *(u32x2*)(MIX + (size_t)qrow * D + 256 + h * 64 + dvb * 16 + fq * 4) = w;
    }
}


template <int QH> __device__ __forceinline__ void na_unit(const Args& a, int layer, int b, int h, int g, uchar* lds) {
    int tid = threadIdx.x; asm volatile("" : "+v"(tid)); const int lane = tid & 63, wave = __builtin_amdgcn_readfirstlane(tid >> 6), fr = lane & 15, fq = lane >> 4;
    const u16* P = (const u16*)(a.ws + WS_X);
    const u16* VTN = (const u16*)(a.ws + WS_VTN) + (size_t)(b * 4 + h) * 64 * NKEY;
    u16* Ks = (u16*)lds;
    u16* Vs = (u16*)(lds + 2 * 64 * 64 * 2);
    const int r = 8 * g + wave, rsw = min(max(r - 4, 0), 248);
    const float C2 = 0.125f * LOG2E;
    const float km = __uint_as_float(((const unsigned*)(a.ws + WS_CTL))[layer * 64 + 16 + b * 4 + h]);
    const float bmax = ((const float*)(a.ws + WS_MISC))[8192 + layer];
    const float* rpb = a.in[I_RPB] + (size_t)(layer * 4 + h) * 15 * 31;
    bf16x8 qf[2][2]; float negb[2], ls[2];
    unsigned mlo = 0u;
#pragma unroll
    for (int qq = 0; qq < 2; ++qq) {
        const int qblk = 2 * QH + qq;
        const int qrow = b * SEQ + r * 64 + qblk * 16 + fr; float n2 = 0.f;
#pragma unroll
        for (int ks = 0; ks < 2; ++ks) qf[qq][ks] = load_scaled8(P + (size_t)qrow * DPROJ + C_NQ + h * 64 + ks * 32 + fq * 8, C2, n2);
        n2 += __shfl_xor(n2, 16); n2 += __shfl_xor(n2, 32);
        negb[qq] = -(sqrtf(n2 * km) + bmax * LOG2E); ls[qq] = 0.f;
        const int c = qblk * 16 + fr, cs = min(max(c - 8, 0), 48);
#pragma unroll
        for (int kb = 0; kb < 4; ++kb)
#pragma unroll
            for (int j = 0; j < 4; ++j) { const int kc = kb * 16 + fq * 4 + j; const unsigned bit = (kc >= cs && kc < cs + 16) ? 1u : 0u; const int idx = (qq * 4 + kb) * 4 + j;
                mlo |= bit << idx; }
    }
    f32x4 O[2][4];
#pragma unroll
    for (int qq = 0; qq < 2; ++qq)
#pragma unroll
        for (int dvb = 0; dvb < 4; ++dvb) O[qq][dvb] = (f32x4){0.f, 0.f, 0.f, 0.f};
    const int lo = min(max(8 * g - 4, 0), 248), hi = min(max(8 * g + 3, 0), 248) + 7, nwin = hi - lo + 1, ntiles = nwin + 4;
    const int sr = tid >> 3, pc = tid & 7;
    auto kaddr = [&](int t) -> const u16* { const int krow = (t < nwin) ? (b * SEQ + (lo + t) * 64 + sr) : (MX + b * CTXL + (t - nwin) * 64 + sr); return P + (size_t)krow * DPROJ + C_NK + h * 64 + pc * 8; };
    auto vaddr = [&](int t) -> const u16* { const int key0 = (t < nwin) ? (CTXL + (lo + t) * 64) : ((t - nwin) * 64); return VTN + (size_t)sr * NKEY + key0 + pc * 8; };
    bf16x8 kreg = *(const bf16x8*)kaddr(0), vreg = *(const bf16x8*)vaddr(0);
    __syncthreads();
#pragma unroll 1
    for (int t = 0; t < ntiles; ++t) {
        u16* Kb = Ks + (t & 1) * 64 * 64; u16* Vb = Vs + (t & 1) * 64 * 72;
        *(bf16x8*)(Kb + sr * 64 + ((pc ^ ((sr >> 1) & 7)) * 8)) = kreg; *(bf16x8*)(Vb + sr * 72 + pc * 8) = vreg;
        __syncthreads();
        if (t + 1 < ntiles) { kreg = *(const bf16x8*)kaddr(t + 1); vreg = *(const bf16x8*)vaddr(t + 1); }
        const bool win = t < nwin; const int kr = lo + t;
        if (win && (kr < rsw || kr > rsw + 7)) continue;
        float bl[3][4];
        if (win) {
#pragma unroll
            for (int dl = 0; dl < 3; ++dl)
#pragma unroll
                for (int j = 0; j < 4; ++j) { const int co = min(max(16 * (dl - 1) + fq * 4 + j - fr + 15, 0), 30); bl[dl][j] = rpb[(kr - r + 7) * 31 + co] * LOG2E; }
        }
#pragma unroll
        for (int i = 0; i < 2; ++i) {
            bf16x8 kf[2][2], vf[4];
#pragma unroll
            for (int kbb = 0; kbb < 2; ++kbb)
#pragma unroll
                for (int ks = 0; ks < 2; ++ks) kf[kbb][ks] = *(const bf16x8*)(Kb + ((2 * i + kbb) * 16 + fr) * 64 + (((ks * 4 + fq) ^ (fr >> 1)) * 8));
#pragma unroll
            for (int dvb = 0; dvb < 4; ++dvb) { const u16* vp = Vb + (dvb * 16 + fr) * 72 + (2 * i) * 16 + fq * 4;
                const s16x4 vlo = *(const s16x4*)vp, vhi = *(const s16x4*)(vp + 16); vf[dvb] = __builtin_shufflevector(vlo, vhi, 0, 1, 2, 3, 4, 5, 6, 7); }
#pragma unroll
            for (int qq = 0; qq < 2; ++qq) {
                const int qblk = 2 * QH + qq;
                if (win && ((qblk == 0 && i == 1) || (qblk == 3 && i == 0))) continue;
                f32x4 p[2];
#pragma unroll
                for (int kbb = 0; kbb < 2; ++kbb) {
                    const int kb = 2 * i + kbb, dl = kb - qblk;
                    if (win && (dl < -1 || dl > 1)) { p[kbb] = (f32x4){0.f, 0.f, 0.f, 0.f}; continue; }
                    f32x4 acc;
#pragma unroll
                    for (int j = 0; j < 4; ++j) {
                        float iv = negb[qq];
                        if (win) { const int idx = (qq * 4 + kb) * 4 + j; const bool inw = (mlo >> idx) & 1u;
                            iv = inw ? (bl[(dl + 1) < 0 ? 0 : ((dl + 1) > 2 ? 2 : (dl + 1))][j] + negb[qq]) : -1e30f; }
                        acc[j] = iv;
                    }
#pragma unroll
                    for (int ks = 0; ks < 2; ++ks) acc = __builtin_amdgcn_mfma_f32_16x16x32_bf16(kf[kbb][ks], qf[qq][ks], acc, 0, 0, 0);
#pragma unroll
                    for (int j = 0; j < 4; ++j) acc[j] = __builtin_amdgcn_exp2f(acc[j]);
                    ls[qq] += (acc[0] + acc[1]) + (acc[2] + acc[3]);
                    p[kbb] = acc;
                }
                const bf16x8 pf = pack8(p[0], p[1]);
#pragma unroll
                for (int dvb = 0; dvb < 4; ++dvb) O[qq][dvb] = __builtin_amdgcn_mfma_f32_16x16x32_bf16(vf[dvb], pf, O[qq][dvb], 0, 0, 0);
            }
        }
    }
    u16* MIX = (u16*)(a.ws + WS_A);
#pragma unroll
    for (int qq = 0; qq < 2; ++qq) {
        const int qblk = 2 * QH + qq;
        float l = ls[qq]; l += __shfl_xor(l, 16); l += __shfl_xor(l, 32);
        const float il = 1.0f / l; const int qrow = b * SEQ + r * 64 + qblk * 16 + fr;
#pragma unroll
        for (int dvb = 0; dvb < 4; ++dvb) {
            u32x2 w; w.x = pk2(O[qq][dvb][0] * il, O[qq][dvb][1] * il); w.y = pk2(O[qq][dvb][2] * il, O[qq][dvb][3] * il);
            *(u32x2*)(MIX + (size_t)qrow * D + 256 + h * 64 + dvb * 16 + fq * 4) = w;
        }
    }
}


__device__ __forceinline__ void ctx_resid_gemm(const Args& a, const u16* A, const u16* Bt, int K, const float* gate, float coef, uchar* lds) {
    int tid = threadIdx.x; asm volatile("" : "+v"(tid)); const int lane = tid & 63, wave = __builtin_amdgcn_readfirstlane(tid >> 6), fr = lane & 15, fq = lane >> 4;
    float* red = (float*)lds;
    float* Hc = (float*)(a.ws + WS_HC);
    const int nks = K >> 5;
    for (int tile = blockIdx.x; tile < 256; tile += gridDim.x) {
        const int row0 = (tile >> 4) * 32, col0 = (tile & 15) * 64;
        f32x4 acc[2][4];
#pragma unroll
        for (int rb = 0; rb < 2; ++rb)
#pragma unroll
            for (int cb = 0; cb < 4; ++cb) acc[rb][cb] = (f32x4){0.f, 0.f, 0.f, 0.f};
#pragma unroll 4
        for (int ks = wave; ks < nks; ks += 8) {
            bf16x8 af[2], bfr[4];
#pragma unroll
            for (int rb = 0; rb < 2; ++rb) af[rb] = *(const bf16x8*)(A + (size_t)(row0 + rb * 16 + fr) * K + ks * 32 + fq * 8);
#pragma unroll
            for (int cb = 0; cb < 4; ++cb) bfr[cb] = *(const bf16x8*)(Bt + (size_t)(col0 + cb * 16 + fr) * K + ks * 32 + fq * 8);
#pragma unroll
            for (int rb = 0; rb < 2; ++rb)
#pragma unroll
                for (int cb = 0; cb < 4; ++cb) acc[rb][cb] = __builtin_amdgcn_mfma_f32_16x16x32_bf16(bfr[cb], af[rb], acc[rb][cb], 0, 0, 0);
        }
        __syncthreads();
#pragma unroll
        for (int rb = 0; rb < 2; ++rb)
#pragma unroll
            for (int cb = 0; cb < 4; ++cb) *(f32x4*)(red + wave * 2048 + (rb * 16 + fr) * 64 + cb * 16 + fq * 4) = acc[rb][cb];
        __syncthreads();
        {
            const int idx = tid * 4, rr = idx >> 6, cc = idx & 63;
            f32x4 sum = (f32x4){0.f, 0.f, 0.f, 0.f};
#pragma unroll
            for (int w = 0; w < 8; ++w) sum = sum + *(const f32x4*)(red + w * 2048 + idx);
            const f32x4 gv = *(const f32x4*)(gate + col0 + cc) * coef;
            f32x4* p = (f32x4*)(Hc + (size_t)(row0 + rr) * D + col0 + cc);
            *p = *p + gv * sum;
        }
    }
    __syncthreads();
}


#ifndef PROBE_DIFF
#define PROBE_DIFF 1
#endif
#ifndef PROBE_NA
#define PROBE_NA 1
#endif
#ifndef PROBE_G13
#define PROBE_G13 1
#endif
#ifndef PROBE_G1
#define PROBE_G1 1
#endif
#ifndef PROBE_PREP
#define PROBE_PREP 1
#endif
#ifndef PROBE_SYNC
#define PROBE_SYNC 0
#endif
#ifndef PROBE_CONV
#define PROBE_CONV 1
#endif
#ifndef PROBE_G3
#define PROBE_G3 1
#endif
#ifndef PROBE_NORM
#define PROBE_NORM 1
#endif
template <int PHMASK, int PH> __device__ __forceinline__ void phase_body(const Args& a, unsigned char* lds) {
    int tid = threadIdx.x; asm volatile("" : "+v"(tid)); const int lane = tid & 63, wave = __builtin_amdgcn_readfirstlane(tid >> 6), G = gridDim.x, bid = blockIdx.x;
    u16* const Abuf = (u16*)(a.ws + WS_A);
    u16* const Xbuf = (u16*)(a.ws + WS_X);
    if constexpr (PH == 0) { if constexpr ((PHMASK & 1) != 0) for (int rep = 0; rep < PROBE_PREP; ++rep) { __syncthreads(); phase_prep(a, lds); } }
    else if constexpr (PH == NPHASE - 1) { if constexpr ((PHMASK & 2) != 0) phase_final(a); }
    else {
        constexpr int layer = (PH - 1) / 12, sp = (PH - 1) % 12;
        constexpr bool last = (layer == 1);
        constexpr int Mpost = last ? MX : MT;
        if constexpr (sp == 0) { if constexpr ((PHMASK & 2) != 0) for (int rep = 0; rep < PROBE_NORM; ++rep) phase_norm(a, layer, 0, MT, layer == 0); }
        if constexpr (sp == 3) { if constexpr ((PHMASK & 2) != 0) for (int rep = 0; rep < PROBE_NORM; ++rep) phase_norm(a, layer, 1, MT, false); }
        if constexpr (sp == 9) { if constexpr ((PHMASK & 2) != 0) for (int rep = 0; rep < PROBE_NORM; ++rep) phase_norm(a, layer, 2, Mpost, false); }
        if constexpr ((sp == 1 || sp == 10) && (PHMASK & 4)) {
            const int M = (sp == 1) ? MT : Mpost;
            pg8::Gemm g{Abuf, (const u16*)(a.ws + WS_W13) + (size_t)(layer * 2 + (sp == 1 ? 0 : 1)) * 2 * DFF * D, M, 2 * DFF, D};
            pg8::StaticOrder S; S.init(M, 2 * DFF, G, bid);
            EpiSwiglu E{Xbuf};
            for (int rep = 0; rep < PROBE_G13; ++rep) pg8::gemm_phase<EpiSwiglu, pg8::StaticOrder, true, true>((LAS unsigned char*)lds, g, S, E);
        }
        if constexpr ((sp == 2 || sp == 11) && (PHMASK & 4)) {
            constexpr bool with_ctx = (sp == 2) || !last;
            const u16* W2t = (const u16*)(a.ws + WS_W2) + (size_t)(layer * 2 + (sp == 2 ? 0 : 1)) * D * DFF;
            pg8::Gemm g{Xbuf, W2t, MX, D, DFF};
            pg8::StaticOrder S; S.init(MX, D, G, bid);
            EpiResid E{a.out, (float*)(a.ws + WS_HC), modp(a, layer, 0, sp == 2 ? 2 : 8), 0.5f};
            pg8::gemm_phase<EpiResid, pg8::StaticOrder, true, true>((LAS unsigned char*)lds, g, S, E);
            if constexpr (with_ctx) ctx_resid_gemm(a, Xbuf + (size_t)MX * DFF, W2t, DFF, modp(a, layer, 2, sp == 2 ? 2 : 8), 0.5f, lds);
        }
        if constexpr (sp == 4 && (PHMASK & 4)) {
            pg8::Gemm g{Abuf, (const u16*)(a.ws + WS_WIN) + (size_t)layer * NPROJ * D, MT, NPROJ, D};
            pg8::StaticOrder S; S.init(MT, NPROJ, G, bid);
            EpiProj E{Xbuf};
            pg8::gemm_phase<EpiProj, pg8::StaticOrder, true, true>((LAS unsigned char*)lds, g, S, E);
        }
        if constexpr (sp == 5) {
            if constexpr ((PHMASK & 8) != 0) for (int u = bid; u < 2 * NCH; u += G) prep_unit(a, layer, u, lds);
            __syncthreads();
            if constexpr ((PHMASK & 16) != 0) for (int rep = 0; rep < PROBE_G1; ++rep) {
                const int gw = bid * 8 + wave, NGW = G * 8;
                for (int wu = gw; wu < 4096; wu += NGW) {
                    const int dir = wu & 1, h = (wu >> 1) & 3, xc = (wu >> 3) & 255, b = wu >> 11;
                    gla_g1_wave(a, layer, b, xc + 4, h, dir, lds + wave * 16384, lane);
                }
                for (int j = 0; j < 64; ++j) if ((j * 32) % NGW == gw) {
                    const int dir = j & 1, h = (j >> 1) & 3, c = (j >> 3) & 3, b = j >> 5;
                    gla_g1_wave(a, layer, b, c, h, dir, lds + wave * 16384, lane);
                }
            }
            __syncthreads();
            const int ncu = last ? 1024 : 1040;
            if constexpr ((PHMASK & 32) != 0) {
                bf16x8 wf[2][8];
                { const u16* PWT = (const u16*)(a.ws + WS_PWT) + (size_t)layer * 256 * 256; const int fr = lane & 15, fq = lane >> 4;
#pragma unroll
                  for (int nbi = 0; nbi < 2; ++nbi)
#pragma unroll
                    for (int ks = 0; ks < 8; ++ks) wf[nbi][ks] = *(const bf16x8*)(PWT + (size_t)((wave * 2 + nbi) * 16 + fr) * 256 + ks * 32 + fq * 8); }
                for (int rep = 0; rep < PROBE_CONV; ++rep) for (int u = bid; u < ncu; u += G) conv_unit(a, layer, u, lds, wf);
            }
        }
        if constexpr (sp == 6) {
            if constexpr ((PHMASK & 64) != 0) gla_scan(a, lds);
            if constexpr ((PHMASK & 128) != 0) for (int rep = 0; rep < PROBE_NA; ++rep) for (int u = bid; u < 512; u += G) { const int uu = u >> 1; if (u & 1) na_unit<1>(a, layer, uu >> 7, (uu >> 5) & 3, uu & 31, lds); else na_unit<0>(a, layer, uu >> 7, (uu >> 5) & 3, uu & 31, lds); }
            if constexpr ((PHMASK & 128) != 0 && !last) for (int wu = bid * 8 + wave; wu < 2 * 4 * 16; wu += G * 8) na_wave(a, layer, true, wu, lane);
            if constexpr ((PHMASK & 256) != 0) for (int rep = 0; rep < PROBE_DIFF; ++rep) for (int u = bid; u < 512; u += G) { const int b = u >> 8, h = (u >> 6) & 3, qb = u & 63; diff_unit(a, layer, b, h, b * SEQ + qb * 256, NCH, lds); }
            if constexpr ((PHMASK & 256) != 0 && !last) for (int u = bid; u < 8; u += G) { const int b = u >> 2, h = u & 3; diff_unit(a, layer, b, h, MX + b * CTXL, 4, lds); }
        }
        if constexpr (sp == 7) {
            __syncthreads();
            if constexpr ((PHMASK & 512) != 0) for (int rep = 0; rep < PROBE_G3; ++rep) for (int wu = bid * 8 + wave; wu < 2 * NCH * 4; wu += G * 8) { const int c = (wu >> 2) % NCH; if (last && c < 4) continue; gla_g3_wave(a, layer, wu, lds + wave * 16384, lane); }
        }
        if constexpr (sp == 8 && (PHMASK & 4)) {
            const u16* Wot = (const u16*)(a.ws + WS_WOUT) + (size_t)layer * D * D;
            pg8::Gemm g{Abuf, Wot, MX, D, D};
            pg8::StaticOrder S; S.init(MX, D, G, bid);
            EpiResid E{a.out, (float*)(a.ws + WS_HC), modp(a, layer, 0, 5), 1.0f};
            pg8::gemm_phase<EpiResid, pg8::StaticOrder, true, true>((LAS unsigned char*)lds, g, S, E);
            if constexpr (!last) ctx_resid_gemm(a, Abuf + (size_t)MX * D, Wot, D, modp(a, layer, 2, 5), 1.0f, lds);
        }
    }
}
template <int PHMASK, int PH> __device__ __forceinline__ void run_phase(const Args& a, int lo, int hi, unsigned char* lds, cg::grid_group& grid, const XcdBarrier& bar) {
    if (lo <= PH && PH < hi) { if (PH > lo) { if (PH == lo + 1) grid.sync(); else xcd_barrier(bar); } phase_body<PHMASK, PH>(a, lds); }
}
template <int PHMASK> __device__ __forceinline__ void run_phases(const Args& a, unsigned char* lds) {
    cg::grid_group grid = cg::this_grid();
    const int lo = a.ph_lo, hi = a.ph_hi;
    volatile LAS unsigned* st = (volatile LAS unsigned*)((LAS unsigned char*)lds + 131072);
    if (threadIdx.x < 2) st[threadIdx.x] = 0u;
    __syncthreads();
    const XcdBarrier bar = xcd_barrier_post((unsigned*)(a.ws + WS_CTL) + 16384, st);
#define RP(k) run_phase<PHMASK, k>(a, lo, hi, lds, grid, bar);
    RP(0) RP(1) RP(2) RP(3) RP(4) RP(5) RP(6) RP(7) RP(8) RP(9) RP(10) RP(11) RP(12) RP(13) RP(14) RP(15) RP(16) RP(17) RP(18) RP(19) RP(20) RP(21) RP(22) RP(23) RP(24) RP(25)
#undef RP
}
extern __shared__ __attribute__((aligned(16))) unsigned char dyn_lds[];
template <int PM> __global__ void __launch_bounds__(512, 2) part_fwd(Args a) { run_phases<PM>(a, dyn_lds); }
#ifndef MK_PER_PHASE
#define MK_PER_PHASE 0
#endif
#if !MK_PER_PHASE
__global__ void __launch_bounds__(512, 2) mega_fwd(Args a) { run_phases<0xFFFF>(a, dyn_lds); }
#define MAIN_KERNEL mega_fwd
#else
#define MAIN_KERNEL part_fwd<4>
#endif
#ifndef MK_PER_PHASE
#define MK_PER_PHASE 0
#endif
extern "C" void kernel_launch(void* const* d_in, const int* in_sizes, int n_in, void* d_out, int out_size, void* d_ws, size_t ws_size, hipStream_t stream) {
    static int grid = 0;
    if (grid == 0) {
        if (n_in != 33 || ws_size < WS_END) { fprintf(stderr, "kernel_launch: unexpected n_in %d / ws_size %zu (need %zu)\n", n_in, ws_size, (size_t)WS_END); grid = -1; return; }
        int dev = 0, cus = 0, per_cu = 0;
        hipGetDevice(&dev); hipDeviceGetAttribute(&cus, hipDeviceAttributeMultiprocessorCount, dev);
        if (hipFuncSetAttribute((const void*)MAIN_KERNEL, hipFuncAttributeMaxDynamicSharedMemorySize, LDS_BYTES) != hipSuccess) { fprintf(stderr, "kernel_launch: hipFuncSetAttribute failed\n"); grid = -1; return; }
#if MK_PER_PHASE
        (void)hipFuncSetAttribute((const void*)part_fwd<1>, hipFuncAttributeMaxDynamicSharedMemorySize, LDS_BYTES); (void)hipFuncSetAttribute((const void*)part_fwd<2>, hipFuncAttributeMaxDynamicSharedMemorySize, LDS_BYTES);
        (void)hipFuncSetAttribute((const void*)part_fwd<4>, hipFuncAttributeMaxDynamicSharedMemorySize, LDS_BYTES); (void)hipFuncSetAttribute((const void*)part_fwd<56>, hipFuncAttributeMaxDynamicSharedMemorySize, LDS_BYTES);
        (void)hipFuncSetAttribute((const void*)part_fwd<448>, hipFuncAttributeMaxDynamicSharedMemorySize, LDS_BYTES); (void)hipFuncSetAttribute((const void*)part_fwd<512>, hipFuncAttributeMaxDynamicSharedMemorySize, LDS_BYTES);
#endif
        if (hipOccupancyMaxActiveBlocksPerMultiprocessor(&per_cu, (const void*)MAIN_KERNEL, 512, LDS_BYTES) != hipSuccess || per_cu < 1) { fprintf(stderr, "kernel_launch: occupancy query says %d\n", per_cu); per_cu = 1; }
        (void)hipGetLastError();
        grid = cus;
    }
    if (grid < 0) return;
    (void)hipMemsetAsync((char*)d_ws + WS_CTL, 0, 131072, stream);
    Args a{};
    for (int i = 0; i < 33; ++i) a.in[i] = (const float*)d_in[i];
    a.out = (float*)d_out; a.ws = (unsigned char*)d_ws;
#if MK_PER_PHASE
    for (int ph = 0; ph < NPHASE; ++ph) {
        a.ph_lo = ph; a.ph_hi = ph + 1;
        const int sp = (ph == 0 || ph == NPHASE - 1) ? -1 : (ph - 1) % 12;
        if (ph == 0) hipLaunchKernelGGL(part_fwd<1>, dim3(grid), dim3(512), LDS_BYTES, stream, a);
        else if (sp == -1 || sp == 0 || sp == 3 || sp == 9) hipLaunchKernelGGL(part_fwd<2>, dim3(grid), dim3(512), LDS_BYTES, stream, a);
        else if (sp == 5) hipLaunchKernelGGL(part_fwd<56>, dim3(grid), dim3(512), LDS_BYTES, stream, a);
        else if (sp == 6) hipLaunchKernelGGL(part_fwd<448>, dim3(grid), dim3(512), LDS_BYTES, stream, a);
        else if (sp == 7) hipLaunchKernelGGL(part_fwd<512>, dim3(grid), dim3(512), LDS_BYTES, stream, a);
        else hipLaunchKernelGGL(part_fwd<4>, dim3(grid), dim3(512), LDS_BYTES, stream, a);
    }
#else
    a.ph_lo = 0; a.ph_hi = NPHASE;
    void* args[] = {&a};
    hipError_t e = hipLaunchCooperativeKernel((const void*)mega_fwd, dim3(grid), dim3(512), args, LDS_BYTES, stream);
    if (e != hipSuccess) fprintf(stderr, "kernel_launch: cooperative launch failed: %s (grid %d)\n", hipGetErrorString(e), grid);
#endif
}
```

```cpp
#include <hip/hip_runtime.h>
#include <hip/hip_cooperative_groups.h>
#include <cstdio>
#include <cstdint>
namespace cg = cooperative_groups;
#define MK_PER_PHASE 0
namespace pg8 {
#define PG8_LAS __attribute__((address_space(3)))
typedef unsigned short bf16_t;
typedef short bf16x8 __attribute__((ext_vector_type(8)));
typedef float f32x4 __attribute__((ext_vector_type(4)));
typedef unsigned u32x4 __attribute__((ext_vector_type(4)));
constexpr int BM = 256, BK = 64, HALF = 128, HTB = HALF * BK * 2  , STAGE_BYTES = 8 * HTB, NXCD = 8, WGM = 8;

__host__ __device__ __forceinline__ int lds_byte(int r, int c) { const int st = (r >> 4) * 2 + (c >> 5), rr = r & 15, cc = c & 31, ob = rr * 64 + cc * 2; return st * 1024 + (ob ^ (((ob >> 9) & 1) << 5)); }
__host__ __device__ __forceinline__ void stage_rc(int b, int& R, int& C) { const int st = b / 1024, sb = b % 1024, swz = sb ^ (((sb >> 9) & 1) << 5); R = (st >> 1) * 16 + swz / 64; C = (st & 1) * 32 + (swz % 64) / 2; }
__host__ __device__ __forceinline__ int perm32(int rho) { const int n = rho >> 4, i = rho & 15; return 8 * (i >> 2) + 4 * n + (i & 3); }

struct Unit { int pm, pn; };
struct Gemm { const bf16_t* A; const bf16_t* Bt; int M, N, K; };

struct StaticOrder {
    int nM, nN, nwg, G, c;
    __host__ __device__ void init(int M, int N, int G_, int c_) { nM = M / BM; nN = N / BM; nwg = nM * nN; G = G_; c = c_; }
    __host__ __device__ bool next(int i, Unit& u) const {
        const long L = (long)i * G + c; if (L >= nwg) return false;
        int wgid = (int)L; { const int q = nwg / NXCD, r = nwg % NXCD, xcd = wgid % NXCD, off = wgid / NXCD; wgid = (xcd < r ? xcd * (q + 1) : r * (q + 1) + (xcd - r) * q) + off; }
        const int nig = WGM * nN, gid = wgid / nig, fm = gid * WGM, gsz = (nM - fm) < WGM ? (nM - fm) : WGM;
        u.pm = fm + ((wgid % nig) % gsz); u.pn = (wgid % nig) / gsz; return true;
    }
    __device__ __forceinline__ void a_ready(const Unit&) const {}
    __device__ __forceinline__ void done(const Unit&) const {}
};

__device__ __forceinline__ unsigned cvt_pk_bf16(float lo, float hi) { unsigned r; asm volatile("v_cvt_pk_bf16_f32 %0, %1, %2" : "=v"(r) : "v"(lo), "v"(hi)); return r; }
template <class Epi, class Sched, bool ALIGN_EPI = false, bool SP2 = false>
__device__ __forceinline__ void gemm_phase(PG8_LAS unsigned char* lds, const Gemm g, const Sched& S, const Epi& E) {
    int tid_l = threadIdx.x; asm volatile("" : "+v"(tid_l)); const int tid = tid_l, wid = __builtin_amdgcn_readfirstlane(tid >> 6), lane = tid & 63, wr = wid >> 2, wc = wid & 3, fr = lane & 15, fq = lane >> 4;
    const int K = g.K, nt = K / BK;
    unsigned voffA[2], voffB[2];
#pragma unroll
    for (int i = 0; i < 2; ++i) { int R, C; stage_rc(tid * 16 + i * 8192, R, C); const int Rb = Epi::PERM ? ((R & ~31) + perm32(R & 31)) : R;
        voffA[i] = (unsigned)(R * K + C) * 2u; voffB[i] = (unsigned)(Rb * K + C) * 2u; }
    const size_t kstep = (size_t)(BK * 2);
    const size_t hstep = (size_t)HALF * K * 2;
    const size_t tstep = 2 * hstep;
    const unsigned ldsw = (unsigned)wid * 1024u;
    const int aoff = lds_byte(wr * 64 + fr, fq * 8), boff = lds_byte(wc * 32 + fr, fq * 8);
#define PG8_SA(b, h) (((b) * 2 + (h)) * HTB)
#define PG8_SB(b, h) ((4 + (b) * 2 + (h)) * HTB)
#define PG8_STAGE(bufoff, gbase, voff) do { _Pragma("unroll") for (int _i = 0; _i < 2; ++_i) \
        __builtin_amdgcn_global_load_lds((const unsigned*)((const char*)(gbase) + (voff)[_i]), (PG8_LAS unsigned*)(lds + (bufoff) + ldsw + _i * 8192), 16, 0, 0); } while (0)
#define PG8_LDA(dst, b, h) do { _Pragma("unroll") for (int m = 0; m < 4; ++m) _Pragma("unroll") for (int k = 0; k < 2; ++k) dst[m][k] = *(const PG8_LAS bf16x8*)(lds + PG8_SA(b, h) + aoff + m * 2048 + k * 1024); } while (0)
#define PG8_LDB(dst, b, h) do { _Pragma("unroll") for (int n = 0; n < 2; ++n) _Pragma("unroll") for (int k = 0; k < 2; ++k) dst[n][k] = *(const PG8_LAS bf16x8*)(lds + PG8_SB(b, h) + boff + n * 2048 + k * 1024); } while (0)
#define PG8_MMA(ai, bj, At, Bt) do { __builtin_amdgcn_s_setprio(1); _Pragma("unroll") for (int m = 0; m < 4; ++m) _Pragma("unroll") for (int n = 0; n < 2; ++n) _Pragma("unroll") for (int k = 0; k < 2; ++k) \
        acc[ai][bj][m][n] = __builtin_amdgcn_mfma_f32_16x16x32_bf16(Bt[n][k], At[m][k], acc[ai][bj][m][n], 0, 0, 0); __builtin_amdgcn_s_setprio(0); } while (0)
#define PG8_WAIT_V(n) asm volatile("s_waitcnt vmcnt(" #n ")" ::: "memory")
#define PG8_WAIT_L(n) asm volatile("s_waitcnt lgkmcnt(" #n ")" ::: "memory")
#define PG8_BAR __builtin_amdgcn_s_barrier()
#define PG8_SCHED __builtin_amdgcn_sched_barrier(0)
    Unit cur, nxt; int ui = 0;
    if (!S.next(0, cur)) return;
    f32x4 acc[2][2][4][2];
#pragma unroll
    for (int a = 0; a < 2; ++a)
#pragma unroll
        for (int b = 0; b < 2; ++b)
#pragma unroll
            for (int m = 0; m < 4; ++m)
#pragma unroll
                for (int n = 0; n < 2; ++n) acc[a][b][m][n] = (f32x4){0.f, 0.f, 0.f, 0.f};
    bf16x8 At[4][2], B0[2][2], B1[2][2];
    const char* cA = (const char*)g.A + (size_t)cur.pm * tstep; const char* cB = (const char*)g.Bt + (size_t)cur.pn * tstep;
    S.a_ready(cur);
    if constexpr (SP2) {
        PG8_STAGE(PG8_SB(0, 0), cB, voffB); PG8_STAGE(PG8_SB(0, 1), cB + hstep, voffB); PG8_STAGE(PG8_SA(0, 0), cA, voffA); PG8_STAGE(PG8_SA(0, 1), cA + hstep, voffA);
        if (wr == 1) PG8_BAR;
        PG8_WAIT_V(2); PG8_BAR;
        PG8_STAGE(PG8_SB(1, 0), cB + kstep, voffB); PG8_STAGE(PG8_SA(1, 0), cA + kstep, voffA); PG8_STAGE(PG8_SB(1, 1), cB + hstep + kstep, voffB);
        PG8_WAIT_V(6); PG8_BAR;
    } else {
        PG8_STAGE(PG8_SB(0, 0), cB, voffB); PG8_STAGE(PG8_SA(0, 0), cA, voffA); PG8_STAGE(PG8_SB(0, 1), cB + hstep, voffB); PG8_STAGE(PG8_SA(0, 1), cA + hstep, voffA);
        if (wr == 1) PG8_BAR;
        PG8_WAIT_V(4); PG8_BAR;
        PG8_STAGE(PG8_SB(1, 0), cB + kstep, voffB); PG8_STAGE(PG8_SA(1, 0), cA + kstep, voffA); PG8_STAGE(PG8_SB(1, 1), cB + hstep + kstep, voffB);
        PG8_WAIT_V(6); PG8_BAR;
    }
    for (;;) {
        const bool has_next = S.next(ui + 1, nxt);
        const char* nA = has_next ? (const char*)g.A + (size_t)nxt.pm * tstep : cA; const char* nB = has_next ? (const char*)g.Bt + (size_t)nxt.pn * tstep : cB;
        for (int t = 0; t < nt; t += 2) {
            const bool last = (t == nt - 2);
            const char* a1 = cA + (size_t)(t + 1) * kstep;
            const char* a2 = last ? nA : cA + (size_t)(t + 2) * kstep; const char* b2 = last ? nB : cB + (size_t)(t + 2) * kstep;
            const char* a3 = a2 + kstep; const char* b3 = b2 + kstep;
            if (last && has_next) S.a_ready(nxt);
            if constexpr (SP2) {
            PG8_LDB(B0, 0, 0); PG8_LDB(B1, 0, 1); PG8_SCHED; PG8_LDA(At, 0, 0); PG8_STAGE(PG8_SA(1, 1), a1 + hstep, voffA);
            PG8_WAIT_V(8); PG8_WAIT_L(0); PG8_BAR; PG8_MMA(0, 0, At, B0); PG8_MMA(0, 1, At, B1); PG8_BAR; PG8_SCHED;
            PG8_LDA(At, 0, 1); PG8_STAGE(PG8_SB(0, 0), b2, voffB); PG8_STAGE(PG8_SB(0, 1), b2 + hstep, voffB); PG8_STAGE(PG8_SA(0, 0), a2, voffA);
            PG8_WAIT_V(8); PG8_WAIT_L(0); PG8_BAR; PG8_MMA(1, 0, At, B0); PG8_MMA(1, 1, At, B1); PG8_BAR; PG8_SCHED;
            PG8_LDB(B0, 1, 0); PG8_LDB(B1, 1, 1); PG8_SCHED; PG8_LDA(At, 1, 0); PG8_STAGE(PG8_SA(0, 1), a2 + hstep, voffA);
            PG8_WAIT_V(8); PG8_WAIT_L(0); PG8_BAR; PG8_MMA(0, 0, At, B0); PG8_MMA(0, 1, At, B1); PG8_BAR; PG8_SCHED;
            PG8_LDA(At, 1, 1); PG8_STAGE(PG8_SB(1, 0), b3, voffB); PG8_STAGE(PG8_SB(1, 1), b3 + hstep, voffB); PG8_STAGE(PG8_SA(1, 0), a3, voffA);
            PG8_WAIT_V(8); PG8_WAIT_L(0); PG8_BAR; PG8_MMA(1, 0, At, B0); PG8_MMA(1, 1, At, B1); PG8_BAR; PG8_SCHED;
            } else {
            PG8_LDB(B0, 0, 0); PG8_SCHED; PG8_LDA(At, 0, 0); PG8_STAGE(PG8_SA(1, 1), a1 + hstep, voffA);
            PG8_WAIT_L(8); PG8_BAR; PG8_WAIT_L(0); PG8_MMA(0, 0, At, B0); PG8_BAR; PG8_SCHED;
            PG8_LDB(B1, 0, 1); PG8_STAGE(PG8_SB(0, 0), b2, voffB);
            PG8_BAR; PG8_WAIT_L(0); PG8_MMA(0, 1, At, B1); PG8_BAR;
            PG8_LDA(At, 0, 1); PG8_STAGE(PG8_SA(0, 0), a2, voffA);
            PG8_BAR; PG8_WAIT_L(0); PG8_MMA(1, 0, At, B0); PG8_BAR; PG8_SCHED;
            PG8_STAGE(PG8_SB(0, 1), b2 + hstep, voffB);
            PG8_WAIT_V(6); PG8_BAR; PG8_MMA(1, 1, At, B1); PG8_BAR;
            PG8_LDB(B0, 1, 0); PG8_SCHED; PG8_LDA(At, 1, 0); PG8_STAGE(PG8_SA(0, 1), a2 + hstep, voffA);
            PG8_WAIT_L(8); PG8_BAR; PG8_WAIT_L(0); PG8_MMA(0, 0, At, B0); PG8_BAR; PG8_SCHED;
            PG8_LDB(B1, 1, 1); PG8_STAGE(PG8_SB(1, 0), b3, voffB);
            PG8_BAR; PG8_WAIT_L(0); PG8_MMA(0, 1, At, B1); PG8_BAR;
            PG8_LDA(At, 1, 1); PG8_STAGE(PG8_SA(1, 0), a3, voffA);
            PG8_BAR; PG8_WAIT_L(0); PG8_MMA(1, 0, At, B0); PG8_BAR; PG8_SCHED;
            PG8_STAGE(PG8_SB(1, 1), b3 + hstep, voffB);
            PG8_WAIT_V(6); PG8_BAR; PG8_MMA(1, 1, At, B1); PG8_BAR;
            }
        }
        if constexpr (ALIGN_EPI) { if (wr == 0) PG8_BAR; }
        if constexpr (!Epi::AFTER_DRAIN) { E(acc, cur, wr, wc, fr, fq); S.done(cur); }
        if (!has_next) break;
#pragma unroll
        for (int a = 0; a < 2; ++a)
#pragma unroll
            for (int b = 0; b < 2; ++b)
#pragma unroll
                for (int m = 0; m < 4; ++m)
#pragma unroll
                    for (int n = 0; n < 2; ++n) acc[a][b][m][n] = (f32x4){0.f, 0.f, 0.f, 0.f};
        cur = nxt; cA = nA; cB = nB; ++ui;
        if constexpr (ALIGN_EPI) { if (wr == 1) PG8_BAR; }
    }
    PG8_WAIT_V(0);
    if constexpr (!ALIGN_EPI) { if (wr == 0) PG8_BAR; }
    PG8_BAR;
    if constexpr (Epi::AFTER_DRAIN) { E.fused(acc, cur, wr, wc, fr, fq, lds, wid, lane); S.done(cur); }
#undef PG8_SA
#undef PG8_SB
#undef PG8_STAGE
#undef PG8_LDA
#undef PG8_LDB
#undef PG8_MMA
#undef PG8_WAIT_V
#undef PG8_WAIT_L
#undef PG8_BAR
#undef PG8_SCHED
}
}

#define LAS __attribute__((address_space(3)))
typedef unsigned short u16;
typedef unsigned char uchar;
typedef short bf16x8 __attribute__((ext_vector_type(8)));
typedef short s16x4 __attribute__((ext_vector_type(4)));
typedef float f32x4 __attribute__((ext_vector_type(4)));
typedef unsigned u32x4 __attribute__((ext_vector_type(4)));
typedef unsigned u32x2 __attribute__((ext_vector_type(2)));

constexpr int D = 1024, SEQ = 16384, CTXL = 256, DFF = 2816, DPROJ = 2848, NPROJ = 3072;
constexpr int MX = 2 * SEQ, MC = 2 * CTXL, MT = MX + MC;
constexpr int NKEY = CTXL + SEQ, NCH = NKEY / 64;
constexpr int C_GQ = 0, C_GK = 128, C_GV = 256, C_GG = 512, C_AF = 768, C_NQ = 800, C_NK = 1056, C_NV = 1312, C_DQ = 1568, C_DK = 1824, C_DV = 2080, C_CA = 2336, C_CG = 2592;
constexpr float LOG2E = 1.4426950408889634f;

constexpr size_t MiB = 1u << 20;
constexpr size_t WS_CTL = 0, WS_MOD = 1 * MiB, WS_MISC = 1 * MiB + 512 * 1024, WS_HC = 2 * MiB, WS_PWT = 4 * MiB, WS_W13 = 8 * MiB, WS_W2 = 52 * MiB, WS_WIN = 74 * MiB,
                 WS_WOUT = 86 * MiB, WS_A = 90 * MiB, WS_X = 155 * MiB, WS_VTD = 336 * MiB, WS_VTN = 353 * MiB, WS_U = 370 * MiB, WS_DEC = 403 * MiB, WS_BC = 404 * MiB, WS_END = 437 * MiB;
constexpr int LDS_BYTES = 131072 + 256;
constexpr int NPHASE = 26;

struct Args { const float* in[33]; float* out; unsigned char* ws; int ph_lo, ph_hi; };

enum { I_X = 0, I_C, I_CTX, I_CCTX, I_ADAW, I_ADAB, I_NF1, I_F1W13, I_F1W2, I_NMIX, I_WIN, I_WAF, I_BAF, I_WAB, I_BAB, I_GNORM, I_RPB, I_LQ1, I_LK1, I_LQ2, I_LK2, I_DNORM,
       I_CDW, I_CDWB, I_CLNG, I_CLNB, I_CPW, I_CPWB, I_WOUT, I_NF2, I_F2W13, I_F2W2, I_FNORM };

__device__ __forceinline__ float bf2f(unsigned short h) { return __uint_as_float(((unsigned)h) << 16); }
__device__ __forceinline__ unsigned short f2bf(float f) { unsigned u = __float_as_uint(f); return (unsigned short)((u + 0x7fffu + ((u >> 16) & 1u)) >> 16); }
__device__ __forceinline__ unsigned pk2(float lo, float hi) { return (unsigned)f2bf(lo) | ((unsigned)f2bf(hi) << 16); }
__device__ __forceinline__ float wave_sum(float v) {
#pragma unroll
    for (int o = 1; o < 64; o <<= 1) v += __shfl_xor(v, o);
    return v;
}
__device__ __forceinline__ float silu_f(float x) { return x * __builtin_amdgcn_rcpf(1.0f + __expf(-x)); }
#define WAVE_SYNC() do { asm volatile("s_waitcnt lgkmcnt(0)" ::: "memory"); __builtin_amdgcn_wave_barrier(); } while (0)
__device__ __forceinline__ int row_of(int b, int c, int tk) { return (c < 4) ? (MX + b * CTXL + c * 64 + tk) : (b * SEQ + (c - 4) * 64 + tk); }
__device__ __forceinline__ float* hrow(const Args& a, int row) { return (row < MX) ? (a.out + (size_t)row * D) : ((float*)(a.ws + WS_HC) + (size_t)(row - MX) * D); }
__device__ __forceinline__ const float* modp(const Args& a, int layer, int g, int j) { return (const float*)(a.ws + WS_MOD) + ((size_t)(layer * 3 + g) * 9 + j) * D; }

struct EpiSwiglu {
    static constexpr bool PERM = true, AFTER_DRAIN = false;
    u16* O;
    __device__ __forceinline__ void operator()(const f32x4 (&acc)[2][2][4][2], const pg8::Unit& u, int wr, int wc, int fr, int fq) const {
        const int row0 = u.pm * 256 + wr * 64 + fr, col0 = u.pn * 128 + wc * 32 + 8 * fq;
#pragma unroll
        for (int ai = 0; ai < 2; ++ai)
#pragma unroll
            for (int m = 0; m < 4; ++m) {
                u16* rowp = O + (size_t)(row0 + ai * 128 + m * 16) * DFF + col0;
                const f32x4 a0 = acc[ai][0][m][0], a1 = acc[ai][0][m][1], u0 = acc[ai][1][m][0], u1 = acc[ai][1][m][1];
                float h[8];
#pragma unroll
                for (int e = 0; e < 4; ++e) { h[e] = silu_f(a0[e]) * u0[e]; h[4 + e] = silu_f(a1[e]) * u1[e]; }
                u32x4 w; w.x = pg8::cvt_pk_bf16(h[0], h[1]); w.y = pg8::cvt_pk_bf16(h[2], h[3]); w.z = pg8::cvt_pk_bf16(h[4], h[5]); w.w = pg8::cvt_pk_bf16(h[6], h[7]);
                *(u32x4*)rowp = w;
            }
    }
};
struct EpiResid {
    static constexpr bool PERM = false, AFTER_DRAIN = false;
    float* hx; float* hc; const float* gate0;
    float coef;
    __device__ __forceinline__ void operator()(const f32x4 (&acc)[2][2][4][2], const pg8::Unit& u, int wr, int wc, int fr, int fq) const {
        const int g = u.pm < 64 ? 0 : (u.pm < 128 ? 1 : 2);
        float* base = (u.pm < 128) ? (hx + (size_t)u.pm * 256 * D) : (hc + (size_t)(u.pm - 128) * 256 * D);
        const int row0 = wr * 64 + fr, col0 = u.pn * 256 + wc * 32 + 4 * fq;
        const float* gate = gate0 + (size_t)g * 9 * D;
        f32x4 gv[2][2];
#pragma unroll
        for (int bj = 0; bj < 2; ++bj)
#pragma unroll
            for (int n = 0; n < 2; ++n) gv[bj][n] = *(const f32x4*)(gate + col0 + bj * 128 + n * 16) * coef;
#pragma unroll
        for (int ai = 0; ai < 2; ++ai)
#pragma unroll
            for (int m = 0; m < 4; ++m) {
                float* rowp = base + (size_t)(row0 + ai * 128 + m * 16) * D + col0;
#pragma unroll
                for (int bj = 0; bj < 2; ++bj)
#pragma unroll
                    for (int n = 0; n < 2; ++n) { f32x4* p = (f32x4*)(rowp + bj * 128 + n * 16); *p = *p + gv[bj][n] * acc[ai][bj][m][n]; }
            }
    }
};
struct EpiProj {
    static constexpr bool PERM = true, AFTER_DRAIN = false;
    u16* O;
    __device__ __forceinline__ void operator()(const f32x4 (&acc)[2][2][4][2], const pg8::Unit& u, int wr, int wc, int fr, int fq) const {
        const int row0 = u.pm * 256 + wr * 64 + fr, col0 = u.pn * 256 + wc * 32 + 8 * fq;
#pragma unroll
        for (int ai = 0; ai < 2; ++ai)
#pragma unroll
            for (int m = 0; m < 4; ++m) {
                u16* rowp = O + (size_t)(row0 + ai * 128 + m * 16) * DPROJ;
#pragma unroll
                for (int bj = 0; bj < 2; ++bj) {
                    const int col = col0 + bj * 128;
                    if (col < DPROJ) {
                        const f32x4 v0 = acc[ai][bj][m][0], v1 = acc[ai][bj][m][1];
                        u32x4 w; w.x = pg8::cvt_pk_bf16(v0[0], v0[1]); w.y = pg8::cvt_pk_bf16(v0[2], v0[3]); w.z = pg8::cvt_pk_bf16(v1[0], v1[1]); w.w = pg8::cvt_pk_bf16(v1[2], v1[3]);
                        *(u32x4*)(rowp + col) = w;
                    }
                }
            }
    }
};

__device__ __forceinline__ void transpose_item(const float* W, int N, u16* WT, int K, int k0, int n0, int drow0, float* scr, int lane) {
    float wv[32];
#pragma unroll
    for (int i = 0; i < 32; ++i) { const int kk = 2 * i + (lane >> 5); wv[i] = W[(size_t)(k0 + kk) * N + n0 + (lane & 31)]; }
#pragma unroll
    for (int i = 0; i < 32; ++i) { const int kk = 2 * i + (lane >> 5); scr[kk * 33 + (lane & 31)] = wv[i]; }
    WAVE_SYNC();
    const int c = lane & 7;
#pragma unroll
    for (int j = 0; j < 4; ++j) {
        const int n = (lane >> 3) + 8 * j; const float* s = scr + (8 * c) * 33 + n;
        u32x4 o; o.x = pk2(s[0 * 33], s[1 * 33]); o.y = pk2(s[2 * 33], s[3 * 33]); o.z = pk2(s[4 * 33], s[5 * 33]); o.w = pk2(s[6 * 33], s[7 * 33]);
        *(u32x4*)(WT + (size_t)(drow0 + n) * K + k0 + 8 * c) = o;
    }
    WAVE_SYNC();
}

__device__ __forceinline__ void phase_prep(const Args& a, uchar* lds) {
    int tid = threadIdx.x; asm volatile("" : "+v"(tid)); const int lane = tid & 63, wave = tid >> 6, G = gridDim.x, bid = blockIdx.x;
    {
        float* sc = (float*)lds;
        float* red = sc + 3 * D;
        float* mod = (float*)(a.ws + WS_MOD);
        for (int i = tid; i < 3 * D; i += 512) { const int g = i >> 10, k = i & 1023; const float v = (g < 2) ? a.in[I_C][g * D + k] : a.in[I_CCTX][k]; sc[i] = silu_f(v); }
        __syncthreads();
        for (int u = bid; u < 2 * 144; u += G) {
            const int l = u / 144, cgp = u % 144, kc = tid >> 6, col = tid & 63;
            const float* w = a.in[I_ADAW] + ((size_t)l * D + kc * 128) * 9216 + cgp * 64 + col;
            float a0 = 0.f, a1 = 0.f, a2 = 0.f;
#pragma unroll 32
            for (int kk = 0; kk < 128; ++kk) { const float wv = w[(size_t)kk * 9216]; const int k = kc * 128 + kk; a0 += sc[k] * wv; a1 += sc[D + k] * wv; a2 += sc[2 * D + k] * wv; }
            red[(kc * 3 + 0) * 64 + col] = a0; red[(kc * 3 + 1) * 64 + col] = a1; red[(kc * 3 + 2) * 64 + col] = a2;
            __syncthreads();
            if (tid < 192) {
                const int g = tid >> 6, cc = tid & 63; float s = a.in[I_ADAB][l * 9216 + cgp * 64 + cc];
#pragma unroll
                for (int k8 = 0; k8 < 8; ++k8) s += red[(k8 * 3 + g) * 64 + cc];
                mod[(size_t)(l * 3 + g) * 9216 + cgp * 64 + cc] = s;
            }
            __syncthreads();
        }
        __syncthreads();
    }
    if (bid == 0) {
        float* tr = (float*)(a.ws + WS_MISC);
        for (int i = tid; i < 2560; i += 512) {
            const int j = i & 7; const int pos = (i < 2048) ? (i >> 3) : ((i - 2048) >> 3);
            const double inv = ((j & 1) ? 0.31622776601683794 : 1.0) * ((j >> 1) == 0 ? 1.0 : ((j >> 1) == 1 ? 0.1 : ((j >> 1) == 2 ? 0.01 : 0.001))), ang = (double)pos * inv;
            float* dst = (i < 2048) ? (tr + (size_t)i * 2) : (tr + 4096 + (size_t)(i - 2048) * 2);
            dst[0] = (float)cos(ang); dst[1] = (float)sin(ang);
        }
    }
    if (bid == (1 % G) && wave < 2) {
        const float* rpb = a.in[I_RPB] + wave * 4 * 15 * 31; float m = 0.f;
        for (int i = lane; i < 4 * 15 * 31; i += 64) m = fmaxf(m, fabsf(rpb[i]));
#pragma unroll
        for (int o = 1; o < 64; o <<= 1) m = fmaxf(m, __shfl_xor(m, o));
        if (lane == 0) ((float*)(a.ws + WS_MISC))[8192 + wave] = m;
    }
    {
        const size_t gt = (size_t)bid * 512 + tid, GT = (size_t)G * 512;
        for (int l = 0; l < 2; ++l) { u32x4* z = (u32x4*)((u16*)(a.ws + WS_WIN) + ((size_t)l * NPROJ + DPROJ) * D);
            for (size_t i = gt; i < (size_t)(NPROJ - DPROJ) * D / 8; i += GT) z[i] = (u32x4){0u, 0u, 0u, 0u}; }
    }
    {
        float* scr = (float*)lds + wave * (64 * 33);
        const int gw = bid * 8 + wave, NGW = G * 8;
        constexpr int I13 = 16 * 176, I2 = 44 * 32, IIN = 16 * 89, IOUT = 16 * 32, IPW = 4 * 8;
        constexpr int NIT = 4 * I13 + 4 * I2 + 2 * IIN + 2 * IOUT + 2 * IPW;
        for (int it = gw; it < NIT; it += NGW) {
            int r = it;
            if (r < 4 * I13) { const int mi = r / I13; r -= mi * I13; const int l = mi >> 1, f = mi & 1, kb = r / 176, nb = r % 176, n0 = nb * 32;
                const int j = (n0 < DFF) ? n0 : n0 - DFF; const int drow0 = 256 * (j >> 7) + (j & 127) + ((n0 < DFF) ? 0 : 128);
                transpose_item(a.in[f ? I_F2W13 : I_F1W13] + (size_t)l * D * 2 * DFF, 2 * DFF, (u16*)(a.ws + WS_W13) + (size_t)mi * 2 * DFF * D, D, kb * 64, n0, drow0, scr, lane); continue; }
            r -= 4 * I13;
            if (r < 4 * I2) { const int mi = r / I2; r -= mi * I2; const int l = mi >> 1, f = mi & 1, kb = r / 32, nb = r % 32;
                transpose_item(a.in[f ? I_F2W2 : I_F1W2] + (size_t)l * DFF * D, D, (u16*)(a.ws + WS_W2) + (size_t)mi * D * DFF, DFF, kb * 64, nb * 32, nb * 32, scr, lane); continue; }
            r -= 4 * I2;
            if (r < 2 * IIN) { const int l = r / IIN; r -= l * IIN; const int kb = r / 89, nb = r % 89;
                transpose_item(a.in[I_WIN] + (size_t)l * D * DPROJ, DPROJ, (u16*)(a.ws + WS_WIN) + (size_t)l * NPROJ * D, D, kb * 64, nb * 32, nb * 32, scr, lane); continue; }
            r -= 2 * IIN;
            if (r < 2 * IOUT) { const int l = r / IOUT; r -= l * IOUT; const int kb = r / 32, nb = r % 32;
                transpose_item(a.in[I_WOUT] + (size_t)l * D * D, D, (u16*)(a.ws + WS_WOUT) + (size_t)l * D * D, D, kb * 64, nb * 32, nb * 32, scr, lane); continue; }
            r -= 2 * IOUT;
            { const int l = r / IPW; r -= l * IPW; const int kb = r / 8, nb = r % 8;
                transpose_item(a.in[I_CPW] + (size_t)l * 256 * 256, 256, (u16*)(a.ws + WS_PWT) + (size_t)l * 256 * 256, 256, kb * 64, nb * 32, nb * 32, scr, lane); }
        }
    }
}

__device__ __forceinline__ void phase_norm(const Args& a, int layer, int which, int M, bool first) {
    int tid = threadIdx.x; asm volatile("" : "+v"(tid)); const int lane = tid & 63, wave = tid >> 6;
    const float* nw = a.in[which == 0 ? I_NF1 : (which == 1 ? I_NMIX : I_NF2)] + (size_t)layer * D;
    u16* A = (u16*)(a.ws + WS_A);
    for (int row = blockIdx.x * 8 + wave; row < M; row += gridDim.x * 8) {
        const float* src = first ? ((row < MX) ? a.in[I_X] + (size_t)row * D : a.in[I_CTX] + (size_t)(row - MX) * D) : hrow(a, row);
        const int g = row < SEQ ? 0 : (row < MX ? 1 : 2);
        const float* sh = modp(a, layer, g, 3 * which), * scl = modp(a, layer, g, 3 * which + 1);
        f32x4 v[4]; float ss = 0.f;
#pragma unroll
        for (int j = 0; j < 4; ++j) { v[j] = ((const f32x4*)src)[lane + 64 * j]; ss += (v[j].x * v[j].x + v[j].y * v[j].y) + (v[j].z * v[j].z + v[j].w * v[j].w); }
        if (first) { f32x4* hd = (f32x4*)hrow(a, row);
#pragma unroll
            for (int j = 0; j < 4; ++j) hd[lane + 64 * j] = v[j]; }
        const float rstd = rsqrtf(wave_sum(ss) * (1.0f / D) + 1e-6f);
        u32x2* o = (u32x2*)(A + (size_t)row * D);
#pragma unroll
        for (int j = 0; j < 4; ++j) {
            const f32x4 w4 = ((const f32x4*)nw)[lane + 64 * j], s4 = ((const f32x4*)scl)[lane + 64 * j], b4 = ((const f32x4*)sh)[lane + 64 * j];
            const f32x4 y = (v[j] * rstd) * w4 * (s4 + 1.0f) + b4;
            u32x2 p; p.x = pk2(y.x, y.y); p.y = pk2(y.z, y.w); o[lane + 64 * j] = p;
        }
    }
}
__device__ __forceinline__ void phase_final(const Args& a) {
    int tid = threadIdx.x; asm volatile("" : "+v"(tid)); const int lane = tid & 63, wave = tid >> 6;
    const float* nw = a.in[I_FNORM];
    for (int row = blockIdx.x * 8 + wave; row < MX; row += gridDim.x * 8) {
        f32x4* p = (f32x4*)(a.out + (size_t)row * D);
        f32x4 v[4]; float ss = 0.f;
#pragma unroll
        for (int j = 0; j < 4; ++j) { v[j] = p[lane + 64 * j]; ss += (v[j].x * v[j].x + v[j].y * v[j].y) + (v[j].z * v[j].z + v[j].w * v[j].w); }
        const float rstd = rsqrtf(wave_sum(ss) * (1.0f / D) + 1e-6f);
#pragma unroll
        for (int j = 0; j < 4; ++j) p[lane + 64 * j] = (v[j] * rstd) * ((const f32x4*)nw)[lane + 64 * j];
    }
}

__device__ __forceinline__ void prep_unit(const Args& a, int layer, int unit, uchar* lds) {
    int tid = threadIdx.x; asm volatile("" : "+v"(tid)); const int b = unit / NCH, c = unit % NCH;
    u16* P = (u16*)(a.ws + WS_X);
    unsigned* ctl = (unsigned*)(a.ws + WS_CTL) + layer * 64;
    unsigned* lmax = (unsigned*)lds;
    u16* T = (u16*)(lds + 256);
    if (tid < 12) lmax[tid] = 0u;
    __syncthreads();
    const float* tr = (const float*)(a.ws + WS_MISC);
    {
        const int tk = tid >> 3, row = row_of(b, c, tk);
        const int t = (c - 4) * 64 + tk, gr = t >> 6, gc = t & 63;
#pragma unroll
        for (int e = 0; e < 2; ++e) {
            const int id = (tid & 7) * 2 + e, isk = id >> 3, h = (id >> 1) & 3, s = id & 1;
            u16* p = P + (size_t)row * DPROJ + C_DQ + isk * 256 + h * 64 + s * 32;
            bf16x8 raw[4];
#pragma unroll
            for (int q = 0; q < 4; ++q) raw[q] = ((const bf16x8*)p)[q];
            float x[32];
#pragma unroll
            for (int q = 0; q < 4; ++q)
#pragma unroll
                for (int i = 0; i < 8; ++i) x[q * 8 + i] = bf2f((u16)raw[q][i]);
            if (c >= 4) {
#pragma unroll
                for (int j = 0; j < 8; ++j) {
                    const float cr = tr[(gr * 8 + j) * 2], sr = tr[(gr * 8 + j) * 2 + 1], cc = tr[4096 + (gc * 8 + j) * 2], sc = tr[4096 + (gc * 8 + j) * 2 + 1];
                    const float x0 = x[j], x1 = x[j + 8], y0 = x[16 + j], y1 = x[24 + j];
                    x[j] = x0 * cr - x1 * sr; x[j + 8] = x1 * cr + x0 * sr;
                    x[16 + j] = y0 * cc - y1 * sc; x[24 + j] = y1 * cc + y0 * sc;
                }
                u32x4 o[4];
#pragma unroll
                for (int q = 0; q < 4; ++q) { o[q].x = pk2(x[q * 8], x[q * 8 + 1]); o[q].y = pk2(x[q * 8 + 2], x[q * 8 + 3]); o[q].z = pk2(x[q * 8 + 4], x[q * 8 + 5]); o[q].w = pk2(x[q * 8 + 6], x[q * 8 + 7]); }
#pragma unroll
                for (int q = 0; q < 4; ++q) ((u32x4*)p)[q] = o[q];
            }
            if (isk) {
                float n2 = 0.f;
#pragma unroll
                for (int i = 0; i < 32; ++i) { const float r = bf2f(f2bf(x[i])); n2 += r * r; }
                atomicMax(&lmax[h * 2 + s], __float_as_uint(n2));
            }
        }
    }
    {
        const int tk = tid >> 3, h = (tid & 7) >> 1, hf = tid & 1, row = row_of(b, c, tk);
        const u16* p = P + (size_t)row * DPROJ + C_NK + h * 64 + hf * 32;
        float n2 = 0.f;
#pragma unroll
        for (int q = 0; q < 4; ++q) { const bf16x8 r = ((const bf16x8*)p)[q];
#pragma unroll
            for (int i = 0; i < 8; ++i) { const float f = bf2f((u16)r[i]); n2 += f * f; } }
        n2 += __shfl_xor(n2, 1);
        if (hf == 0) atomicMax(&lmax[8 + h], __float_as_uint(n2));
    }
#pragma unroll 1
    for (int wh = 0; wh < 2; ++wh) {
        const int ccol = wh ? C_NV : C_DV;
        u16* VT = (u16*)(a.ws + (wh ? WS_VTN : WS_VTD));
        __syncthreads();
        for (int i = tid; i < 64 * 32; i += 512) { const int tk = i >> 5, pc = i & 31;
            *(bf16x8*)(T + tk * 264 + pc * 8) = *(const bf16x8*)(P + (size_t)row_of(b, c, tk) * DPROJ + ccol + pc * 8); }
        __syncthreads();
        {
            const int r = tid >> 1, hf = tid & 1, h = r >> 6, dv = r & 63;
            u16* dst = VT + ((size_t)(b * 4 + h) * 64 + dv) * NKEY + c * 64 + hf * 32;
#pragma unroll
            for (int q = 0; q < 4; ++q) {
                u32x4 o; unsigned w[4];
#pragma unroll
                for (int i = 0; i < 4; ++i) { const int t0 = hf * 32 + q * 8 + i * 2; w[i] = (unsigned)T[t0 * 264 + r] | ((unsigned)T[(t0 + 1) * 264 + r] << 16); }
                o.x = w[0]; o.y = w[1]; o.z = w[2]; o.w = w[3];
                ((u32x4*)dst)[q] = o;
            }
        }
    }
    __syncthreads();
    if (tid < 8) atomicMax(&ctl[(b * 4 + (tid >> 1)) * 2 + (tid & 1)], lmax[tid]);
    else if (tid < 12) atomicMax(&ctl[16 + b * 4 + (tid - 8)], lmax[tid]);
    __syncthreads();
}

template <int dir> __device__ __forceinline__ void gla_bcum(const Args& a, int layer, const u16* prow, int h, int lane, float (&bc)[32]) {
    const float* wa = a.in[dir ? I_WAB : I_WAF] + (size_t)layer * 16 * 128 + h * 32;
    const float* ba = a.in[dir ? I_BAB : I_BAF] + (size_t)layer * 128 + h * 32;
    const bf16x8 r0 = *(const bf16x8*)(prow + C_AF + dir * 16), r1 = *(const bf16x8*)(prow + C_AF + dir * 16 + 8);
    float av[16];
#pragma unroll
    for (int i = 0; i < 8; ++i) { av[i] = bf2f((u16)r0[i]); av[8 + i] = bf2f((u16)r1[i]); }
#pragma unroll
    for (int d = 0; d < 32; ++d) {
        float z = ba[d];
#pragma unroll
        for (int r = 0; r < 16; ++r) z += av[r] * wa[r * 128 + d];
        const float ls = fminf(z, 0.f) - __logf(1.0f + __expf(-fabsf(z)));
        bc[d] = ls * (1.0f / 16.0f);
        if ((d & 3) == 3) __builtin_amdgcn_sched_barrier(0);
    }
#pragma unroll
    for (int off = 1; off < 64; off <<= 1) {
#pragma unroll
        for (int d = 0; d < 32; ++d) {
            if (dir == 0) { const float t = __shfl_up(bc[d], off); if (lane >= off) bc[d] += t; }
            else { const float t = __shfl_down(bc[d], off); if (lane + off < 64) bc[d] += t; }
        }
    }
}
__device__ __forceinline__ int gla_scan_idx(int dir, int c) { return dir == 0 ? c : ((c < 4) ? 3 - c : 263 - c); }

template <int dir> __device__ __forceinline__ void gla_g1_wave(const Args& a, int layer, int b, int c, int h, uchar* wlds, int lane) {
    asm volatile("" : "+v"(lane));
    const int fr = lane & 15, fq = lane >> 4;
    const u16* P = (const u16*)(a.ws + WS_X);
    const u16* prow = P + (size_t)row_of(b, c, lane) * DPROJ;
    u16* VT = (u16*)wlds;
    u16* KT = (u16*)(wlds + 8192);
    float* U = (float*)(a.ws + WS_U); float* DEC = (float*)(a.ws + WS_DEC);
    {
        bf16x8 vr[8];
#pragma unroll
        for (int q = 0; q < 8; ++q) vr[q] = ((const bf16x8*)(prow + C_GV + h * 64))[q];
#pragma unroll
        for (int q = 0; q < 8; ++q)
#pragma unroll
            for (int i = 0; i < 8; ++i) VT[(q * 8 + i) * 64 + lane] = (u16)vr[q][i];
    }
    float bc[32];
    gla_bcum<dir>(a, layer, prow, h, lane, bc);
    const int n = gla_scan_idx(dir, c);
    const size_t sidx = ((size_t)((b * 2 + dir) * 4 + h) * NCH + n);
    {
        f32x4* bcp = (f32x4*)((float*)(a.ws + WS_BC) + ((((size_t)((b * 2 + dir) * 4 + h) * NCH + c) * 64 + lane) * 32));
#pragma unroll
        for (int q = 0; q < 8; ++q) bcp[q] = (f32x4){bc[q * 4], bc[q * 4 + 1], bc[q * 4 + 2], bc[q * 4 + 3]};
    }
    {
        bf16x8 kr[4];
#pragma unroll
        for (int q = 0; q < 4; ++q) kr[q] = ((const bf16x8*)(prow + C_GK + h * 32))[q];
#pragma unroll
        for (int d = 0; d < 32; ++d) { const float bl = __shfl(bc[d], dir ? 0 : 63); KT[d * 64 + lane] = f2bf(bf2f((u16)kr[d >> 3][d & 7]) * __expf(bl - bc[d])); }
    }
    if (lane == (dir ? 0 : 63)) {
#pragma unroll
        for (int q = 0; q < 8; ++q) { f32x4 o;
#pragma unroll
            for (int e = 0; e < 4; ++e) o[e] = __expf(bc[q * 4 + e]);
            ((f32x4*)(DEC + sidx * 32))[q] = o; }
    }
    WAVE_SYNC();
    f32x4 acc[4][2];
#pragma unroll
    for (int dvb = 0; dvb < 4; ++dvb)
#pragma unroll
        for (int db = 0; db < 2; ++db) acc[dvb][db] = (f32x4){0.f, 0.f, 0.f, 0.f};
#pragma unroll
    for (int ks = 0; ks < 2; ++ks) {
        bf16x8 kf[2];
#pragma unroll
        for (int db = 0; db < 2; ++db) kf[db] = *(const bf16x8*)(KT + (db * 16 + fr) * 64 + ks * 32 + fq * 8);
#pragma unroll
        for (int dvb = 0; dvb < 4; ++dvb) {
            const bf16x8 vf = *(const bf16x8*)(VT + (dvb * 16 + fr) * 64 + ks * 32 + fq * 8);
#pragma unroll
            for (int db = 0; db < 2; ++db) acc[dvb][db] = __builtin_amdgcn_mfma_f32_16x16x32_bf16(vf, kf[db], acc[dvb][db], 0, 0, 0);
        }
    }
    float* ub = U + sidx * 2048;
#pragma unroll
    for (int dvb = 0; dvb < 4; ++dvb)
#pragma unroll
        for (int db = 0; db < 2; ++db) *(f32x4*)(ub + (db * 16 + fr) * 64 + dvb * 16 + fq * 4) = acc[dvb][db];
    WAVE_SYNC();
}
__device__ __forceinline__ void gla_scan(const Args& a, uchar* lds) {
    int tid = threadIdx.x; asm volatile("" : "+v"(tid));
    float* U = (float*)(a.ws + WS_U); const float* DEC = (const float*)(a.ws + WS_DEC);
    float* PL = (float*)lds;
    const int seg = tid >> 7, el = tid & 127;
    constexpr int SEGN = NCH / 4;
    for (int blk = blockIdx.x; blk < 16 * 16; blk += gridDim.x) {
        const int seq = blk >> 4, e = (blk & 15) * 128 + el, d = e >> 6;
        float* u = U + ((size_t)seq * NCH + seg * SEGN) * 2048 + e; const float* dc = DEC + ((size_t)seq * NCH + seg * SEGN) * 32 + d;
        float pr = 1.f, s = 0.f;
#pragma unroll 13
        for (int n = 0; n < SEGN; ++n) { const float un = u[(size_t)n * 2048], dn = dc[n * 32]; s = dn * s + un; pr *= dn; }
        __syncthreads();
        PL[(seg * 128 + el) * 2] = pr; PL[(seg * 128 + el) * 2 + 1] = s;
        __syncthreads();
        float s0 = 0.f;
        for (int k = 0; k < seg; ++k) s0 = PL[(k * 128 + el) * 2] * s0 + PL[(k * 128 + el) * 2 + 1];
        s = s0;
#pragma unroll 13
        for (int n = 0; n < SEGN; ++n) { const float un = u[(size_t)n * 2048], dn = dc[n * 32]; u[(size_t)n * 2048] = s; s = dn * s + un; }
    }
    __syncthreads();
}
__device__ __forceinline__ void gla_g3_wave(const Args& a, int layer, int wu, uchar* wlds, int lane) {
    asm volatile("" : "+v"(lane));
    const int h = __builtin_amdgcn_readfirstlane(wu & 3), bc_ = __builtin_amdgcn_readfirstlane(wu >> 2), b = bc_ / NCH, c = bc_ % NCH;
    const int fr = lane & 15, fq = lane >> 4;
    const u16* P = (const u16*)(a.ws + WS_X);
    const int row_l = row_of(b, c, lane);
    const u16* prow = P + (size_t)row_l * DPROJ;
    u16* R0 = (u16*)wlds;
    u16* ST = (u16*)(wlds + 4096);
    u16* VT = (u16*)(wlds + 8192);
    const float* U = (const float*)(a.ws + WS_U);
    {
        bf16x8 vr[8];
#pragma unroll
        for (int q = 0; q < 8; ++q) vr[q] = ((const bf16x8*)(prow + C_GV + h * 64))[q];
#pragma unroll
        for (int q = 0; q < 8; ++q)
#pragma unroll
            for (int i = 0; i < 8; ++i) VT[(q * 8 + i) * 64 + lane] = (u16)vr[q][i];
    }
    f32x4 O[4][4];
#pragma unroll
    for (int qb = 0; qb < 4; ++qb)
#pragma unroll
        for (int dvb = 0; dvb < 4; ++dvb) O[qb][dvb] = (f32x4){0.f, 0.f, 0.f, 0.f};
#pragma unroll
    for (int dir = 0; dir < 2; ++dir) {
        __builtin_amdgcn_sched_barrier(0);
        const int n = gla_scan_idx(dir, c);
        const float* sp = U + ((size_t)((b * 2 + dir) * 4 + h) * NCH + n) * 2048;
        u32x4 qpk[4], kpk[4];
        {
            const f32x4* bcp = (const f32x4*)((const float*)(a.ws + WS_BC) + ((((size_t)((b * 2 + dir) * 4 + h) * NCH + c) * 64 + lane) * 32));
#pragma unroll
            for (int q = 0; q < 4; ++q) {
                const bf16x8 qr = ((const bf16x8*)(prow + C_GQ + h * 32))[q], kr = ((const bf16x8*)(prow + C_GK + h * 32))[q];
                const f32x4 b0 = bcp[2 * q], b1 = bcp[2 * q + 1];
                float e[8];
#pragma unroll
                for (int i = 0; i < 4; ++i) { e[i] = __expf(b0[i]); e[4 + i] = __expf(b1[i]); }
                unsigned wq[4], wk[4];
#pragma unroll
                for (int i = 0; i < 4; ++i) {
                    wq[i] = pk2(bf2f((u16)qr[2 * i]) * 0.17677669529663687f * e[2 * i], bf2f((u16)qr[2 * i + 1]) * 0.17677669529663687f * e[2 * i + 1]);
                    wk[i] = pk2(bf2f((u16)kr[2 * i]) * __builtin_amdgcn_rcpf(e[2 * i]), bf2f((u16)kr[2 * i + 1]) * __builtin_amdgcn_rcpf(e[2 * i + 1]));
                }
                qpk[q] = (u32x4){wq[0], wq[1], wq[2], wq[3]}; kpk[q] = (u32x4){wk[0], wk[1], wk[2], wk[3]};
            }
        }
        WAVE_SYNC();
#pragma unroll
        for (int q = 0; q < 4; ++q) ((u32x4*)(R0 + lane * 32))[q] = qpk[q];
#pragma unroll
        for (int q = 0; q < 4; ++q) { u32x4 o; unsigned w[4];
#pragma unroll
            for (int i = 0; i < 4; ++i) { const int d = q * 8 + 2 * i; w[i] = pk2(sp[d * 64 + lane], sp[(d + 1) * 64 + lane]); }
            o.x = w[0]; o.y = w[1]; o.z = w[2]; o.w = w[3]; ((u32x4*)(ST + lane * 32))[q] = o; }
        WAVE_SYNC();
        bf16x8 qf[4];
#pragma unroll
        for (int qb = 0; qb < 4; ++qb) qf[qb] = *(const bf16x8*)(R0 + (qb * 16 + fr) * 32 + fq * 8);
        WAVE_SYNC();
#pragma unroll
        for (int q = 0; q < 4; ++q) ((u32x4*)(R0 + lane * 32))[q] = kpk[q];
        WAVE_SYNC();
#pragma unroll
        for (int dvb = 0; dvb < 4; ++dvb) {
            const bf16x8 sf = *(const bf16x8*)(ST + (dvb * 16 + fr) * 32 + fq * 8);
#pragma unroll
            for (int qb = 0; qb < 4; ++qb) O[qb][dvb] = __builtin_amdgcn_mfma_f32_16x16x32_bf16(sf, qf[qb], O[qb][dvb], 0, 0, 0);
        }
#pragma unroll
        for (int ip = 0; ip < 2; ++ip) {
            const bf16x8 kf0 = *(const bf16x8*)(R0 + ((2 * ip) * 16 + fr) * 32 + fq * 8), kf1 = *(const bf16x8*)(R0 + ((2 * ip + 1) * 16 + fr) * 32 + fq * 8);
            bf16x8 pf[4];
#pragma unroll
            for (int qb = 0; qb < 4; ++qb) {
                f32x4 a0 = (f32x4){0.f, 0.f, 0.f, 0.f}, a1 = a0;
                a0 = __builtin_amdgcn_mfma_f32_16x16x32_bf16(kf0, qf[qb], a0, 0, 0, 0);
                a1 = __builtin_amdgcn_mfma_f32_16x16x32_bf16(kf1, qf[qb], a1, 0, 0, 0);
                const int i = qb * 16 + fr;
                float p[8];
#pragma unroll
                for (int jj = 0; jj < 4; ++jj) {
                    const int j0 = (2 * ip) * 16 + fq * 4 + jj, j1 = j0 + 16;
                    p[jj] = (dir == 0 ? (j0 <= i) : (j0 >= i)) ? a0[jj] : 0.f;
                    p[4 + jj] = (dir == 0 ? (j1 <= i) : (j1 >= i)) ? a1[jj] : 0.f;
                }
                u32x4 w; w.x = pk2(p[0], p[1]); w.y = pk2(p[2], p[3]); w.z = pk2(p[4], p[5]); w.w = pk2(p[6], p[7]);
                pf[qb] = __builtin_bit_cast(bf16x8, w);
            }
#pragma unroll
            for (int dvb = 0; dvb < 4; ++dvb) {
                const u16* vp = VT + (dvb * 16 + fr) * 64 + (2 * ip) * 16 + fq * 4;
                const s16x4 lo = *(const s16x4*)vp, hi = *(const s16x4*)(vp + 16);
                const bf16x8 vf = __builtin_shufflevector(lo, hi, 0, 1, 2, 3, 4, 5, 6, 7);
#pragma unroll
                for (int qb = 0; qb < 4; ++qb) O[qb][dvb] = __builtin_amdgcn_mfma_f32_16x16x32_bf16(vf, pf[qb], O[qb][dvb], 0, 0, 0);
            }
        }
    }
    const float* gnw = a.in[I_GNORM] + layer * 64;
    u16* MIX = (u16*)(a.ws + WS_A);
#pragma unroll
    for (int qb = 0; qb < 4; ++qb) {
        float ss = 0.f;
#pragma unroll
        for (int dvb = 0; dvb < 4; ++dvb)
#pragma unroll
            for (int jj = 0; jj < 4; ++jj) ss += O[qb][dvb][jj] * O[qb][dvb][jj];
        ss += __shfl_xor(ss, 16); ss += __shfl_xor(ss, 32);
        const float r = rsqrtf(ss * (1.0f / 64.0f) + 1e-6f);
        const int row = row_of(b, c, qb * 16 + fr);
#pragma unroll
        for (int dvb = 0; dvb < 4; ++dvb) {
            const int v0 = dvb * 16 + fq * 4;
            const s16x4 g4 = *(const s16x4*)(P + (size_t)row * DPROJ + C_GG + h * 64 + v0);
            const f32x4 nw = *(const f32x4*)(gnw + v0);
            float o[4];
#pragma unroll
            for (int jj = 0; jj < 4; ++jj) o[jj] = O[qb][dvb][jj] * r * nw[jj] * silu_f(bf2f((u16)g4[jj]));
            u32x2 w; w.x = pk2(o[0], o[1]); w.y = pk2(o[2], o[3]);
            *(u32x2*)(MIX + (size_t)row * D + h * 64 + v0) = w;
        }
    }
    WAVE_SYNC();
}

__device__ __forceinline__ void conv_unit(const Args& a, int layer, int unit, uchar* lds, const bf16x8 (&wf)[2][8]) {
    int tid = threadIdx.x; asm volatile("" : "+v"(tid)); const int lane = tid & 63, wave = tid >> 6, fr = lane & 15, fq = lane >> 4;
    int t0, L, rowbase;
    if (unit < 1024) { const int b = unit >> 9; t0 = (unit & 511) * 32; L = SEQ; rowbase = b * SEQ; }
    else { const int uu = unit - 1024, b = uu >> 3; t0 = (uu & 7) * 32; L = CTXL; rowbase = MX + b * CTXL; }
    const u16* P = (const u16*)(a.ws + WS_X);
    float* Ub = (float*)lds;
    float* Y = (float*)(lds + 65536);
    u16* Z = (u16*)(lds + 98304);
    for (int i = tid; i < 62 * 64; i += 512) {
        const int p = i >> 6, c4 = (i & 63) * 4, t = t0 - 15 + p;
        f32x4 u = (f32x4){0.f, 0.f, 0.f, 0.f};
        if (t >= 0 && t < L) {
            const u16* pr = P + (size_t)(rowbase + t) * DPROJ;
            const s16x4 av = *(const s16x4*)(pr + C_CA + c4), gv = *(const s16x4*)(pr + C_CG + c4);
#pragma unroll
            for (int e = 0; e < 4; ++e) { const float g = bf2f((u16)gv[e]); u[e] = bf2f((u16)av[e]) / (1.0f + __expf(-g)); }
        }
        *(f32x4*)(Ub + p * 256 + c4) = u;
    }
    __syncthreads();
    {
        const int c = tid & 255, th = tid >> 8;
        const float* dw = a.in[I_CDW] + (size_t)layer * 31 * 256 + c;
        float w[31];
#pragma unroll
        for (int k = 0; k < 31; ++k) w[k] = dw[k * 256];
        const float bias = a.in[I_CDWB][layer * 256 + c];
        float uw[46];
#pragma unroll
        for (int i = 0; i < 46; ++i) uw[i] = Ub[(th * 16 + i) * 256 + c];
#pragma unroll
        for (int tt = 0; tt < 16; ++tt) {
            float acc = bias;
#pragma unroll
            for (int k = 0; k < 31; ++k) acc += w[k] * uw[tt + k];
            Y[(th * 16 + tt) * 256 + c] = acc;
        }
    }
    __syncthreads();
    {
        const f32x4 g4 = *(const f32x4*)(a.in[I_CLNG] + layer * 256 + lane * 4), b4 = *(const f32x4*)(a.in[I_CLNB] + layer * 256 + lane * 4);
#pragma unroll
        for (int q = 0; q < 4; ++q) {
            const int t = wave * 4 + q;
            const f32x4 v = *(const f32x4*)(Y + t * 256 + lane * 4);
            const float mu = wave_sum((v.x + v.y) + (v.z + v.w)) * (1.0f / 256.0f);
            const f32x4 dlt = v - mu;
            const float var = wave_sum((dlt.x * dlt.x + dlt.y * dlt.y) + (dlt.z * dlt.z + dlt.w * dlt.w)) * (1.0f / 256.0f);
            const float rs = rsqrtf(var + 1e-5f);
            float z[4];
#pragma unroll
            for (int e = 0; e < 4; ++e) z[e] = silu_f(dlt[e] * rs * g4[e] + b4[e]);
            u32x2 w; w.x = pk2(z[0], z[1]); w.y = pk2(z[2], z[3]);
            *(u32x2*)(Z + t * 264 + lane * 4) = w;
        }
    }
    __syncthreads();
    {
        f32x4 acc[2][2];
#pragma unroll
        for (int i = 0; i < 2; ++i)
#pragma unroll
            for (int j = 0; j < 2; ++j) acc[i][j] = (f32x4){0.f, 0.f, 0.f, 0.f};
#pragma unroll
        for (int ks = 0; ks < 8; ++ks) {
            bf16x8 zf[2];
#pragma unroll
            for (int tb = 0; tb < 2; ++tb) zf[tb] = *(const bf16x8*)(Z + (tb * 16 + fr) * 264 + ks * 32 + fq * 8);
#pragma unroll
            for (int nbi = 0; nbi < 2; ++nbi)
#pragma unroll
                for (int tb = 0; tb < 2; ++tb) acc[nbi][tb] = __builtin_amdgcn_mfma_f32_16x16x32_bf16(wf[nbi][ks], zf[tb], acc[nbi][tb], 0, 0, 0);
        }
        u16* MIX = (u16*)(a.ws + WS_A);
#pragma unroll
        for (int nbi = 0; nbi < 2; ++nbi) {
            const int n0 = (wave * 2 + nbi) * 16 + fq * 4;
            const f32x4 pb = *(const f32x4*)(a.in[I_CPWB] + layer * 256 + n0);
#pragma unroll
            for (int tb = 0; tb < 2; ++tb) {
                const int row = rowbase + t0 + tb * 16 + fr;
                u32x2 w; w.x = pk2(acc[nbi][tb][0] + pb[0], acc[nbi][tb][1] + pb[1]); w.y = pk2(acc[nbi][tb][2] + pb[2], acc[nbi][tb][3] + pb[3]);
                *(u32x2*)(MIX + (size_t)row * D + 768 + n0) = w;
            }
        }
    }
    __syncthreads();
}
#define XB_TMO      128
#define XB_XCNT(j)  (256  + 64 * (j))
#define XB_XSUB(j)  (1280 + 64 * (j))
#define XB_XGEN(j)  (2304 + 64 * (j))
#define XB_TOP      3328
#define XB_TOPGEN   3392
#define XCD_BAR_WORDS 3456
#define XB_SPIN_CAP (1u << 18)

__device__ __forceinline__ unsigned xb_ld(unsigned* p)              { return __hip_atomic_load(p, __ATOMIC_RELAXED, __HIP_MEMORY_SCOPE_AGENT); }
__device__ __forceinline__ unsigned xb_add(unsigned* p, unsigned v) { return __hip_atomic_fetch_add(p, v, __ATOMIC_RELAXED, __HIP_MEMORY_SCOPE_AGENT); }
__device__ __forceinline__ unsigned xb_xcc_id() { return (unsigned)__builtin_amdgcn_s_getreg((3 << 11) | 20) & 0xFu; }
#define XB_SPIN(cond, bar) do { unsigned _sp = 0; while (cond) { __builtin_amdgcn_s_sleep(1); \
    if ((++_sp & 255u) == 0u) { if (xb_ld(&(bar)[XB_TMO])) break; if (_sp > XB_SPIN_CAP) { atomicAdd(&(bar)[XB_TMO], 1u); break; } } } } while (0)

struct XcdBarrier {
    unsigned* bar; unsigned x;
    volatile LAS unsigned* st;
};

__device__ __forceinline__ XcdBarrier xcd_barrier_post(unsigned* bar, volatile LAS unsigned* st) {
    XcdBarrier b; b.bar = bar; b.x = xb_xcc_id(); b.st = st;
    if (threadIdx.x == 0) (void)xb_add(&bar[XB_XCNT(b.x)], 1u);
    return b;
}
__device__ __forceinline__ void xcd_barrier_complete(unsigned* bar, unsigned x, unsigned& nloc, unsigned& nx) {
    const unsigned G = gridDim.x * gridDim.y * gridDim.z;
    unsigned sum, cnt, mine, sp = 0u;
    for (;;) {
        sum = 0u; cnt = 0u; mine = 0u;
#pragma unroll
        for (unsigned j = 0; j < 16; ++j) { const unsigned c = xb_ld(&bar[XB_XCNT(j)]); sum += c; cnt += (c > 0u) ? 1u : 0u; mine = (j == x) ? c : mine; }
        if (sum == G) break;
        __builtin_amdgcn_s_sleep(1);
        if ((++sp & 255u) == 0u) { if (xb_ld(&bar[XB_TMO])) break; if (sp > XB_SPIN_CAP) { atomicAdd(&bar[XB_TMO], 1u); break; } }
    }
    nloc = mine > 0u ? mine : 1u; nx = cnt > 0u ? cnt : 1u;
}

__device__ __forceinline__ void xcd_barrier(const XcdBarrier& b) {
    asm volatile("s_waitcnt vmcnt(0)" ::: "memory");
    __syncthreads();
    if (threadIdx.x == 0) {
        unsigned* bar = b.bar;
        __builtin_amdgcn_s_waitcnt(0);
        unsigned nloc = b.st[0], nx = b.st[1];
        if (nloc == 0u) { xcd_barrier_complete(bar, b.x, nloc, nx); b.st[0] = nloc; b.st[1] = nx; }
        const unsigned old = xb_add(&bar[XB_XSUB(b.x)], 1u);
        const unsigned gen = old / nloc;
        if (old + 1u == (gen + 1u) * nloc) {
            __builtin_amdgcn_fence(__ATOMIC_RELEASE, "agent");
            asm volatile("s_waitcnt vmcnt(0)" ::: "memory");
            const unsigned og = xb_add(&bar[XB_TOP], 1u);
            const unsigned tg = og / nx;
            if (og + 1u == (tg + 1u) * nx) xb_add(&bar[XB_TOPGEN], 1u);
            else XB_SPIN(xb_ld(&bar[XB_TOPGEN]) == tg, bar);
            __builtin_amdgcn_fence(__ATOMIC_ACQUIRE, "agent");
            xb_add(&bar[XB_XGEN(b.x)], 1u);
            asm volatile("s_waitcnt vmcnt(0)" ::: "memory");
        } else {
            XB_SPIN(xb_ld(&bar[XB_XGEN(b.x)]) == gen, bar);
            __builtin_amdgcn_fence(__ATOMIC_ACQUIRE, "agent");
            asm volatile("s_waitcnt vmcnt(0)" ::: "memory");
        }
    }
    __syncthreads();
}

typedef float f32x2_t __attribute__((ext_vector_type(2)));
typedef __bf16 bf16x2_t __attribute__((ext_vector_type(2)));
__device__ __forceinline__ unsigned cvtpk_s(float lo, float hi) { f32x2_t v = {lo, hi}; bf16x2_t b = __builtin_convertvector(v, bf16x2_t); return __builtin_bit_cast(unsigned, b); }
__device__ __forceinline__ bf16x8 pack8(const f32x4& p0, const f32x4& p1) {
    u32x4 w; w.x = cvtpk_s(p0[0], p0[1]); w.y = cvtpk_s(p0[2], p0[3]); w.z = cvtpk_s(p1[0], p1[1]); w.w = cvtpk_s(p1[2], p1[3]);
    return __builtin_bit_cast(bf16x8, w);
}
__device__ __forceinline__ bf16x8 load_scaled8(const u16* p, float sc, float& n2) {
    const bf16x8 raw = *(const bf16x8*)p; bf16x8 o;
#pragma unroll
    for (int i = 0; i < 8; ++i) { const u16 r = f2bf(bf2f((u16)raw[i]) * sc); const float f = bf2f(r); n2 += f * f; o[i] = (short)r; }
    return o;
}

__device__ __forceinline__ void diff_unit(const Args& a, int layer, int b, int h, int q0row, int ntiles, uchar* lds) {
    int tid = threadIdx.x; asm volatile("" : "+v"(tid)); const int lane = tid & 63, wave = tid >> 6, fr = lane & 15, fq = lane >> 4;
    const u16* P = (const u16*)(a.ws + WS_X);
    const u16* VTD = (const u16*)(a.ws + WS_VTD) + (size_t)(b * 4 + h) * 64 * NKEY;
    const unsigned* ctl = (const unsigned*)(a.ws + WS_CTL) + layer * 64;
    u16* Ks = (u16*)lds;
    u16* Vs = (u16*)(lds + 4 * 64 * 64 * 2);
    const float C2 = 0.17677669529663687f * LOG2E;
    bf16x8 qf[2][2]; float negb[2][2];
#pragma unroll
    for (int qb = 0; qb < 2; ++qb)
#pragma unroll
        for (int s = 0; s < 2; ++s) {
            const int row = q0row + wave * 32 + qb * 16 + fr; float n2 = 0.f;
            qf[qb][s] = load_scaled8(P + (size_t)row * DPROJ + C_DQ + h * 64 + s * 32 + fq * 8, C2, n2);
            n2 += __shfl_xor(n2, 16); n2 += __shfl_xor(n2, 32);
            const float km = __uint_as_float(ctl[(b * 4 + h) * 2 + s]);
            negb[qb][s] = -sqrtf(n2 * km);
        }
    f32x4 O[2][2][4], Ls[2][2];
    const bf16x8 ones = (bf16x8){(short)0x3F80, (short)0x3F80, (short)0x3F80, (short)0x3F80, (short)0x3F80, (short)0x3F80, (short)0x3F80, (short)0x3F80};
#pragma unroll
    for (int qb = 0; qb < 2; ++qb)
#pragma unroll
        for (int s = 0; s < 2; ++s) { Ls[qb][s] = (f32x4){0.f, 0.f, 0.f, 0.f};
#pragma unroll
            for (int dvb = 0; dvb < 4; ++dvb) O[qb][s][dvb] = (f32x4){0.f, 0.f, 0.f, 0.f}; }
    const int sr = tid >> 3, pc = tid & 7;
    auto kaddr = [&](int t) -> const u16* { const int krow = (t < 4) ? (MX + b * CTXL + t * 64 + sr) : (b * SEQ + (t - 4) * 64 + sr); return P + (size_t)krow * DPROJ + C_DK + h * 64 + pc * 8; };
    auto vaddr = [&](int t) -> const u16* { return VTD + (size_t)sr * NKEY + t * 64 + pc * 8; };
    auto compute_tile = [&](const u16* Kb, const u16* Vb) {
        f32x4 S0[2][2], S1[2][2];
        bf16x8 pfr[2][2];
        bf16x8 vfr[4];
#define DIFF_QK(g) do { const int i_ = (g) >> 1, s_ = (g) & 1; \
            const bf16x8 kf0 = *(const bf16x8*)(Kb + ((2 * i_) * 16 + fr) * 64 + (((s_ * 4 + fq) ^ (fr >> 1)) * 8)), kf1 = *(const bf16x8*)(Kb + ((2 * i_ + 1) * 16 + fr) * 64 + (((s_ * 4 + fq) ^ (fr >> 1)) * 8)); \
            _Pragma("unroll") for (int qb = 0; qb < 2; ++qb) { const float nb = negb[qb][s_]; const f32x4 c0 = (f32x4){nb, nb, nb, nb}; \
                S0[(g) & 1][qb] = __builtin_amdgcn_mfma_f32_16x16x32_bf16(kf0, qf[qb][s_], c0, 0, 0, 0); \
                S1[(g) & 1][qb] = __builtin_amdgcn_mfma_f32_16x16x32_bf16(kf1, qf[qb][s_], c0, 0, 0, 0); } } while (0)
#define DIFF_EXP(g) do { _Pragma("unroll") for (int qb = 0; qb < 2; ++qb) { f32x4 e0, e1; \
                _Pragma("unroll") for (int j = 0; j < 4; ++j) { e0[j] = __builtin_amdgcn_exp2f(S0[(g) & 1][qb][j]); e1[j] = __builtin_amdgcn_exp2f(S1[(g) & 1][qb][j]); } \
                pfr[(g) & 1][qb] = pack8(e0, e1); } } while (0)
#define DIFF_VLOAD(i_) do { _Pragma("unroll") for (int dvb = 0; dvb < 4; ++dvb) { const u16* vp = Vb + (dvb * 16 + fr) * 72 + (2 * (i_)) * 16 + fq * 4; \
                const s16x4 lo = *(const s16x4*)vp, hi = *(const s16x4*)(vp + 16); vfr[dvb] = __builtin_shufflevector(lo, hi, 0, 1, 2, 3, 4, 5, 6, 7); } } while (0)
#define DIFF_PV(g) do { const int s_ = (g) & 1; \
            _Pragma("unroll") for (int qb = 0; qb < 2; ++qb) Ls[qb][s_] = __builtin_amdgcn_mfma_f32_16x16x32_bf16(ones, pfr[(g) & 1][qb], Ls[qb][s_], 0, 0, 0); \
            _Pragma("unroll") for (int dvb = 0; dvb < 4; ++dvb) _Pragma("unroll") for (int qb = 0; qb < 2; ++qb) \
                O[qb][s_][dvb] = __builtin_amdgcn_mfma_f32_16x16x32_bf16(vfr[dvb], pfr[(g) & 1][qb], O[qb][s_][dvb], 0, 0, 0); } while (0)
        DIFF_QK(0); DIFF_VLOAD(0);
        DIFF_QK(1); DIFF_EXP(0);
        DIFF_QK(2); DIFF_EXP(1); DIFF_PV(0);
        DIFF_QK(3); DIFF_EXP(2); DIFF_PV(1); DIFF_VLOAD(1);
        DIFF_EXP(3); DIFF_PV(2);
        DIFF_PV(3);
#undef DIFF_QK
#undef DIFF_EXP
#undef DIFF_VLOAD
#undef DIFF_PV
    };
    bf16x8 kA = *(const bf16x8*)kaddr(0), vA = *(const bf16x8*)vaddr(0), kB = *(const bf16x8*)kaddr(1), vB = *(const bf16x8*)vaddr(1);
    __syncthreads();
#pragma unroll 1
    for (int t = 0; t < ntiles; t += 2) {
        u16* K0 = Ks + ((t >> 1) & 1) * 2 * 64 * 64; u16* V0 = Vs + ((t >> 1) & 1) * 2 * 64 * 72;
        *(bf16x8*)(K0 + sr * 64 + ((pc ^ ((sr >> 1) & 7)) * 8)) = kA; *(bf16x8*)(V0 + sr * 72 + pc * 8) = vA;
        *(bf16x8*)(K0 + 64 * 64 + sr * 64 + ((pc ^ ((sr >> 1) & 7)) * 8)) = kB; *(bf16x8*)(V0 + 64 * 72 + sr * 72 + pc * 8) = vB;
        __syncthreads();
        if (t + 2 < ntiles) { kA = *(const bf16x8*)kaddr(t + 2); vA = *(const bf16x8*)vaddr(t + 2); kB = *(const bf16x8*)kaddr(t + 3); vB = *(const bf16x8*)vaddr(t + 3); }
        compute_tile(K0, V0);
        compute_tile(K0 + 64 * 64, V0 + 64 * 72);
    }
    const float lam_init = (layer == 0) ? 0.2f : (0.8f - 0.6f * 0.7408182206817179f);
    float d1 = 0.f, d2 = 0.f;
    if (lane < 32) { d1 = a.in[I_LQ1][layer * 32 + lane] * a.in[I_LK1][layer * 32 + lane]; d2 = a.in[I_LQ2][layer * 32 + lane] * a.in[I_LK2][layer * 32 + lane]; }
    const float lam = expf(wave_sum(d1)) - expf(wave_sum(d2)) + lam_init;
    const float* dnw = a.in[I_DNORM] + layer * 64;
    u16* MIX = (u16*)(a.ws + WS_A);
#pragma unroll
    for (int qb = 0; qb < 2; ++qb) {
        const float l1 = Ls[qb][0][0], l2 = Ls[qb][1][0];
        const float i1 = 1.0f / l1, i2 = lam / l2;
        f32x4 o[4]; float ss = 0.f;
#pragma unroll
        for (int dvb = 0; dvb < 4; ++dvb) { o[dvb] = O[qb][0][dvb] * i1 - O[qb][1][dvb] * i2; ss += (o[dvb][0] * o[dvb][0] + o[dvb][1] * o[dvb][1]) + (o[dvb][2] * o[dvb][2] + o[dvb][3] * o[dvb][3]); }
        ss += __shfl_xor(ss, 16); ss += __shfl_xor(ss, 32);
        const float r = rsqrtf(ss * (1.0f / 64.0f) + 1e-6f) * (1.0f - lam_init);
        const int row = q0row + wave * 32 + qb * 16 + fr;
#pragma unroll
        for (int dvb = 0; dvb < 4; ++dvb) {
            const int v0 = dvb * 16 + fq * 4; const f32x4 nw = *(const f32x4*)(dnw + v0);
            u32x2 w; w.x = pk2(o[dvb][0] * r * nw[0], o[dvb][1] * r * nw[1]); w.y = pk2(o[dvb][2] * r * nw[2], o[dvb][3] * r * nw[3]);
            *(u32x2*)(MIX + (size_t)row * D + 512 + h * 64 + v0) = w;
        }
    }
}

__device__ __forceinline__ void na_wave(const Args& a, int layer, bool ctxq, int wu, int lane) {
    asm volatile("" : "+v"(lane));
    const int fr = lane & 15, fq = lane >> 4;
    const u16* P = (const u16*)(a.ws + WS_X);
    int b, h, r, qblk, qrow;
    if (!ctxq) { qblk = wu & 3; h = (wu >> 2) & 3; r = (wu >> 4) & 255; b = wu >> 12; qrow = b * SEQ + r * 64 + qblk * 16 + fr; }
    else { qblk = wu & 15; h = (wu >> 4) & 3; b = wu >> 6; r = 0; qrow = MX + b * CTXL + qblk * 16 + fr; }
    const int c = qblk * 16 + fr;
    const u16* VTN = (const u16*)(a.ws + WS_VTN) + (size_t)(b * 4 + h) * 64 * NKEY;
    const float C2 = 0.125f * LOG2E;
    bf16x8 qf[2]; float n2 = 0.f;
#pragma unroll
    for (int ks = 0; ks < 2; ++ks) qf[ks] = load_scaled8(P + (size_t)qrow * DPROJ + C_NQ + h * 64 + ks * 32 + fq * 8, C2, n2);
    n2 += __shfl_xor(n2, 16); n2 += __shfl_xor(n2, 32);
    const float km = __uint_as_float(((const unsigned*)(a.ws + WS_CTL))[layer * 64 + 16 + b * 4 + h]);
    const float bmax = ((const float*)(a.ws + WS_MISC))[8192 + layer];
    const float negb = -(sqrtf(n2 * km) + bmax * LOG2E);
    const float* rpb = a.in[I_RPB] + (size_t)(layer * 4 + h) * 15 * 31;
    const int rs = min(max(r - 4, 0), 248), cs = min(max(c - 8, 0), 48);
    f32x4 O[4]; float ls = 0.f;
#pragma unroll
    for (int dvb = 0; dvb < 4; ++dvb) O[dvb] = (f32x4){0.f, 0.f, 0.f, 0.f};
    const int nwh = (qblk == 0 || qblk == 3) ? 1 : 2, nwin = ctxq ? 0 : 8 * nwh, nsteps = nwin + 8;
    struct NaStep { bf16x8 kf[2][2]; s16x4 vlo[4], vhi[4]; float iv[2][4]; };
    auto load_step = [&](int st, NaStep& S) {
        int t, i; bool win;
        if (st < nwin) { win = true; if (nwh == 2) { t = st >> 1; i = st & 1; } else { t = st; i = (qblk == 3) ? 1 : 0; } }
        else { win = false; const int s2 = st - nwin; t = s2 >> 1; i = s2 & 1; }
        const int kr = rs + t;
        const int krow0 = win ? (b * SEQ + kr * 64) : (MX + b * CTXL + t * 64);
        const int key0 = win ? (CTXL + kr * 64) : (t * 64);
#pragma unroll
        for (int kbb = 0; kbb < 2; ++kbb) {
            const int kb = 2 * i + kbb;
#pragma unroll
            for (int ks = 0; ks < 2; ++ks) S.kf[kbb][ks] = *(const bf16x8*)(P + (size_t)(krow0 + kb * 16 + fr) * DPROJ + C_NK + h * 64 + ks * 32 + fq * 8);
#pragma unroll
            for (int j = 0; j < 4; ++j) {
                float iv = negb;
                if (win) { const int kc = kb * 16 + fq * 4 + j; const bool inw = (kc >= cs) && (kc < cs + 16);
                    const int co = min(max(kc - c + 15, 0), 30);
                    const float bias = rpb[(kr - r + 7) * 31 + co];
                    iv = inw ? (bias * LOG2E + negb) : -1e30f; }
                S.iv[kbb][j] = iv;
            }
        }
#pragma unroll
        for (int dvb = 0; dvb < 4; ++dvb) {
            const u16* vp = VTN + (size_t)(dvb * 16 + fr) * NKEY + key0 + (2 * i) * 16 + fq * 4;
            S.vlo[dvb] = *(const s16x4*)vp; S.vhi[dvb] = *(const s16x4*)(vp + 16);
        }
    };
    auto compute_step = [&](const NaStep& S) {
        f32x4 acc[2];
#pragma unroll
        for (int kbb = 0; kbb < 2; ++kbb) {
            acc[kbb] = (f32x4){S.iv[kbb][0], S.iv[kbb][1], S.iv[kbb][2], S.iv[kbb][3]};
#pragma unroll
            for (int ks = 0; ks < 2; ++ks) acc[kbb] = __builtin_amdgcn_mfma_f32_16x16x32_bf16(S.kf[kbb][ks], qf[ks], acc[kbb], 0, 0, 0);
#pragma unroll
            for (int j = 0; j < 4; ++j) acc[kbb][j] = __builtin_amdgcn_exp2f(acc[kbb][j]);
            ls += (acc[kbb][0] + acc[kbb][1]) + (acc[kbb][2] + acc[kbb][3]);
        }
        const bf16x8 pf = pack8(acc[0], acc[1]);
#pragma unroll
        for (int dvb = 0; dvb < 4; ++dvb) {
            const bf16x8 vf = __builtin_shufflevector(S.vlo[dvb], S.vhi[dvb], 0, 1, 2, 3, 4, 5, 6, 7);
            O[dvb] = __builtin_amdgcn_mfma_f32_16x16x32_bf16(vf, pf, O[dvb], 0, 0, 0);
        }
    };
    {
        NaStep SA, SB;
        load_step(0, SA);
#pragma unroll 1
        for (int st = 0; st < nsteps; st += 2) {
            load_step(st + 1, SB);
            compute_step(SA);
            if (st + 2 < nsteps) load_step(st + 2, SA);
            compute_step(SB);
        }
    }
    ls += __shfl_xor(ls, 16); ls += __shfl_xor(ls, 32);
    const float il = 1.0f / ls;
    u16* MIX = (u16*)(a.ws + WS_A);
#pragma unroll
    for (int dvb = 0; dvb < 4; ++dvb) {
        u32x2 w; w.x = pk2(O[dvb][0] * il, O[dvb][1] * il); w.y = pk2(O[dvb][2] * il, O[dvb][3] * il);
        *(u32x2*)(MIX + (size_t)qrow * D + 256 + h * 64 + dvb * 16 + fq * 4) = w;
    }
}


template <int QH> __device__ __forceinline__ void na_unit(const Args& a, int layer, int b, int h, int g, uchar* lds) {
    int tid = threadIdx.x; asm volatile("" : "+v"(tid)); const int lane = tid & 63, wave = __builtin_amdgcn_readfirstlane(tid >> 6), fr = lane & 15, fq = lane >> 4;
    const u16* P = (const u16*)(a.ws + WS_X);
    const u16* VTN = (const u16*)(a.ws + WS_VTN) + (size_t)(b * 4 + h) * 64 * NKEY;
    u16* Ks = (u16*)lds;
    u16* Vs = (u16*)(lds + 2 * 64 * 64 * 2);
    const int r = 8 * g + wave, rsw = min(max(r - 4, 0), 248);
    const float C2 = 0.125f * LOG2E;
    const float km = __uint_as_float(((const unsigned*)(a.ws + WS_CTL))[layer * 64 + 16 + b * 4 + h]);
    const float bmax = ((const float*)(a.ws + WS_MISC))[8192 + layer];
    const float* rpb = a.in[I_RPB] + (size_t)(layer * 4 + h) * 15 * 31;
    bf16x8 qf[2][2]; float negb[2], ls[2];
    unsigned mlo = 0u;
#pragma unroll
    for (int qq = 0; qq < 2; ++qq) {
        const int qblk = 2 * QH + qq;
        const int qrow = b * SEQ + r * 64 + qblk * 16 + fr; float n2 = 0.f;
#pragma unroll
        for (int ks = 0; ks < 2; ++ks) qf[qq][ks] = load_scaled8(P + (size_t)qrow * DPROJ + C_NQ + h * 64 + ks * 32 + fq * 8, C2, n2);
        n2 += __shfl_xor(n2, 16); n2 += __shfl_xor(n2, 32);
        negb[qq] = -(sqrtf(n2 * km) + bmax * LOG2E); ls[qq] = 0.f;
        const int c = qblk * 16 + fr, cs = min(max(c - 8, 0), 48);
#pragma unroll
        for (int kb = 0; kb < 4; ++kb)
#pragma unroll
            for (int j = 0; j < 4; ++j) { const int kc = kb * 16 + fq * 4 + j; const unsigned bit = (kc >= cs && kc < cs + 16) ? 1u : 0u; const int idx = (qq * 4 + kb) * 4 + j;
                mlo |= bit << idx; }
    }
    f32x4 O[2][4];
#pragma unroll
    for (int qq = 0; qq < 2; ++qq)
#pragma unroll
        for (int dvb = 0; dvb < 4; ++dvb) O[qq][dvb] = (f32x4){0.f, 0.f, 0.f, 0.f};
    const int lo = min(max(8 * g - 4, 0), 248), hi = min(max(8 * g + 3, 0), 248) + 7, nwin = hi - lo + 1, ntiles = nwin + 4;
    const int sr = tid >> 3, pc = tid & 7;
    auto kaddr = [&](int t) -> const u16* { const int krow = (t < nwin) ? (b * SEQ + (lo + t) * 64 + sr) : (MX + b * CTXL + (t - nwin) * 64 + sr); return P + (size_t)krow * DPROJ + C_NK + h * 64 + pc * 8; };
    auto vaddr = [&](int t) -> const u16* { const int key0 = (t < nwin) ? (CTXL + (lo + t) * 64) : ((t - nwin) * 64); return VTN + (size_t)sr * NKEY + key0 + pc * 8; };
    bf16x8 kreg = *(const bf16x8*)kaddr(0), vreg = *(const bf16x8*)vaddr(0);
    __syncthreads();
#pragma unroll 1
    for (int t = 0; t < ntiles; ++t) {
        u16* Kb = Ks + (t & 1) * 64 * 64; u16* Vb = Vs + (t & 1) * 64 * 72;
        *(bf16x8*)(Kb + sr * 64 + ((pc ^ ((sr >> 1) & 7)) * 8)) = kreg; *(bf16x8*)(Vb + sr * 72 + pc * 8) = vreg;
        __syncthreads();
        if (t + 1 < ntiles) { kreg = *(const bf16x8*)kaddr(t + 1); vreg = *(const bf16x8*)vaddr(t + 1); }
        const bool win = t < nwin; const int kr = lo + t;
        if (win && (kr < rsw || kr > rsw + 7)) continue;
        float bl[3][4];
        if (win) {
#pragma unroll
            for (int dl = 0; dl < 3; ++dl)
#pragma unroll
                for (int j = 0; j < 4; ++j) { const int co = min(max(16 * (dl - 1) + fq * 4 + j - fr + 15, 0), 30); bl[dl][j] = rpb[(kr - r + 7) * 31 + co] * LOG2E; }
        }
#pragma unroll
        for (int i = 0; i < 2; ++i) {
            bf16x8 kf[2][2], vf[4];
#pragma unroll
            for (int kbb = 0; kbb < 2; ++kbb)
#pragma unroll
                for (int ks = 0; ks < 2; ++ks) kf[kbb][ks] = *(const bf16x8*)(Kb + ((2 * i + kbb) * 16 + fr) * 64 + (((ks * 4 + fq) ^ (fr >> 1)) * 8));
#pragma unroll
            for (int dvb = 0; dvb < 4; ++dvb) { const u16* vp = Vb + (dvb * 16 + fr) * 72 + (2 * i) * 16 + fq * 4;
                const s16x4 vlo = *(const s16x4*)vp, vhi = *(const s16x4*)(vp + 16); vf[dvb] = __builtin_shufflevector(vlo, vhi, 0, 1, 2, 3, 4, 5, 6, 7); }
#pragma unroll
            for (int qq = 0; qq < 2; ++qq) {
                const int qblk = 2 * QH + qq;
                if (win && ((qblk == 0 && i == 1) || (qblk == 3 && i == 0))) continue;
                f32x4 p[2];
#pragma unroll
                for (int kbb = 0; kbb < 2; ++kbb) {
                    const int kb = 2 * i + kbb, dl = kb - qblk;
                    if (win && (dl < -1 || dl > 1)) { p[kbb] = (f32x4){0.f, 0.f, 0.f, 0.f}; continue; }
                    f32x4 acc;
#pragma unroll
                    for (int j = 0; j < 4; ++j) {
                        float iv = negb[qq];
                        if (win) { const int idx = (qq * 4 + kb) * 4 + j; const bool inw = (mlo >> idx) & 1u;
                            iv = inw ? (bl[(dl + 1) < 0 ? 0 : ((dl + 1) > 2 ? 2 : (dl + 1))][j] + negb[qq]) : -1e30f; }
                        acc[j] = iv;
                    }
#pragma unroll
                    for (int ks = 0; ks < 2; ++ks) acc = __builtin_amdgcn_mfma_f32_16x16x32_bf16(kf[kbb][ks], qf[qq][ks], acc, 0, 0, 0);
#pragma unroll
                    for (int j = 0; j < 4; ++j) acc[j] = __builtin_amdgcn_exp2f(acc[j]);
                    ls[qq] += (acc[0] + acc[1]) + (acc[2] + acc[3]);
                    p[kbb] = acc;
                }
                const bf16x8 pf = pack8(p[0], p[1]);
#pragma unroll
                for (int dvb = 0; dvb < 4; ++dvb) O[qq][dvb] = __builtin_amdgcn_mfma_f32_16x16x32_bf16(vf[dvb], pf, O[qq][dvb], 0, 0, 0);
            }
        }
    }
    u16* MIX = (u16*)(a.ws + WS_A);
#pragma unroll
    for (int qq = 0; qq < 2; ++qq) {
        const int qblk = 2 * QH + qq;
        float l = ls[qq]; l += __shfl_xor(l, 16); l += __shfl_xor(l, 32);
        const float il = 1.0f / l; const int qrow = b * SEQ + r * 64 + qblk * 16 + fr;
#pragma unroll
        for (int dvb = 0; dvb < 4; ++dvb) {
            u32x2 w; w.x = pk2(O[qq][dvb][0] * il, O[qq][dvb][1] * il); w.y = pk2(O[qq][dvb][2] * il, O[qq][dvb][3] * il);
            *(u32x2*)(MIX + (size_t)qrow * D + 256 + h * 64 + dvb * 16 + fq * 4) = w;
        }
    }
}


__device__ __forceinline__ void ctx_resid_gemm(const Args& a, const u16* A, const u16* Bt, int K, const float* gate, float coef, uchar* lds) {
    int tid = threadIdx.x; asm volatile("" : "+v"(tid)); const int lane = tid & 63, wave = __builtin_amdgcn_readfirstlane(tid >> 6), fr = lane & 15, fq = lane >> 4;
    float* red = (float*)lds;
    float* Hc = (float*)(a.ws + WS_HC);
    const int nks = K >> 5;
    for (int tile = blockIdx.x; tile < 256; tile += gridDim.x) {
        const int row0 = (tile >> 4) * 32, col0 = (tile & 15) * 64;
        f32x4 acc[2][4];
#pragma unroll
        for (int rb = 0; rb < 2; ++rb)
#pragma unroll
            for (int cb = 0; cb < 4; ++cb) acc[rb][cb] = (f32x4){0.f, 0.f, 0.f, 0.f};
#pragma unroll 4
        for (int ks = wave; ks < nks; ks += 8) {
            bf16x8 af[2], bfr[4];
#pragma unroll
            for (int rb = 0; rb < 2; ++rb) af[rb] = *(const bf16x8*)(A + (size_t)(row0 + rb * 16 + fr) * K + ks * 32 + fq * 8);
#pragma unroll
            for (int cb = 0; cb < 4; ++cb) bfr[cb] = *(const bf16x8*)(Bt + (size_t)(col0 + cb * 16 + fr) * K + ks * 32 + fq * 8);
#pragma unroll
            for (int rb = 0; rb < 2; ++rb)
#pragma unroll
                for (int cb = 0; cb < 4; ++cb) acc[rb][cb] = __builtin_amdgcn_mfma_f32_16x16x32_bf16(bfr[cb], af[rb], acc[rb][cb], 0, 0, 0);
        }
        __syncthreads();
#pragma unroll
        for (int rb = 0; rb < 2; ++rb)
#pragma unroll
            for (int cb = 0; cb < 4; ++cb) *(f32x4*)(red + wave * 2048 + (rb * 16 + fr) * 64 + cb * 16 + fq * 4) = acc[rb][cb];
        __syncthreads();
        {
            const int idx = tid * 4, rr = idx >> 6, cc = idx & 63;
            f32x4 sum = (f32x4){0.f, 0.f, 0.f, 0.f};
#pragma unroll
            for (int w = 0; w < 8; ++w) sum = sum + *(const f32x4*)(red + w * 2048 + idx);
            const f32x4 gv = *(const f32x4*)(gate + col0 + cc) * coef;
            f32x4* p = (f32x4*)(Hc + (size_t)(row0 + rr) * D + col0 + cc);
            *p = *p + gv * sum;
        }
    }
    __syncthreads();
}


#ifndef PROBE_DIFF
#define PROBE_DIFF 1
#endif
#ifndef PROBE_NA
#define PROBE_NA 1
#endif
#ifndef PROBE_G13
#define PROBE_G13 1
#endif
#ifndef PROBE_G1
#define PROBE_G1 1
#endif
#ifndef PROBE_PREP
#define PROBE_PREP 1
#endif
#ifndef PROBE_SYNC
#define PROBE_SYNC 0
#endif
#ifndef PROBE_CONV
#define PROBE_CONV 1
#endif
#ifndef PROBE_G3
#define PROBE_G3 1
#endif
#ifndef PROBE_NORM
#define PROBE_NORM 1
#endif
template <int PHMASK, int PH> __device__ __forceinline__ void phase_body(const Args& a, unsigned char* lds) {
    int tid = threadIdx.x; asm volatile("" : "+v"(tid)); const int lane = tid & 63, wave = __builtin_amdgcn_readfirstlane(tid >> 6), G = gridDim.x, bid = blockIdx.x;
    u16* const Abuf = (u16*)(a.ws + WS_A);
    u16* const Xbuf = (u16*)(a.ws + WS_X);
    if constexpr (PH == 0) { if constexpr ((PHMASK & 1) != 0) for (int rep = 0; rep < PROBE_PREP; ++rep) { __syncthreads(); phase_prep(a, lds); } }
    else if constexpr (PH == NPHASE - 1) { if constexpr ((PHMASK & 2) != 0) phase_final(a); }
    else {
        constexpr int layer = (PH - 1) / 12, sp = (PH - 1) % 12;
        constexpr bool last = (layer == 1);
        constexpr int Mpost = last ? MX : MT;
        if constexpr (sp == 0) { if constexpr ((PHMASK & 2) != 0) for (int rep = 0; rep < PROBE_NORM; ++rep) phase_norm(a, layer, 0, MT, layer == 0); }
        if constexpr (sp == 3) { if constexpr ((PHMASK & 2) != 0) for (int rep = 0; rep < PROBE_NORM; ++rep) phase_norm(a, layer, 1, MT, false); }
        if constexpr (sp == 9) { if constexpr ((PHMASK & 2) != 0) for (int rep = 0; rep < PROBE_NORM; ++rep) phase_norm(a, layer, 2, Mpost, false); }
        if constexpr ((sp == 1 || sp == 10) && (PHMASK & 4)) {
            const int M = (sp == 1) ? MT : Mpost;
            pg8::Gemm g{Abuf, (const u16*)(a.ws + WS_W13) + (size_t)(layer * 2 + (sp == 1 ? 0 : 1)) * 2 * DFF * D, M, 2 * DFF, D};
            pg8::StaticOrder S; S.init(M, 2 * DFF, G, bid);
            EpiSwiglu E{Xbuf};
            for (int rep = 0; rep < PROBE_G13; ++rep) pg8::gemm_phase<EpiSwiglu, pg8::StaticOrder, true, true>((LAS unsigned char*)lds, g, S, E);
        }
        if constexpr ((sp == 2 || sp == 11) && (PHMASK & 4)) {
            constexpr bool with_ctx = (sp == 2) || !last;
            const u16* W2t = (const u16*)(a.ws + WS_W2) + (size_t)(layer * 2 + (sp == 2 ? 0 : 1)) * D * DFF;
            pg8::Gemm g{Xbuf, W2t, MX, D, DFF};
            pg8::StaticOrder S; S.init(MX, D, G, bid);
            EpiResid E{a.out, (float*)(a.ws + WS_HC), modp(a, layer, 0, sp == 2 ? 2 : 8), 0.5f};
            pg8::gemm_phase<EpiResid, pg8::StaticOrder, true, true>((LAS unsigned char*)lds, g, S, E);
            if constexpr (with_ctx) ctx_resid_gemm(a, Xbuf + (size_t)MX * DFF, W2t, DFF, modp(a, layer, 2, sp == 2 ? 2 : 8), 0.5f, lds);
        }
        if constexpr (sp == 4 && (PHMASK & 4)) {
            pg8::Gemm g{Abuf, (const u16*)(a.ws + WS_WIN) + (size_t)layer * NPROJ * D, MT, NPROJ, D};
            pg8::StaticOrder S; S.init(MT, NPROJ, G, bid);
            EpiProj E{Xbuf};
            pg8::gemm_phase<EpiProj, pg8::StaticOrder, true, true>((LAS unsigned char*)lds, g, S, E);
        }
        if constexpr (sp == 5) {
            if constexpr ((PHMASK & 8) != 0) for (int u = bid; u < 2 * NCH; u += G) prep_unit(a, layer, u, lds);
            __syncthreads();
            if constexpr ((PHMASK & 16) != 0) for (int rep = 0; rep < PROBE_G1; ++rep) {
                const int gw = bid * 8 + wave, NGW = G * 8;
                for (int wu = gw; wu < 4096; wu += NGW) {
                    const int dir = wu & 1, h = (wu >> 1) & 3, xc = (wu >> 3) & 255, b = wu >> 11;
                    if (dir) gla_g1_wave<1>(a, layer, b, xc + 4, h, lds + wave * 16384, lane); else gla_g1_wave<0>(a, layer, b, xc + 4, h, lds + wave * 16384, lane);
                }
                for (int j = 0; j < 64; ++j) if ((j * 32) % NGW == gw) {
                    const int dir = j & 1, h = (j >> 1) & 3, c = (j >> 3) & 3, b = j >> 5;
                    if (dir) gla_g1_wave<1>(a, layer, b, c, h, lds + wave * 16384, lane); else gla_g1_wave<0>(a, layer, b, c, h, lds + wave * 16384, lane);
                }
            }
            __syncthreads();
            const int ncu = last ? 1024 : 1040;
            if constexpr ((PHMASK & 32) != 0) {
                bf16x8 wf[2][8];
                { const u16* PWT = (const u16*)(a.ws + WS_PWT) + (size_t)layer * 256 * 256; const int fr = lane & 15, fq = lane >> 4;
#pragma unroll
                  for (int nbi = 0; nbi < 2; ++nbi)
#pragma unroll
                    for (int ks = 0; ks < 8; ++ks) wf[nbi][ks] = *(const bf16x8*)(PWT + (size_t)((wave * 2 + nbi) * 16 + fr) * 256 + ks * 32 + fq * 8); }
                for (int rep = 0; rep < PROBE_CONV; ++rep) for (int u = bid; u < ncu; u += G) conv_unit(a, layer, u, lds, wf);
            }
        }
        if constexpr (sp == 6) {
            if constexpr ((PHMASK & 64) != 0) gla_scan(a, lds);
            if constexpr ((PHMASK & 128) != 0) for (int rep = 0; rep < PROBE_NA; ++rep) for (int u = bid; u < 512; u += G) { const int uu = u >> 1; if (u & 1) na_unit<1>(a, layer, uu >> 7, (uu >> 5) & 3, uu & 31, lds); else na_unit<0>(a, layer, uu >> 7, (uu >> 5) & 3, uu & 31, lds); }
            if constexpr ((PHMASK & 128) != 0 && !last) for (int wu = bid * 8 + wave; wu < 2 * 4 * 16; wu += G * 8) na_wave(a, layer, true, wu, lane);
            if constexpr ((PHMASK & 256) != 0) for (int rep = 0; rep < PROBE_DIFF; ++rep) for (int u = bid; u < 512; u += G) { const int b = u >> 8, h = (u >> 6) & 3, qb = u & 63; diff_unit(a, layer, b, h, b * SEQ + qb * 256, NCH, lds); }
            if constexpr ((PHMASK & 256) != 0 && !last) for (int u = bid; u < 8; u += G) { const int b = u >> 2, h = u & 3; diff_unit(a, layer, b, h, MX + b * CTXL, 4, lds); }
        }
        if constexpr (sp == 7) {
            __syncthreads();
            if constexpr ((PHMASK & 512) != 0) for (int rep = 0; rep < PROBE_G3; ++rep) for (int wu = bid * 8 + wave; wu < 2 * NCH * 4; wu += G * 8) { const int c = (wu >> 2) % NCH; if (last && c < 4) continue; gla_g3_wave(a, layer, wu, lds + wave * 16384, lane); }
        }
        if constexpr (sp == 8 && (PHMASK & 4)) {
            const u16* Wot = (const u16*)(a.ws + WS_WOUT) + (size_t)layer * D * D;
            pg8::Gemm g{Abuf, Wot, MX, D, D};
            pg8::StaticOrder S; S.init(MX, D, G, bid);
            EpiResid E{a.out, (float*)(a.ws + WS_HC), modp(a, layer, 0, 5), 1.0f};
            pg8::gemm_phase<EpiResid, pg8::StaticOrder, true, true>((LAS unsigned char*)lds, g, S, E);
            if constexpr (!last) ctx_resid_gemm(a, Abuf + (size_t)MX * D, Wot, D, modp(a, layer, 2, 5), 1.0f, lds);
        }
    }
}
template <int PHMASK, int PH> __device__ __forceinline__ void run_phase(const Args& a, int lo, int hi, unsigned char* lds, cg::grid_group& grid, const XcdBarrier& bar) {
    if (lo <= PH && PH < hi) { if (PH > lo) { if (PH == lo + 1) grid.sync(); else xcd_barrier(bar); } phase_body<PHMASK, PH>(a, lds); }
}
template <int PHMASK> __device__ __forceinline__ void run_phases(const Args& a, unsigned char* lds) {
    cg::grid_group grid = cg::this_grid();
    const int lo = a.ph_lo, hi = a.ph_hi;
    volatile LAS unsigned* st = (volatile LAS unsigned*)((LAS unsigned char*)lds + 131072);
    if (threadIdx.x < 2) st[threadIdx.x] = 0u;
    __syncthreads();
    const XcdBarrier bar = xcd_barrier_post((unsigned*)(a.ws + WS_CTL) + 16384, st);
#define RP(k) run_phase<PHMASK, k>(a, lo, hi, lds, grid, bar);
    RP(0) RP(1) RP(2) RP(3) RP(4) RP(5) RP(6) RP(7) RP(8) RP(9) RP(10) RP(11) RP(12) RP(13) RP(14) RP(15) RP(16) RP(17) RP(18) RP(19) RP(20) RP(21) RP(22) RP(23) RP(24) RP(25)
#undef RP
}
extern __shared__ __attribute__((aligned(16))) unsigned char dyn_lds[];
template <int PM> __global__ void __launch_bounds__(512, 2) part_fwd(Args a) { run_phases<PM>(a, dyn_lds); }
#ifndef MK_PER_PHASE
#define MK_PER_PHASE 0
#endif
#if !MK_PER_PHASE
__global__ void __launch_bounds__(512, 2) mega_fwd(Args a) { run_phases<0xFFFF>(a, dyn_lds); }
#define MAIN_KERNEL mega_fwd
#else
#define MAIN_KERNEL part_fwd<4>
#endif
#ifndef MK_PER_PHASE
#define MK_PER_PHASE 0
#endif
extern "C" void kernel_launch(void* const* d_in, const int* in_sizes, int n_in, void* d_out, int out_size, void* d_ws, size_t ws_size, hipStream_t stream) {
    static int grid = 0;
    if (grid == 0) {
        if (n_in != 33 || ws_size < WS_END) { fprintf(stderr, "kernel_launch: unexpected n_in %d / ws_size %zu (need %zu)\n", n_in, ws_size, (size_t)WS_END); grid = -1; return; }
        int dev = 0, cus = 0, per_cu = 0;
        hipGetDevice(&dev); hipDeviceGetAttribute(&cus, hipDeviceAttributeMultiprocessorCount, dev);
        if (hipFuncSetAttribute((const void*)MAIN_KERNEL, hipFuncAttributeMaxDynamicSharedMemorySize, LDS_BYTES) != hipSuccess) { fprintf(stderr, "kernel_launch: hipFuncSetAttribute failed\n"); grid = -1; return; }
#if MK_PER_PHASE
        (void)hipFuncSetAttribute((const void*)part_fwd<1>, hipFuncAttributeMaxDynamicSharedMemorySize, LDS_BYTES); (void)hipFuncSetAttribute((const void*)part_fwd<2>, hipFuncAttributeMaxDynamicSharedMemorySize, LDS_BYTES);
        (void)hipFuncSetAttribute((const void*)part_fwd<4>, hipFuncAttributeMaxDynamicSharedMemorySize, LDS_BYTES); (void)hipFuncSetAttribute((const void*)part_fwd<56>, hipFuncAttributeMaxDynamicSharedMemorySize, LDS_BYTES);
        (void)hipFuncSetAttribute((const void*)part_fwd<448>, hipFuncAttributeMaxDynamicSharedMemorySize, LDS_BYTES); (void)hipFuncSetAttribute((const void*)part_fwd<512>, hipFuncAttributeMaxDynamicSharedMemorySize, LDS_BYTES);
#endif
        if (hipOccupancyMaxActiveBlocksPerMultiprocessor(&per_cu, (const void*)MAIN_KERNEL, 512, LDS_BYTES) != hipSuccess || per_cu < 1) { fprintf(stderr, "kernel_launch: occupancy query says %d\n", per_cu); per_cu = 1; }
        (void)hipGetLastError();
        grid = cus;
    }
    if (grid < 0) return;
    (void)hipMemsetAsync((char*)d_ws + WS_CTL, 0, 131072, stream);
    Args a{};
    for (int i = 0; i < 33; ++i) a.in[i] = (const float*)d_in[i];
    a.out = (float*)d_out; a.ws = (unsigned char*)d_ws;
#if MK_PER_PHASE
    for (int ph = 0; ph < NPHASE; ++ph) {
        a.ph_lo = ph; a.ph_hi = ph + 1;
        const int sp = (ph == 0 || ph == NPHASE - 1) ? -1 : (ph - 1) % 12;
        if (ph == 0) hipLaunchKernelGGL(part_fwd<1>, dim3(grid), dim3(512), LDS_BYTES, stream, a);
        else if (sp == -1 || sp == 0 || sp == 3 || sp == 9) hipLaunchKernelGGL(part_fwd<2>, dim3(grid), dim3(512), LDS_BYTES, stream, a);
        else if (sp == 5) hipLaunchKernelGGL(part_fwd<56>, dim3(grid), dim3(512), LDS_BYTES, stream, a);
        else if (sp == 6) hipLaunchKernelGGL(part_fwd<448>, dim3(grid), dim3(512), LDS_BYTES, stream, a);
        else if (sp == 7) hipLaunchKernelGGL(part_fwd<512>, dim3(grid), dim3(512), LDS_BYTES, stream, a);
        else hipLaunchKernelGGL(part_fwd<4>, dim3(grid), dim3(512), LDS_BYTES, stream, a);
    }
#else
    a.ph_lo = 0; a.ph_hi = NPHASE;
    void* args[] = {&a};
    hipError_t e = hipLaunchCooperativeKernel((const void*)mega_fwd, dim3(grid), dim3(512), args, LDS_BYTES, stream);
    if (e != hipSuccess) fprintf(stderr, "kernel_launch: cooperative launch failed: %s (grid %d)\n", hipGetErrorString(e), grid);
#endif
}
```

```cpp
#include <hip/hip_runtime.h>
#include <hip/hip_cooperative_groups.h>
#include <cstdio>
#include <cstdint>
namespace cg = cooperative_groups;
#define MK_PER_PHASE 0
namespace pg8 {
#define PG8_LAS __attribute__((address_space(3)))
typedef unsigned short bf16_t;
typedef short bf16x8 __attribute__((ext_vector_type(8)));
typedef float f32x4 __attribute__((ext_vector_type(4)));
typedef unsigned u32x4 __attribute__((ext_vector_type(4)));
constexpr int BM = 256, BK = 64, HALF = 128, HTB = HALF * BK * 2  , STAGE_BYTES = 8 * HTB, NXCD = 8, WGM = 8;

__host__ __device__ __forceinline__ int lds_byte(int r, int c) { const int st = (r >> 4) * 2 + (c >> 5), rr = r & 15, cc = c & 31, ob = rr * 64 + cc * 2; return st * 1024 + (ob ^ (((ob >> 9) & 1) << 5)); }
__host__ __device__ __forceinline__ void stage_rc(int b, int& R, int& C) { const int st = b / 1024, sb = b % 1024, swz = sb ^ (((sb >> 9) & 1) << 5); R = (st >> 1) * 16 + swz / 64; C = (st & 1) * 32 + (swz % 64) / 2; }
__host__ __device__ __forceinline__ int perm32(int rho) { const int n = rho >> 4, i = rho & 15; return 8 * (i >> 2) + 4 * n + (i & 3); }

struct Unit { int pm, pn; };
struct Gemm { const bf16_t* A; const bf16_t* Bt; int M, N, K; };

struct StaticOrder {
    int nM, nN, nwg, G, c;
    __host__ __device__ void init(int M, int N, int G_, int c_) { nM = M / BM; nN = N / BM; nwg = nM * nN; G = G_; c = c_; }
    __host__ __device__ bool next(int i, Unit& u) const {
        const long L = (long)i * G + c; if (L >= nwg) return false;
        int wgid = (int)L; { const int q = nwg / NXCD, r = nwg % NXCD, xcd = wgid % NXCD, off = wgid / NXCD; wgid = (xcd < r ? xcd * (q + 1) : r * (q + 1) + (xcd - r) * q) + off; }
        const int nig = WGM * nN, gid = wgid / nig, fm = gid * WGM, gsz = (nM - fm) < WGM ? (nM - fm) : WGM;
        u.pm = fm + ((wgid % nig) % gsz); u.pn = (wgid % nig) / gsz; return true;
    }
    __device__ __forceinline__ void a_ready(const Unit&) const {}
    __device__ __forceinline__ void done(const Unit&) const {}
};

__device__ __forceinline__ unsigned cvt_pk_bf16(float lo, float hi) { unsigned r; asm volatile("v_cvt_pk_bf16_f32 %0, %1, %2" : "=v"(r) : "v"(lo), "v"(hi)); return r; }
template <class Epi, class Sched, bool ALIGN_EPI = false, bool SP2 = false>
__device__ __forceinline__ void gemm_phase(PG8_LAS unsigned char* lds, const Gemm g, const Sched& S, const Epi& E) {
    int tid_l = threadIdx.x; asm volatile("" : "+v"(tid_l)); const int tid = tid_l, wid = __builtin_amdgcn_readfirstlane(tid >> 6), lane = tid & 63, wr = wid >> 2, wc = wid & 3, fr = lane & 15, fq = lane >> 4;
    const int K = g.K, nt = K / BK;
    unsigned voffA[2], voffB[2];
#pragma unroll
    for (int i = 0; i < 2; ++i) { int R, C; stage_rc(tid * 16 + i * 8192, R, C); const int Rb = Epi::PERM ? ((R & ~31) + perm32(R & 31)) : R;
        voffA[i] = (unsigned)(R * K + C) * 2u; voffB[i] = (unsigned)(Rb * K + C) * 2u; }
    const size_t kstep = (size_t)(BK * 2);
    const size_t hstep = (size_t)HALF * K * 2;
    const size_t tstep = 2 * hstep;
    const unsigned ldsw = (unsigned)wid * 1024u;
    const int aoff = lds_byte(wr * 64 + fr, fq * 8), boff = lds_byte(wc * 32 + fr, fq * 8);
#define PG8_SA(b, h) (((b) * 2 + (h)) * HTB)
#define PG8_SB(b, h) ((4 + (b) * 2 + (h)) * HTB)
#define PG8_STAGE(bufoff, gbase, voff) do { _Pragma("unroll") for (int _i = 0; _i < 2; ++_i) \
        __builtin_amdgcn_global_load_lds((const unsigned*)((const char*)(gbase) + (voff)[_i]), (PG8_LAS unsigned*)(lds + (bufoff) + ldsw + _i * 8192), 16, 0, 0); } while (0)
#define PG8_LDA(dst, b, h) do { _Pragma("unroll") for (int m = 0; m < 4; ++m) _Pragma("unroll") for (int k = 0; k < 2; ++k) dst[m][k] = *(const PG8_LAS bf16x8*)(lds + PG8_SA(b, h) + aoff + m * 2048 + k * 1024); } while (0)
#define PG8_LDB(dst, b, h) do { _Pragma("unroll") for (int n = 0; n < 2; ++n) _Pragma("unroll") for (int k = 0; k < 2; ++k) dst[n][k] = *(const PG8_LAS bf16x8*)(lds + PG8_SB(b, h) + boff + n * 2048 + k * 1024); } while (0)
#define PG8_MMA(ai, bj, At, Bt) do { __builtin_amdgcn_s_setprio(1); _Pragma("unroll") for (int m = 0; m < 4; ++m) _Pragma("unroll") for (int n = 0; n < 2; ++n) _Pragma("unroll") for (int k = 0; k < 2; ++k) \
        acc[ai][bj][m][n] = __builtin_amdgcn_mfma_f32_16x16x32_bf16(Bt[n][k], At[m][k], acc[ai][bj][m][n], 0, 0, 0); __builtin_amdgcn_s_setprio(0); } while (0)
#define PG8_WAIT_V(n) asm volatile("s_waitcnt vmcnt(" #n ")" ::: "memory")
#define PG8_WAIT_L(n) asm volatile("s_waitcnt lgkmcnt(" #n ")" ::: "memory")
#define PG8_BAR __builtin_amdgcn_s_barrier()
#define PG8_SCHED __builtin_amdgcn_sched_barrier(0)
    Unit cur, nxt; int ui = 0;
    if (!S.next(0, cur)) return;
    f32x4 acc[2][2][4][2];
#pragma unroll
    for (int a = 0; a < 2; ++a)
#pragma unroll
        for (int b = 0; b < 2; ++b)
#pragma unroll
            for (int m = 0; m < 4; ++m)
#pragma unroll
                for (int n = 0; n < 2; ++n) acc[a][b][m][n] = (f32x4){0.f, 0.f, 0.f, 0.f};
    bf16x8 At[4][2], B0[2][2], B1[2][2];
    const char* cA = (const char*)g.A + (size_t)cur.pm * tstep; const char* cB = (const char*)g.Bt + (size_t)cur.pn * tstep;
    S.a_ready(cur);
    if constexpr (SP2) {
        PG8_STAGE(PG8_SB(0, 0), cB, voffB); PG8_STAGE(PG8_SB(0, 1), cB + hstep, voffB); PG8_STAGE(PG8_SA(0, 0), cA, voffA); PG8_STAGE(PG8_SA(0, 1), cA + hstep, voffA);
        if (wr == 1) PG8_BAR;
        PG8_WAIT_V(2); PG8_BAR;
        PG8_STAGE(PG8_SB(1, 0), cB + kstep, voffB); PG8_STAGE(PG8_SA(1, 0), cA + kstep, voffA); PG8_STAGE(PG8_SB(1, 1), cB + hstep + kstep, voffB);
        PG8_WAIT_V(6); PG8_BAR;
    } else {
        PG8_STAGE(PG8_SB(0, 0), cB, voffB); PG8_STAGE(PG8_SA(0, 0), cA, voffA); PG8_STAGE(PG8_SB(0, 1), cB + hstep, voffB); PG8_STAGE(PG8_SA(0, 1), cA + hstep, voffA);
        if (wr == 1) PG8_BAR;
        PG8_WAIT_V(4); PG8_BAR;
        PG8_STAGE(PG8_SB(1, 0), cB + kstep, voffB); PG8_STAGE(PG8_SA(1, 0), cA + kstep, voffA); PG8_STAGE(PG8_SB(1, 1), cB + hstep + kstep, voffB);
        PG8_WAIT_V(6); PG8_BAR;
    }
    for (;;) {
        const bool has_next = S.next(ui + 1, nxt);
        const char* nA = has_next ? (const char*)g.A + (size_t)nxt.pm * tstep : cA; const char* nB = has_next ? (const char*)g.Bt + (size_t)nxt.pn * tstep : cB;
        for (int t = 0; t < nt; t += 2) {
            const bool last = (t == nt - 2);
            const char* a1 = cA + (size_t)(t + 1) * kstep;
            const char* a2 = last ? nA : cA + (size_t)(t + 2) * kstep; const char* b2 = last ? nB : cB + (size_t)(t + 2) * kstep;
            const char* a3 = a2 + kstep; const char* b3 = b2 + kstep;
            if (last && has_next) S.a_ready(nxt);
            if constexpr (SP2) {
            PG8_LDB(B0, 0, 0); PG8_LDB(B1, 0, 1); PG8_SCHED; PG8_LDA(At, 0, 0); PG8_STAGE(PG8_SA(1, 1), a1 + hstep, voffA);
            PG8_WAIT_V(8); PG8_WAIT_L(0); PG8_BAR; PG8_MMA(0, 0, At, B0); PG8_MMA(0, 1, At, B1); PG8_BAR; PG8_SCHED;
            PG8_LDA(At, 0, 1); PG8_STAGE(PG8_SB(0, 0), b2, voffB); PG8_STAGE(PG8_SB(0, 1), b2 + hstep, voffB); PG8_STAGE(PG8_SA(0, 0), a2, voffA);
            PG8_WAIT_V(8); PG8_WAIT_L(0); PG8_BAR; PG8_MMA(1, 0, At, B0); PG8_MMA(1, 1, At, B1); PG8_BAR; PG8_SCHED;
            PG8_LDB(B0, 1, 0); PG8_LDB(B1, 1, 1); PG8_SCHED; PG8_LDA(At, 1, 0); PG8_STAGE(PG8_SA(0, 1), a2 + hstep, voffA);
            PG8_WAIT_V(8); PG8_WAIT_L(0); PG8_BAR; PG8_MMA(0, 0, At, B0); PG8_MMA(0, 1, At, B1); PG8_BAR; PG8_SCHED;
            PG8_LDA(At, 1, 1); PG8_STAGE(PG8_SB(1, 0), b3, voffB); PG8_STAGE(PG8_SB(1, 1), b3 + hstep, voffB); PG8_STAGE(PG8_SA(1, 0), a3, voffA);
            PG8_WAIT_V(8); PG8_WAIT_L(0); PG8_BAR; PG8_MMA(1, 0, At, B0); PG8_MMA(1, 1, At, B1); PG8_BAR; PG8_SCHED;
            } else {
            PG8_LDB(B0, 0, 0); PG8_SCHED; PG8_LDA(At, 0, 0); PG8_STAGE(PG8_SA(1, 1), a1 + hstep, voffA);
            PG8_WAIT_L(8); PG8_BAR; PG8_WAIT_L(0); PG8_MMA(0, 0, At, B0); PG8_BAR; PG8_SCHED;
            PG8_LDB(B1, 0, 1); PG8_STAGE(PG8_SB(0, 0), b2, voffB);
            PG8_BAR; PG8_WAIT_L(0); PG8_MMA(0, 1, At, B1); PG8_BAR;
            PG8_LDA(At, 0, 1); PG8_STAGE(PG8_SA(0, 0), a2, voffA);
            PG8_BAR; PG8_WAIT_L(0); PG8_MMA(1, 0, At, B0); PG8_BAR; PG8_SCHED;
            PG8_STAGE(PG8_SB(0, 1), b2 + hstep, voffB);
            PG8_WAIT_V(6); PG8_BAR; PG8_MMA(1, 1, At, B1); PG8_BAR;
            PG8_LDB(B0, 1, 0); PG8_SCHED; PG8_LDA(At, 1, 0); PG8_STAGE(PG8_SA(0, 1), a2 + hstep, voffA);
            PG8_WAIT_L(8); PG8_BAR; PG8_WAIT_L(0); PG8_MMA(0, 0, At, B0); PG8_BAR; PG8_SCHED;
            PG8_LDB(B1, 1, 1); PG8_STAGE(PG8_SB(1, 0), b3, voffB);
            PG8_BAR; PG8_WAIT_L(0); PG8_MMA(0, 1, At, B1); PG8_BAR;
            PG8_LDA(At, 1, 1); PG8_STAGE(PG8_SA(1, 0), a3, voffA);
            PG8_BAR; PG8_WAIT_L(0); PG8_MMA(1, 0, At, B0); PG8_BAR; PG8_SCHED;
            PG8_STAGE(PG8_SB(1, 1), b3 + hstep, voffB);
            PG8_WAIT_V(6); PG8_BAR; PG8_MMA(1, 1, At, B1); PG8_BAR;
            }
        }
        if constexpr (ALIGN_EPI) { if (wr == 0) PG8_BAR; }
        if constexpr (!Epi::AFTER_DRAIN) { E(acc, cur, wr, wc, fr, fq); S.done(cur); }
        if (!has_next) break;
#pragma unroll
        for (int a = 0; a < 2; ++a)
#pragma unroll
            for (int b = 0; b < 2; ++b)
#pragma unroll
                for (int m = 0; m < 4; ++m)
#pragma unroll
                    for (int n = 0; n < 2; ++n) acc[a][b][m][n] = (f32x4){0.f, 0.f, 0.f, 0.f};
        cur = nxt; cA = nA; cB = nB; ++ui;
        if constexpr (ALIGN_EPI) { if (wr == 1) PG8_BAR; }
    }
    PG8_WAIT_V(0);
    if constexpr (!ALIGN_EPI) { if (wr == 0) PG8_BAR; }
    PG8_BAR;
    if constexpr (Epi::AFTER_DRAIN) { E.fused(acc, cur, wr, wc, fr, fq, lds, wid, lane); S.done(cur); }
#undef PG8_SA
#undef PG8_SB
#undef PG8_STAGE
#undef PG8_LDA
#undef PG8_LDB
#undef PG8_MMA
#undef PG8_WAIT_V
#undef PG8_WAIT_L
#undef PG8_BAR
#undef PG8_SCHED
}
}

#define LAS __attribute__((address_space(3)))
typedef unsigned short u16;
typedef unsigned char uchar;
typedef short bf16x8 __attribute__((ext_vector_type(8)));
typedef short s16x4 __attribute__((ext_vector_type(4)));
typedef float f32x4 __attribute__((ext_vector_type(4)));
typedef unsigned u32x4 __attribute__((ext_vector_type(4)));
typedef unsigned u32x2 __attribute__((ext_vector_type(2)));

constexpr int D = 1024, SEQ = 16384, CTXL = 256, DFF = 2816, DPROJ = 2848, NPROJ = 3072;
constexpr int MX = 2 * SEQ, MC = 2 * CTXL, MT = MX + MC;
constexpr int NKEY = CTXL + SEQ, NCH = NKEY / 64;
constexpr int C_GQ = 0, C_GK = 128, C_GV = 256, C_GG = 512, C_AF = 768, C_NQ = 800, C_NK = 1056, C_NV = 1312, C_DQ = 1568, C_DK = 1824, C_DV = 2080, C_CA = 2336, C_CG = 2592;
constexpr float LOG2E = 1.4426950408889634f;

constexpr size_t MiB = 1u << 20;
constexpr size_t WS_CTL = 0, WS_MOD = 1 * MiB, WS_MISC = 1 * MiB + 512 * 1024, WS_HC = 2 * MiB, WS_PWT = 4 * MiB, WS_W13 = 8 * MiB, WS_W2 = 52 * MiB, WS_WIN = 74 * MiB,
                 WS_WOUT = 86 * MiB, WS_A = 90 * MiB, WS_X = 155 * MiB, WS_VTD = 336 * MiB, WS_VTN = 353 * MiB, WS_U = 370 * MiB, WS_DEC = 403 * MiB, WS_BC = 404 * MiB, WS_END = 437 * MiB;
constexpr int LDS_BYTES = 131072 + 256;
constexpr int NPHASE = 26;

struct Args { const float* in[33]; float* out; unsigned char* ws; int ph_lo, ph_hi; };

enum { I_X = 0, I_C, I_CTX, I_CCTX, I_ADAW, I_ADAB, I_NF1, I_F1W13, I_F1W2, I_NMIX, I_WIN, I_WAF, I_BAF, I_WAB, I_BAB, I_GNORM, I_RPB, I_LQ1, I_LK1, I_LQ2, I_LK2, I_DNORM,
       I_CDW, I_CDWB, I_CLNG, I_CLNB, I_CPW, I_CPWB, I_WOUT, I_NF2, I_F2W13, I_F2W2, I_FNORM };

__device__ __forceinline__ float bf2f(unsigned short h) { return __uint_as_float(((unsigned)h) << 16); }
__device__ __forceinline__ unsigned short f2bf(float f) { unsigned u = __float_as_uint(f); return (unsigned short)((u + 0x7fffu + ((u >> 16) & 1u)) >> 16); }
__device__ __forceinline__ unsigned pk2(float lo, float hi) { return (unsigned)f2bf(lo) | ((unsigned)f2bf(hi) << 16); }
__device__ __forceinline__ float wave_sum(float v) {
#pragma unroll
    for (int o = 1; o < 64; o <<= 1) v += __shfl_xor(v, o);
    return v;
}
__device__ __forceinline__ float silu_f(float x) { return x * __builtin_amdgcn_rcpf(1.0f + __expf(-x)); }
#define WAVE_SYNC() do { asm volatile("s_waitcnt lgkmcnt(0)" ::: "memory"); __builtin_amdgcn_wave_barrier(); } while (0)
__device__ __forceinline__ int row_of(int b, int c, int tk) { return (c < 4) ? (MX + b * CTXL + c * 64 + tk) : (b * SEQ + (c - 4) * 64 + tk); }
__device__ __forceinline__ float* hrow(const Args& a, int row) { return (row < MX) ? (a.out + (size_t)row * D) : ((float*)(a.ws + WS_HC) + (size_t)(row - MX) * D); }
__device__ __forceinline__ const float* modp(const Args& a, int layer, int g, int j) { return (const float*)(a.ws + WS_MOD) + ((size_t)(layer * 3 + g) * 9 + j) * D; }

struct EpiSwiglu {
    static constexpr bool PERM = true, AFTER_DRAIN = false;
    u16* O;
    __device__ __forceinline__ void operator()(const f32x4 (&acc)[2][2][4][2], const pg8::Unit& u, int wr, int wc, int fr, int fq) const {
        const int row0 = u.pm * 256 + wr * 64 + fr, col0 = u.pn * 128 + wc * 32 + 8 * fq;
#pragma unroll
        for (int ai = 0; ai < 2; ++ai)
#pragma unroll
            for (int m = 0; m < 4; ++m) {
                u16* rowp = O + (size_t)(row0 + ai * 128 + m * 16) * DFF + col0;
                const f32x4 a0 = acc[ai][0][m][0], a1 = acc[ai][0][m][1], u0 = acc[ai][1][m][0], u1 = acc[ai][1][m][1];
                float h[8];
#pragma unroll
                for (int e = 0; e < 4; ++e) { h[e] = silu_f(a0[e]) * u0[e]; h[4 + e] = silu_f(a1[e]) * u1[e]; }
                u32x4 w; w.x = pg8::cvt_pk_bf16(h[0], h[1]); w.y = pg8::cvt_pk_bf16(h[2], h[3]); w.z = pg8::cvt_pk_bf16(h[4], h[5]); w.w = pg8::cvt_pk_bf16(h[6], h[7]);
                *(u32x4*)rowp = w;
            }
    }
};
struct EpiResid {
    static constexpr bool PERM = false, AFTER_DRAIN = false;
    float* hx; float* hc; const float* sx; const float* sc; const float* gate0;
    float coef;
    __device__ __forceinline__ void operator()(const f32x4 (&acc)[2][2][4][2], const pg8::Unit& u, int wr, int wc, int fr, int fq) const {
        const int g = u.pm < 64 ? 0 : (u.pm < 128 ? 1 : 2);
        float* base = (u.pm < 128) ? (hx + (size_t)u.pm * 256 * D) : (hc + (size_t)(u.pm - 128) * 256 * D);
        const float* sbase = (u.pm < 128) ? (sx + (size_t)u.pm * 256 * D) : (sc + (size_t)(u.pm - 128) * 256 * D);
        const int row0 = wr * 64 + fr, col0 = u.pn * 256 + wc * 32 + 4 * fq;
        const float* gate = gate0 + (size_t)g * 9 * D;
        f32x4 gv[2][2];
#pragma unroll
        for (int bj = 0; bj < 2; ++bj)
#pragma unroll
            for (int n = 0; n < 2; ++n) gv[bj][n] = *(const f32x4*)(gate + col0 + bj * 128 + n * 16) * coef;
#pragma unroll
        for (int ai = 0; ai < 2; ++ai)
#pragma unroll
            for (int m = 0; m < 4; ++m) {
                float* rowp = base + (size_t)(row0 + ai * 128 + m * 16) * D + col0; const float* srcp = sbase + (size_t)(row0 + ai * 128 + m * 16) * D + col0;
#pragma unroll
                for (int bj = 0; bj < 2; ++bj)
#pragma unroll
                    for (int n = 0; n < 2; ++n) { const int off = bj * 128 + n * 16; *(f32x4*)(rowp + off) = *(const f32x4*)(srcp + off) + gv[bj][n] * acc[ai][bj][m][n]; }
            }
    }
};
struct EpiProj {
    static constexpr bool PERM = true, AFTER_DRAIN = false;
    u16* O;
    __device__ __forceinline__ void operator()(const f32x4 (&acc)[2][2][4][2], const pg8::Unit& u, int wr, int wc, int fr, int fq) const {
        const int row0 = u.pm * 256 + wr * 64 + fr, col0 = u.pn * 256 + wc * 32 + 8 * fq;
#pragma unroll
        for (int ai = 0; ai < 2; ++ai)
#pragma unroll
            for (int m = 0; m < 4; ++m) {
                u16* rowp = O + (size_t)(row0 + ai * 128 + m * 16) * DPROJ;
#pragma unroll
                for (int bj = 0; bj < 2; ++bj) {
                    const int col = col0 + bj * 128;
                    if (col < DPROJ) {
                        const f32x4 v0 = acc[ai][bj][m][0], v1 = acc[ai][bj][m][1];
                        u32x4 w; w.x = pg8::cvt_pk_bf16(v0[0], v0[1]); w.y = pg8::cvt_pk_bf16(v0[2], v0[3]); w.z = pg8::cvt_pk_bf16(v1[0], v1[1]); w.w = pg8::cvt_pk_bf16(v1[2], v1[3]);
                        *(u32x4*)(rowp + col) = w;
                    }
                }
            }
    }
};

__device__ __forceinline__ void transpose_item(const float* W, int N, u16* WT, int K, int k0, int n0, int drow0, float* scr, int lane) {
    float wv[32];
#pragma unroll
    for (int i = 0; i < 32; ++i) { const int kk = 2 * i + (lane >> 5); wv[i] = W[(size_t)(k0 + kk) * N + n0 + (lane & 31)]; }
#pragma unroll
    for (int i = 0; i < 32; ++i) { const int kk = 2 * i + (lane >> 5); scr[kk * 33 + (lane & 31)] = wv[i]; }
    WAVE_SYNC();
    const int c = lane & 7;
#pragma unroll
    for (int j = 0; j < 4; ++j) {
        const int n = (lane >> 3) + 8 * j; const float* s = scr + (8 * c) * 33 + n;
        u32x4 o; o.x = pk2(s[0 * 33], s[1 * 33]); o.y = pk2(s[2 * 33], s[3 * 33]); o.z = pk2(s[4 * 33], s[5 * 33]); o.w = pk2(s[6 * 33], s[7 * 33]);
        *(u32x4*)(WT + (size_t)(drow0 + n) * K + k0 + 8 * c) = o;
    }
    WAVE_SYNC();
}

__device__ __forceinline__ void phase_prep(const Args& a, uchar* lds) {
    int tid = threadIdx.x; asm volatile("" : "+v"(tid)); const int lane = tid & 63, wave = tid >> 6, G = gridDim.x, bid = blockIdx.x;
    {
        float* sc = (float*)lds;
        float* red = sc + 3 * D;
        float* mod = (float*)(a.ws + WS_MOD);
        for (int i = tid; i < 3 * D; i += 512) { const int g = i >> 10, k = i & 1023; const float v = (g < 2) ? a.in[I_C][g * D + k] : a.in[I_CCTX][k]; sc[i] = silu_f(v); }
        __syncthreads();
        for (int u = bid; u < 2 * 144; u += G) {
            const int l = u / 144, cgp = u % 144, kc = tid >> 6, col = tid & 63;
            const float* w = a.in[I_ADAW] + ((size_t)l * D + kc * 128) * 9216 + cgp * 64 + col;
            float a0 = 0.f, a1 = 0.f, a2 = 0.f;
#pragma unroll 32
            for (int kk = 0; kk < 128; ++kk) { const float wv = w[(size_t)kk * 9216]; const int k = kc * 128 + kk; a0 += sc[k] * wv; a1 += sc[D + k] * wv; a2 += sc[2 * D + k] * wv; }
            red[(kc * 3 + 0) * 64 + col] = a0; red[(kc * 3 + 1) * 64 + col] = a1; red[(kc * 3 + 2) * 64 + col] = a2;
            __syncthreads();
            if (tid < 192) {
                const int g = tid >> 6, cc = tid & 63; float s = a.in[I_ADAB][l * 9216 + cgp * 64 + cc];
#pragma unroll
                for (int k8 = 0; k8 < 8; ++k8) s += red[(k8 * 3 + g) * 64 + cc];
                mod[(size_t)(l * 3 + g) * 9216 + cgp * 64 + cc] = s;
            }
            __syncthreads();
        }
        __syncthreads();
    }
    if (bid == 0) {
        float* tr = (float*)(a.ws + WS_MISC);
        for (int i = tid; i < 2560; i += 512) {
            const int j = i & 7; const int pos = (i < 2048) ? (i >> 3) : ((i - 2048) >> 3);
            const double inv = ((j & 1) ? 0.31622776601683794 : 1.0) * ((j >> 1) == 0 ? 1.0 : ((j >> 1) == 1 ? 0.1 : ((j >> 1) == 2 ? 0.01 : 0.001))), ang = (double)pos * inv;
            float* dst = (i < 2048) ? (tr + (size_t)i * 2) : (tr + 4096 + (size_t)(i - 2048) * 2);
            dst[0] = (float)cos(ang); dst[1] = (float)sin(ang);
        }
    }
    if (bid == (1 % G) && wave < 2) {
        const float* rpb = a.in[I_RPB] + wave * 4 * 15 * 31; float m = 0.f;
        for (int i = lane; i < 4 * 15 * 31; i += 64) m = fmaxf(m, fabsf(rpb[i]));
#pragma unroll
        for (int o = 1; o < 64; o <<= 1) m = fmaxf(m, __shfl_xor(m, o));
        if (lane == 0) ((float*)(a.ws + WS_MISC))[8192 + wave] = m;
    }
    {
        const size_t gt = (size_t)bid * 512 + tid, GT = (size_t)G * 512;
        for (int l = 0; l < 2; ++l) { u32x4* z = (u32x4*)((u16*)(a.ws + WS_WIN) + ((size_t)l * NPROJ + DPROJ) * D);
            for (size_t i = gt; i < (size_t)(NPROJ - DPROJ) * D / 8; i += GT) z[i] = (u32x4){0u, 0u, 0u, 0u}; }
    }
    {
        float* scr = (float*)lds + wave * (64 * 33);
        const int gw = bid * 8 + wave, NGW = G * 8;
        constexpr int I13 = 16 * 176, I2 = 44 * 32, IIN = 16 * 89, IOUT = 16 * 32, IPW = 4 * 8;
        constexpr int NIT = 4 * I13 + 4 * I2 + 2 * IIN + 2 * IOUT + 2 * IPW;
        for (int it = gw; it < NIT; it += NGW) {
            int r = it;
            if (r < 4 * I13) { const int mi = r / I13; r -= mi * I13; const int l = mi >> 1, f = mi & 1, kb = r / 176, nb = r % 176, n0 = nb * 32;
                const int j = (n0 < DFF) ? n0 : n0 - DFF; const int drow0 = 256 * (j >> 7) + (j & 127) + ((n0 < DFF) ? 0 : 128);
                transpose_item(a.in[f ? I_F2W13 : I_F1W13] + (size_t)l * D * 2 * DFF, 2 * DFF, (u16*)(a.ws + WS_W13) + (size_t)mi * 2 * DFF * D, D, kb * 64, n0, drow0, scr, lane); continue; }
            r -= 4 * I13;
            if (r < 4 * I2) { const int mi = r / I2; r -= mi * I2; const int l = mi >> 1, f = mi & 1, kb = r / 32, nb = r % 32;
                transpose_item(a.in[f ? I_F2W2 : I_F1W2] + (size_t)l * DFF * D, D, (u16*)(a.ws + WS_W2) + (size_t)mi * D * DFF, DFF, kb * 64, nb * 32, nb * 32, scr, lane); continue; }
            r -= 4 * I2;
            if (r < 2 * IIN) { const int l = r / IIN; r -= l * IIN; const int kb = r / 89, nb = r % 89;
                transpose_item(a.in[I_WIN] + (size_t)l * D * DPROJ, DPROJ, (u16*)(a.ws + WS_WIN) + (size_t)l * NPROJ * D, D, kb * 64, nb * 32, nb * 32, scr, lane); continue; }
            r -= 2 * IIN;
            if (r < 2 * IOUT) { const int l = r / IOUT; r -= l * IOUT; const int kb = r / 32, nb = r % 32;
                transpose_item(a.in[I_WOUT] + (size_t)l * D * D, D, (u16*)(a.ws + WS_WOUT) + (size_t)l * D * D, D, kb * 64, nb * 32, nb * 32, scr, lane); continue; }
            r -= 2 * IOUT;
            { const int l = r / IPW; r -= l * IPW; const int kb = r / 8, nb = r % 8;
                transpose_item(a.in[I_CPW] + (size_t)l * 256 * 256, 256, (u16*)(a.ws + WS_PWT) + (size_t)l * 256 * 256, 256, kb * 64, nb * 32, nb * 32, scr, lane); }
        }
    }
}

__device__ __forceinline__ void phase_norm(const Args& a, int layer, int which, int M, bool first) {
    int tid = threadIdx.x; asm volatile("" : "+v"(tid)); const int lane = tid & 63, wave = tid >> 6;
    const float* nw = a.in[which == 0 ? I_NF1 : (which == 1 ? I_NMIX : I_NF2)] + (size_t)layer * D;
    u16* A = (u16*)(a.ws + WS_A);
    constexpr int R = 4;
    for (int row0 = (blockIdx.x * 8 + wave) * R; row0 < M; row0 += gridDim.x * 8 * R) {
        const int g = row0 < SEQ ? 0 : (row0 < MX ? 1 : 2);
        const float* sh = modp(a, layer, g, 3 * which), * scl = modp(a, layer, g, 3 * which + 1);
        f32x4 v[R][4];
#pragma unroll
        for (int q = 0; q < R; ++q) { const int row = row0 + q;
            const float* src = first ? ((row < MX) ? a.in[I_X] + (size_t)row * D : a.in[I_CTX] + (size_t)(row - MX) * D) : hrow(a, row);
#pragma unroll
            for (int j = 0; j < 4; ++j) v[q][j] = ((const f32x4*)src)[lane + 64 * j]; }
        f32x4 c4[4], b4[4];
#pragma unroll
        for (int j = 0; j < 4; ++j) { c4[j] = ((const f32x4*)nw)[lane + 64 * j] * (((const f32x4*)scl)[lane + 64 * j] + 1.0f); b4[j] = ((const f32x4*)sh)[lane + 64 * j]; }
#pragma unroll
        for (int q = 0; q < R; ++q) {
            float ss = 0.f;
#pragma unroll
            for (int j = 0; j < 4; ++j) ss += (v[q][j].x * v[q][j].x + v[q][j].y * v[q][j].y) + (v[q][j].z * v[q][j].z + v[q][j].w * v[q][j].w);
            const float rstd = rsqrtf(wave_sum(ss) * (1.0f / D) + 1e-6f);
            u32x2* o = (u32x2*)(A + (size_t)(row0 + q) * D);
#pragma unroll
            for (int j = 0; j < 4; ++j) { const f32x4 y = (v[q][j] * rstd) * c4[j] + b4[j]; u32x2 p; p.x = pk2(y.x, y.y); p.y = pk2(y.z, y.w); o[lane + 64 * j] = p; }
        }
    }
}
__device__ __forceinline__ void phase_final(const Args& a) {
    int tid = threadIdx.x; asm volatile("" : "+v"(tid)); const int lane = tid & 63, wave = tid >> 6;
    const float* nw = a.in[I_FNORM];
    constexpr int R = 4;
    for (int row0 = (blockIdx.x * 8 + wave) * R; row0 < MX; row0 += gridDim.x * 8 * R) {
        f32x4 v[R][4];
#pragma unroll
        for (int q = 0; q < R; ++q)
#pragma unroll
            for (int j = 0; j < 4; ++j) v[q][j] = ((const f32x4*)(a.out + (size_t)(row0 + q) * D))[lane + 64 * j];
#pragma unroll
        for (int q = 0; q < R; ++q) {
            float ss = 0.f;
#pragma unroll
            for (int j = 0; j < 4; ++j) ss += (v[q][j].x * v[q][j].x + v[q][j].y * v[q][j].y) + (v[q][j].z * v[q][j].z + v[q][j].w * v[q][j].w);
            const float rstd = rsqrtf(wave_sum(ss) * (1.0f / D) + 1e-6f);
            f32x4* p = (f32x4*)(a.out + (size_t)(row0 + q) * D);
#pragma unroll
            for (int j = 0; j < 4; ++j) p[lane + 64 * j] = (v[q][j] * rstd) * ((const f32x4*)nw)[lane + 64 * j];
        }
    }
}

__device__ __forceinline__ void prep_unit(const Args& a, int layer, int unit, uchar* lds) {
    int tid = threadIdx.x; asm volatile("" : "+v"(tid)); const int b = unit / NCH, c = unit % NCH;
    u16* P = (u16*)(a.ws + WS_X);
    unsigned* ctl = (unsigned*)(a.ws + WS_CTL) + layer * 64;
    unsigned* lmax = (unsigned*)lds;
    u16* T = (u16*)(lds + 256);
    if (tid < 12) lmax[tid] = 0u;
    __syncthreads();
    const float* tr = (const float*)(a.ws + WS_MISC);
    {
        const int tk = tid >> 3, row = row_of(b, c, tk);
        const int t = (c - 4) * 64 + tk, gr = t >> 6, gc = t & 63;
        bf16x8 raw2[2][4];
#pragma unroll
        for (int e = 0; e < 2; ++e) {
            const int id = (tid & 7) * 2 + e, isk = id >> 3, h = (id >> 1) & 3, s = id & 1;
            const u16* p = P + (size_t)row * DPROJ + C_DQ + isk * 256 + h * 64 + s * 32;
#pragma unroll
            for (int q = 0; q < 4; ++q) raw2[e][q] = ((const bf16x8*)p)[q];
        }
#pragma unroll
        for (int e = 0; e < 2; ++e) {
            const int id = (tid & 7) * 2 + e, isk = id >> 3, h = (id >> 1) & 3, s = id & 1;
            u16* p = P + (size_t)row * DPROJ + C_DQ + isk * 256 + h * 64 + s * 32;
            bf16x8 raw[4];
#pragma unroll
            for (int q = 0; q < 4; ++q) raw[q] = raw2[e][q];
            float x[32];
#pragma unroll
            for (int q = 0; q < 4; ++q)
#pragma unroll
                for (int i = 0; i < 8; ++i) x[q * 8 + i] = bf2f((u16)raw[q][i]);
            if (c >= 4) {
#pragma unroll
                for (int j = 0; j < 8; ++j) {
                    const float cr = tr[(gr * 8 + j) * 2], sr = tr[(gr * 8 + j) * 2 + 1], cc = tr[4096 + (gc * 8 + j) * 2], sc = tr[4096 + (gc * 8 + j) * 2 + 1];
                    const float x0 = x[j], x1 = x[j + 8], y0 = x[16 + j], y1 = x[24 + j];
                    x[j] = x0 * cr - x1 * sr; x[j + 8] = x1 * cr + x0 * sr;
                    x[16 + j] = y0 * cc - y1 * sc; x[24 + j] = y1 * cc + y0 * sc;
                }
                u32x4 o[4];
#pragma unroll
                for (int q = 0; q < 4; ++q) { o[q].x = pk2(x[q * 8], x[q * 8 + 1]); o[q].y = pk2(x[q * 8 + 2], x[q * 8 + 3]); o[q].z = pk2(x[q * 8 + 4], x[q * 8 + 5]); o[q].w = pk2(x[q * 8 + 6], x[q * 8 + 7]); }
#pragma unroll
                for (int q = 0; q < 4; ++q) ((u32x4*)p)[q] = o[q];
            }
            if (isk) {
                float n2 = 0.f;
#pragma unroll
                for (int i = 0; i < 32; ++i) { const float r = bf2f(f2bf(x[i])); n2 += r * r; }
                atomicMax(&lmax[h * 2 + s], __float_as_uint(n2));
            }
        }
    }
    {
        const int tk = tid >> 3, h = (tid & 7) >> 1, hf = tid & 1, row = row_of(b, c, tk);
        const u16* p = P + (size_t)row * DPROJ + C_NK + h * 64 + hf * 32;
        float n2 = 0.f;
#pragma unroll
        for (int q = 0; q < 4; ++q) { const bf16x8 r = ((const bf16x8*)p)[q];
#pragma unroll
            for (int i = 0; i < 8; ++i) { const float f = bf2f((u16)r[i]); n2 += f * f; } }
        n2 += __shfl_xor(n2, 1);
        if (hf == 0) atomicMax(&lmax[8 + h], __float_as_uint(n2));
    }
#pragma unroll 1
    for (int wh = 0; wh < 2; ++wh) {
        const int ccol = wh ? C_NV : C_DV;
        u16* VT = (u16*)(a.ws + (wh ? WS_VTN : WS_VTD));
        __syncthreads();
        for (int i = tid; i < 64 * 32; i += 512) { const int tk = i >> 5, pc = i & 31;
            *(bf16x8*)(T + tk * 264 + pc * 8) = *(const bf16x8*)(P + (size_t)row_of(b, c, tk) * DPROJ + ccol + pc * 8); }
        __syncthreads();
        {
            const int r = tid >> 1, hf = tid & 1, h = r >> 6, dv = r & 63;
            u16* dst = VT + ((size_t)(b * 4 + h) * 64 + dv) * NKEY + c * 64 + hf * 32;
#pragma unroll
            for (int q = 0; q < 4; ++q) {
                u32x4 o; unsigned w[4];
#pragma unroll
                for (int i = 0; i < 4; ++i) { const int t0 = hf * 32 + q * 8 + i * 2; w[i] = (unsigned)T[t0 * 264 + r] | ((unsigned)T[(t0 + 1) * 264 + r] << 16); }
                o.x = w[0]; o.y = w[1]; o.z = w[2]; o.w = w[3];
                ((u32x4*)dst)[q] = o;
            }
        }
    }
    __syncthreads();
    if (tid < 8) atomicMax(&ctl[(b * 4 + (tid >> 1)) * 2 + (tid & 1)], lmax[tid]);
    else if (tid < 12) atomicMax(&ctl[16 + b * 4 + (tid - 8)], lmax[tid]);
    __syncthreads();
}

template <int dir> __device__ __forceinline__ void gla_bcum(const Args& a, int layer, const bf16x8 r0, const bf16x8 r1, int h, int lane, float (&bc)[32]) {
    const float* wa = a.in[dir ? I_WAB : I_WAF] + (size_t)layer * 16 * 128 + h * 32;
    const float* ba = a.in[dir ? I_BAB : I_BAF] + (size_t)layer * 128 + h * 32;
    float av[16];
#pragma unroll
    for (int i = 0; i < 8; ++i) { av[i] = bf2f((u16)r0[i]); av[8 + i] = bf2f((u16)r1[i]); }
#pragma unroll
    for (int d = 0; d < 32; ++d) {
        float z = ba[d];
#pragma unroll
        for (int r = 0; r < 16; ++r) z += av[r] * wa[r * 128 + d];
        const float ls = fminf(z, 0.f) - __logf(1.0f + __expf(-fabsf(z)));
        bc[d] = ls * (1.0f / 16.0f);
        if ((d & 3) == 3) __builtin_amdgcn_sched_barrier(0);
    }
#pragma unroll
    for (int off = 1; off < 64; off <<= 1) {
#pragma unroll
        for (int d = 0; d < 32; ++d) {
            if (dir == 0) { const float t = __shfl_up(bc[d], off); if (lane >= off) bc[d] += t; }
            else { const float t = __shfl_down(bc[d], off); if (lane + off < 64) bc[d] += t; }
        }
    }
}
__device__ __forceinline__ int gla_scan_idx(int dir, int c) { return dir == 0 ? c : ((c < 4) ? 3 - c : 263 - c); }

template <int dir> __device__ __forceinline__ void gla_g1_wave(const Args& a, int layer, int b, int c, int h, uchar* wlds, int lane) {
    asm volatile("" : "+v"(lane));
    const int fr = lane & 15, fq = lane >> 4;
    const u16* P = (const u16*)(a.ws + WS_X);
    const u16* prow = P + (size_t)row_of(b, c, lane) * DPROJ;
    u16* VT = (u16*)wlds;
    u16* KT = (u16*)(wlds + 8192);
    float* U = (float*)(a.ws + WS_U); float* DEC = (float*)(a.ws + WS_DEC);
    bf16x8 kr[4];
    const bf16x8 ar0 = *(const bf16x8*)(prow + C_AF + dir * 16), ar1 = *(const bf16x8*)(prow + C_AF + dir * 16 + 8);
    {
        bf16x8 vr[8];
#pragma unroll
        for (int q = 0; q < 8; ++q) vr[q] = ((const bf16x8*)(prow + C_GV + h * 64))[q];
#pragma unroll
        for (int q = 0; q < 4; ++q) kr[q] = ((const bf16x8*)(prow + C_GK + h * 32))[q];
#pragma unroll
        for (int q = 0; q < 8; ++q)
#pragma unroll
            for (int i = 0; i < 8; ++i) VT[(q * 8 + i) * 64 + lane] = (u16)vr[q][i];
    }
    float bc[32];
    gla_bcum<dir>(a, layer, ar0, ar1, h, lane, bc);
    const int n = gla_scan_idx(dir, c);
    const size_t sidx = ((size_t)((b * 2 + dir) * 4 + h) * NCH + n);
    {
        f32x4* bcp = (f32x4*)((float*)(a.ws + WS_BC) + ((((size_t)((b * 2 + dir) * 4 + h) * NCH + c) * 64 + lane) * 32));
#pragma unroll
        for (int q = 0; q < 8; ++q) bcp[q] = (f32x4){bc[q * 4], bc[q * 4 + 1], bc[q * 4 + 2], bc[q * 4 + 3]};
    }
    {
#pragma unroll
        for (int d = 0; d < 32; ++d) { const float bl = __shfl(bc[d], dir ? 0 : 63); KT[d * 64 + lane] = f2bf(bf2f((u16)kr[d >> 3][d & 7]) * __expf(bl - bc[d])); }
    }
    if (lane == (dir ? 0 : 63)) {
#pragma unroll
        for (int q = 0; q < 8; ++q) { f32x4 o;
#pragma unroll
            for (int e = 0; e < 4; ++e) o[e] = __expf(bc[q * 4 + e]);
            ((f32x4*)(DEC + sidx * 32))[q] = o; }
    }
    WAVE_SYNC();
    f32x4 acc[4][2];
#pragma unroll
    for (int dvb = 0; dvb < 4; ++dvb)
#pragma unroll
        for (int db = 0; db < 2; ++db) acc[dvb][db] = (f32x4){0.f, 0.f, 0.f, 0.f};
#pragma unroll
    for (int ks = 0; ks < 2; ++ks) {
        bf16x8 kf[2];
#pragma unroll
        for (int db = 0; db < 2; ++db) kf[db] = *(const bf16x8*)(KT + (db * 16 + fr) * 64 + ks * 32 + fq * 8);
#pragma unroll
        for (int dvb = 0; dvb < 4; ++dvb) {
            const bf16x8 vf = *(const bf16x8*)(VT + (dvb * 16 + fr) * 64 + ks * 32 + fq * 8);
#pragma unroll
            for (int db = 0; db < 2; ++db) acc[dvb][db] = __builtin_amdgcn_mfma_f32_16x16x32_bf16(vf, kf[db], acc[dvb][db], 0, 0, 0);
        }
    }
    float* ub = U + sidx * 2048;
#pragma unroll
    for (int dvb = 0; dvb < 4; ++dvb)
#pragma unroll
        for (int db = 0; db < 2; ++db) *(f32x4*)(ub + (db * 16 + fr) * 64 + dvb * 16 + fq * 4) = acc[dvb][db];
    WAVE_SYNC();
}
__device__ __forceinline__ void gla_scan(const Args& a, uchar* lds) {
    int tid = threadIdx.x; asm volatile("" : "+v"(tid));
    float* U = (float*)(a.ws + WS_U); const float* DEC = (const float*)(a.ws + WS_DEC);
    float* PL = (float*)lds;
    const int seg = tid >> 7, el = tid & 127;
    constexpr int SEGN = NCH / 4;
    for (int blk = blockIdx.x; blk < 16 * 16; blk += gridDim.x) {
        const int seq = blk >> 4, e = (blk & 15) * 128 + el, d = e >> 6;
        float* u = U + ((size_t)seq * NCH + seg * SEGN) * 2048 + e; const float* dc = DEC + ((size_t)seq * NCH + seg * SEGN) * 32 + d;
        float pr = 1.f, s = 0.f;
#pragma unroll 13
        for (int n = 0; n < SEGN; ++n) { const float un = u[(size_t)n * 2048], dn = dc[n * 32]; s = dn * s + un; pr *= dn; }
        __syncthreads();
        PL[(seg * 128 + el) * 2] = pr; PL[(seg * 128 + el) * 2 + 1] = s;
        __syncthreads();
        float s0 = 0.f;
        for (int k = 0; k < seg; ++k) s0 = PL[(k * 128 + el) * 2] * s0 + PL[(k * 128 + el) * 2 + 1];
        s = s0;
#pragma unroll 13
        for (int n = 0; n < SEGN; ++n) { const float un = u[(size_t)n * 2048], dn = dc[n * 32]; u[(size_t)n * 2048] = s; s = dn * s + un; }
    }
    __syncthreads();
}
__device__ __forceinline__ void gla_g3_wave(const Args& a, int layer, int wu, uchar* wlds, int lane) {
    asm volatile("" : "+v"(lane));
    const int h = __builtin_amdgcn_readfirstlane(wu & 3), bc_ = __builtin_amdgcn_readfirstlane(wu >> 2), b = bc_ / NCH, c = bc_ % NCH;
    const int fr = lane & 15, fq = lane >> 4;
    const u16* P = (const u16*)(a.ws + WS_X);
    const int row_l = row_of(b, c, lane);
    const u16* prow = P + (size_t)row_l * DPROJ;
    u16* R0 = (u16*)wlds;
    u16* ST = (u16*)(wlds + 4096);
    u16* VT = (u16*)(wlds + 8192);
    const float* U = (const float*)(a.ws + WS_U);
    {
        bf16x8 vr[8];
#pragma unroll
        for (int q = 0; q < 8; ++q) vr[q] = ((const bf16x8*)(prow + C_GV + h * 64))[q];
#pragma unroll
        for (int q = 0; q < 8; ++q)
#pragma unroll
            for (int i = 0; i < 8; ++i) VT[(q * 8 + i) * 64 + lane] = (u16)vr[q][i];
    }
    f32x4 O[4][4];
#pragma unroll
    for (int qb = 0; qb < 4; ++qb)
#pragma unroll
        for (int dvb = 0; dvb < 4; ++dvb) O[qb][dvb] = (f32x4){0.f, 0.f, 0.f, 0.f};
#pragma unroll
    for (int dir = 0; dir < 2; ++dir) {
        __builtin_amdgcn_sched_barrier(0);
        const int n = gla_scan_idx(dir, c);
        const float* sp = U + ((size_t)((b * 2 + dir) * 4 + h) * NCH + n) * 2048;
        u32x4 qpk[4], kpk[4], spk[4];
        {
#pragma unroll
            for (int q = 0; q < 4; ++q) { unsigned w[4];
#pragma unroll
                for (int i = 0; i < 4; ++i) { const int d = q * 8 + 2 * i; w[i] = pk2(sp[d * 64 + lane], sp[(d + 1) * 64 + lane]); }
                spk[q] = (u32x4){w[0], w[1], w[2], w[3]}; }
        }
        {
            const f32x4* bcp = (const f32x4*)((const float*)(a.ws + WS_BC) + ((((size_t)((b * 2 + dir) * 4 + h) * NCH + c) * 64 + lane) * 32));
#pragma unroll
            for (int q = 0; q < 4; ++q) {
                const bf16x8 qr = ((const bf16x8*)(prow + C_GQ + h * 32))[q], kr = ((const bf16x8*)(prow + C_GK + h * 32))[q];
                const f32x4 b0 = bcp[2 * q], b1 = bcp[2 * q + 1];
                float e[8];
#pragma unroll
                for (int i = 0; i < 4; ++i) { e[i] = __expf(b0[i]); e[4 + i] = __expf(b1[i]); }
                unsigned wq[4], wk[4];
#pragma unroll
                for (int i = 0; i < 4; ++i) {
                    wq[i] = pk2(bf2f((u16)qr[2 * i]) * 0.17677669529663687f * e[2 * i], bf2f((u16)qr[2 * i + 1]) * 0.17677669529663687f * e[2 * i + 1]);
                    wk[i] = pk2(bf2f((u16)kr[2 * i]) * __builtin_amdgcn_rcpf(e[2 * i]), bf2f((u16)kr[2 * i + 1]) * __builtin_amdgcn_rcpf(e[2 * i + 1]));
                }
                qpk[q] = (u32x4){wq[0], wq[1], wq[2], wq[3]}; kpk[q] = (u32x4){wk[0], wk[1], wk[2], wk[3]};
            }
        }
        WAVE_SYNC();
#pragma unroll
        for (int q = 0; q < 4; ++q) ((u32x4*)(R0 + lane * 32))[q] = qpk[q];
#pragma unroll
        for (int q = 0; q < 4; ++q) ((u32x4*)(ST + lane * 32))[q] = spk[q];
        WAVE_SYNC();
        bf16x8 qf[4];
#pragma unroll
        for (int qb = 0; qb < 4; ++qb) qf[qb] = *(const bf16x8*)(R0 + (qb * 16 + fr) * 32 + fq * 8);
        WAVE_SYNC();
#pragma unroll
        for (int q = 0; q < 4; ++q) ((u32x4*)(R0 + lane * 32))[q] = kpk[q];
        WAVE_SYNC();
#pragma unroll
        for (int dvb = 0; dvb < 4; ++dvb) {
            const bf16x8 sf = *(const bf16x8*)(ST + (dvb * 16 + fr) * 32 + fq * 8);
#pragma unroll
            for (int qb = 0; qb < 4; ++qb) O[qb][dvb] = __builtin_amdgcn_mfma_f32_16x16x32_bf16(sf, qf[qb], O[qb][dvb], 0, 0, 0);
        }
#pragma unroll
        for (int ip = 0; ip < 2; ++ip) {
            const bf16x8 kf0 = *(const bf16x8*)(R0 + ((2 * ip) * 16 + fr) * 32 + fq * 8), kf1 = *(const bf16x8*)(R0 + ((2 * ip + 1) * 16 + fr) * 32 + fq * 8);
            bf16x8 pf[4];
#pragma unroll
            for (int qb = 0; qb < 4; ++qb) {
                f32x4 a0 = (f32x4){0.f, 0.f, 0.f, 0.f}, a1 = a0;
                a0 = __builtin_amdgcn_mfma_f32_16x16x32_bf16(kf0, qf[qb], a0, 0, 0, 0);
                a1 = __builtin_amdgcn_mfma_f32_16x16x32_bf16(kf1, qf[qb], a1, 0, 0, 0);
                const int i = qb * 16 + fr;
                float p[8];
#pragma unroll
                for (int jj = 0; jj < 4; ++jj) {
                    const int j0 = (2 * ip) * 16 + fq * 4 + jj, j1 = j0 + 16;
                    p[jj] = (dir == 0 ? (j0 <= i) : (j0 >= i)) ? a0[jj] : 0.f;
                    p[4 + jj] = (dir == 0 ? (j1 <= i) : (j1 >= i)) ? a1[jj] : 0.f;
                }
                u32x4 w; w.x = pk2(p[0], p[1]); w.y = pk2(p[2], p[3]); w.z = pk2(p[4], p[5]); w.w = pk2(p[6], p[7]);
                pf[qb] = __builtin_bit_cast(bf16x8, w);
            }
#pragma unroll
            for (int dvb = 0; dvb < 4; ++dvb) {
                const u16* vp = VT + (dvb * 16 + fr) * 64 + (2 * ip) * 16 + fq * 4;
                const s16x4 lo = *(const s16x4*)vp, hi = *(const s16x4*)(vp + 16);
                const bf16x8 vf = __builtin_shufflevector(lo, hi, 0, 1, 2, 3, 4, 5, 6, 7);
#pragma unroll
                for (int qb = 0; qb < 4; ++qb) O[qb][dvb] = __builtin_amdgcn_mfma_f32_16x16x32_bf16(vf, pf[qb], O[qb][dvb], 0, 0, 0);
            }
        }
    }
    const float* gnw = a.in[I_GNORM] + layer * 64;
    u16* MIX = (u16*)(a.ws + WS_A);
#pragma unroll
    for (int qb = 0; qb < 4; ++qb) {
        float ss = 0.f;
#pragma unroll
        for (int dvb = 0; dvb < 4; ++dvb)
#pragma unroll
            for (int jj = 0; jj < 4; ++jj) ss += O[qb][dvb][jj] * O[qb][dvb][jj];
        ss += __shfl_xor(ss, 16); ss += __shfl_xor(ss, 32);
        const float r = rsqrtf(ss * (1.0f / 64.0f) + 1e-6f);
        const int row = row_of(b, c, qb * 16 + fr);
#pragma unroll
        for (int dvb = 0; dvb < 4; ++dvb) {
            const int v0 = dvb * 16 + fq * 4;
            const s16x4 g4 = *(const s16x4*)(P + (size_t)row * DPROJ + C_GG + h * 64 + v0);
            const f32x4 nw = *(const f32x4*)(gnw + v0);
            float o[4];
#pragma unroll
            for (int jj = 0; jj < 4; ++jj) o[jj] = O[qb][dvb][jj] * r * nw[jj] * silu_f(bf2f((u16)g4[jj]));
            u32x2 w; w.x = pk2(o[0], o[1]); w.y = pk2(o[2], o[3]);
            *(u32x2*)(MIX + (size_t)row * D + h * 64 + v0) = w;
        }
    }
    WAVE_SYNC();
}

__device__ __forceinline__ void conv_unit(const Args& a, int layer, int unit, uchar* lds, const bf16x8 (&wf)[2][8]) {
    int tid = threadIdx.x; asm volatile("" : "+v"(tid)); const int lane = tid & 63, wave = tid >> 6, fr = lane & 15, fq = lane >> 4;
    int t0, L, rowbase;
    if (unit < 1024) { const int b = unit >> 9; t0 = (unit & 511) * 32; L = SEQ; rowbase = b * SEQ; }
    else { const int uu = unit - 1024, b = uu >> 3; t0 = (uu & 7) * 32; L = CTXL; rowbase = MX + b * CTXL; }
    const u16* P = (const u16*)(a.ws + WS_X);
    float* Ub = (float*)lds;
    float* Y = (float*)(lds + 65536);
    u16* Z = (u16*)(lds + 98304);
    {
        s16x4 av[8], gv[8];
#pragma unroll
        for (int it = 0; it < 8; ++it) {
            const int i = tid + it * 512, p = i >> 6, c4 = (i & 63) * 4, t = t0 - 15 + p;
            av[it] = (s16x4){0, 0, 0, 0}; gv[it] = av[it];
            if (i < 62 * 64 && t >= 0 && t < L) { const u16* pr = P + (size_t)(rowbase + t) * DPROJ; av[it] = *(const s16x4*)(pr + C_CA + c4); gv[it] = *(const s16x4*)(pr + C_CG + c4); }
        }
#pragma unroll
        for (int it = 0; it < 8; ++it) {
            const int i = tid + it * 512, p = i >> 6, c4 = (i & 63) * 4;
            f32x4 u;
#pragma unroll
            for (int e = 0; e < 4; ++e) { const float g = bf2f((u16)gv[it][e]); u[e] = bf2f((u16)av[it][e]) * __builtin_amdgcn_rcpf(1.0f + __expf(-g)); }
            if (i < 62 * 64) *(f32x4*)(Ub + p * 256 + c4) = u;
        }
    }
    __syncthreads();
    {
        const int c = tid & 255, th = tid >> 8;
        const float* dw = a.in[I_CDW] + (size_t)layer * 31 * 256 + c;
        float w[31];
#pragma unroll
        for (int k = 0; k < 31; ++k) w[k] = dw[k * 256];
        const float bias = a.in[I_CDWB][layer * 256 + c];
        float uw[46];
#pragma unroll
        for (int i = 0; i < 46; ++i) uw[i] = Ub[(th * 16 + i) * 256 + c];
#pragma unroll
        for (int tt = 0; tt < 16; ++tt) {
            float acc = bias;
#pragma unroll
            for (int k = 0; k < 31; ++k) acc += w[k] * uw[tt + k];
            Y[(th * 16 + tt) * 256 + c] = acc;
        }
    }
    __syncthreads();
    {
        const f32x4 g4 = *(const f32x4*)(a.in[I_CLNG] + layer * 256 + lane * 4), b4 = *(const f32x4*)(a.in[I_CLNB] + layer * 256 + lane * 4);
#pragma unroll
        for (int q = 0; q < 4; ++q) {
            const int t = wave * 4 + q;
            const f32x4 v = *(const f32x4*)(Y + t * 256 + lane * 4);
            const float mu = wave_sum((v.x + v.y) + (v.z + v.w)) * (1.0f / 256.0f);
            const f32x4 dlt = v - mu;
            const float var = wave_sum((dlt.x * dlt.x + dlt.y * dlt.y) + (dlt.z * dlt.z + dlt.w * dlt.w)) * (1.0f / 256.0f);
            const float rs = rsqrtf(var + 1e-5f);
            float z[4];
#pragma unroll
            for (int e = 0; e < 4; ++e) z[e] = silu_f(dlt[e] * rs * g4[e] + b4[e]);
            u32x2 w; w.x = pk2(z[0], z[1]); w.y = pk2(z[2], z[3]);
            *(u32x2*)(Z + t * 264 + lane * 4) = w;
        }
    }
    __syncthreads();
    {
        f32x4 acc[2][2];
#pragma unroll
        for (int i = 0; i < 2; ++i)
#pragma unroll
            for (int j = 0; j < 2; ++j) acc[i][j] = (f32x4){0.f, 0.f, 0.f, 0.f};
#pragma unroll
        for (int ks = 0; ks < 8; ++ks) {
            bf16x8 zf[2];
#pragma unroll
            for (int tb = 0; tb < 2; ++tb) zf[tb] = *(const bf16x8*)(Z + (tb * 16 + fr) * 264 + ks * 32 + fq * 8);
#pragma unroll
            for (int nbi = 0; nbi < 2; ++nbi)
#pragma unroll
                for (int tb = 0; tb < 2; ++tb) acc[nbi][tb] = __builtin_amdgcn_mfma_f32_16x16x32_bf16(wf[nbi][ks], zf[tb], acc[nbi][tb], 0, 0, 0);
        }
        u16* MIX = (u16*)(a.ws + WS_A);
#pragma unroll
        for (int nbi = 0; nbi < 2; ++nbi) {
            const int n0 = (wave * 2 + nbi) * 16 + fq * 4;
            const f32x4 pb = *(const f32x4*)(a.in[I_CPWB] + layer * 256 + n0);
#pragma unroll
            for (int tb = 0; tb < 2; ++tb) {
                const int row = rowbase + t0 + tb * 16 + fr;
                u32x2 w; w.x = pk2(acc[nbi][tb][0] + pb[0], acc[nbi][tb][1] + pb[1]); w.y = pk2(acc[nbi][tb][2] + pb[2], acc[nbi][tb][3] + pb[3]);
                *(u32x2*)(MIX + (size_t)row * D + 768 + n0) = w;
            }
        }
    }
    __syncthreads();
}
#define XB_TMO      128
#define XB_XCNT(j)  (256  + 64 * (j))
#define XB_XSUB(j)  (1280 + 64 * (j))
#define XB_XGEN(j)  (2304 + 64 * (j))
#define XB_TOP      3328
#define XB_TOPGEN   3392
#define XCD_BAR_WORDS 3456
#define XB_SPIN_CAP (1u << 18)

__device__ __forceinline__ unsigned xb_ld(unsigned* p)              { return __hip_atomic_load(p, __ATOMIC_RELAXED, __HIP_MEMORY_SCOPE_AGENT); }
__device__ __forceinline__ unsigned xb_add(unsigned* p, unsigned v) { return __hip_atomic_fetch_add(p, v, __ATOMIC_RELAXED, __HIP_MEMORY_SCOPE_AGENT); }
__device__ __forceinline__ unsigned xb_xcc_id() { return (unsigned)__builtin_amdgcn_s_getreg((3 << 11) | 20) & 0xFu; }
#define XB_SPIN(cond, bar) do { unsigned _sp = 0; while (cond) { __builtin_amdgcn_s_sleep(1); \
    if ((++_sp & 255u) == 0u) { if (xb_ld(&(bar)[XB_TMO])) break; if (_sp > XB_SPIN_CAP) { atomicAdd(&(bar)[XB_TMO], 1u); break; } } } } while (0)

struct XcdBarrier {
    unsigned* bar; unsigned x;
    volatile LAS unsigned* st;
};

__device__ __forceinline__ XcdBarrier xcd_barrier_post(unsigned* bar, volatile LAS unsigned* st) {
    XcdBarrier b; b.bar = bar; b.x = xb_xcc_id(); b.st = st;
    if (threadIdx.x == 0) (void)xb_add(&bar[XB_XCNT(b.x)], 1u);
    return b;
}
__device__ __forceinline__ void xcd_barrier_complete(unsigned* bar, unsigned x, unsigned& nloc, unsigned& nx) {
    const unsigned G = gridDim.x * gridDim.y * gridDim.z;
    unsigned sum, cnt, mine, sp = 0u;
    for (;;) {
        sum = 0u; cnt = 0u; mine = 0u;
#pragma unroll
        for (unsigned j = 0; j < 16; ++j) { const unsigned c = xb_ld(&bar[XB_XCNT(j)]); sum += c; cnt += (c > 0u) ? 1u : 0u; mine = (j == x) ? c : mine; }
        if (sum == G) break;
        __builtin_amdgcn_s_sleep(1);
        if ((++sp & 255u) == 0u) { if (xb_ld(&bar[XB_TMO])) break; if (sp > XB_SPIN_CAP) { atomicAdd(&bar[XB_TMO], 1u); break; } }
    }
    nloc = mine > 0u ? mine : 1u; nx = cnt > 0u ? cnt : 1u;
}

__device__ __forceinline__ void xcd_barrier(const XcdBarrier& b) {
    asm volatile("s_waitcnt vmcnt(0)" ::: "memory");
    __syncthreads();
    if (threadIdx.x == 0) {
        unsigned* bar = b.bar;
        __builtin_amdgcn_s_waitcnt(0);
        unsigned nloc = b.st[0], nx = b.st[1];
        if (nloc == 0u) { xcd_barrier_complete(bar, b.x, nloc, nx); b.st[0] = nloc; b.st[1] = nx; }
        const unsigned old = xb_add(&bar[XB_XSUB(b.x)], 1u);
        const unsigned gen = old / nloc;
        if (old + 1u == (gen + 1u) * nloc) {
            __builtin_amdgcn_fence(__ATOMIC_RELEASE, "agent");
            asm volatile("s_waitcnt vmcnt(0)" ::: "memory");
            const unsigned og = xb_add(&bar[XB_TOP], 1u);
            const unsigned tg = og / nx;
            if (og + 1u == (tg + 1u) * nx) xb_add(&bar[XB_TOPGEN], 1u);
            else XB_SPIN(xb_ld(&bar[XB_TOPGEN]) == tg, bar);
            __builtin_amdgcn_fence(__ATOMIC_ACQUIRE, "agent");
            xb_add(&bar[XB_XGEN(b.x)], 1u);
            asm volatile("s_waitcnt vmcnt(0)" ::: "memory");
        } else {
            XB_SPIN(xb_ld(&bar[XB_XGEN(b.x)]) == gen, bar);
            __builtin_amdgcn_fence(__ATOMIC_ACQUIRE, "agent");
            asm volatile("s_waitcnt vmcnt(0)" ::: "memory");
        }
    }
    __syncthreads();
}

typedef float f32x2_t __attribute__((ext_vector_type(2)));
typedef __bf16 bf16x2_t __attribute__((ext_vector_type(2)));
__device__ __forceinline__ unsigned cvtpk_s(float lo, float hi) { f32x2_t v = {lo, hi}; bf16x2_t b = __builtin_convertvector(v, bf16x2_t); return __builtin_bit_cast(unsigned, b); }
__device__ __forceinline__ bf16x8 pack8(const f32x4& p0, const f32x4& p1) {
    u32x4 w; w.x = cvtpk_s(p0[0], p0[1]); w.y = cvtpk_s(p0[2], p0[3]); w.z = cvtpk_s(p1[0], p1[1]); w.w = cvtpk_s(p1[2], p1[3]);
    return __builtin_bit_cast(bf16x8, w);
}
__device__ __forceinline__ bf16x8 load_scaled8(const u16* p, float sc, float& n2) {
    const bf16x8 raw = *(const bf16x8*)p; bf16x8 o;
#pragma unroll
    for (int i = 0; i < 8; ++i) { const u16 r = f2bf(bf2f((u16)raw[i]) * sc); const float f = bf2f(r); n2 += f * f; o[i] = (short)r; }
    return o;
}

__device__ __forceinline__ void diff_unit(const Args& a, int layer, int b, int h, int q0row, int ntiles, uchar* lds) {
    int tid = threadIdx.x; asm volatile("" : "+v"(tid)); const int lane = tid & 63, wave = tid >> 6, fr = lane & 15, fq = lane >> 4;
    const u16* P = (const u16*)(a.ws + WS_X);
    const u16* VTD = (const u16*)(a.ws + WS_VTD) + (size_t)(b * 4 + h) * 64 * NKEY;
    const unsigned* ctl = (const unsigned*)(a.ws + WS_CTL) + layer * 64;
    u16* Ks = (u16*)lds;
    u16* Vs = (u16*)(lds + 4 * 64 * 64 * 2);
    const float C2 = 0.17677669529663687f * LOG2E;
    bf16x8 qf[2][2]; float negb[2][2];
#pragma unroll
    for (int qb = 0; qb < 2; ++qb)
#pragma unroll
        for (int s = 0; s < 2; ++s) {
            const int row = q0row + wave * 32 + qb * 16 + fr; float n2 = 0.f;
            qf[qb][s] = load_scaled8(P + (size_t)row * DPROJ + C_DQ + h * 64 + s * 32 + fq * 8, C2, n2);
            n2 += __shfl_xor(n2, 16); n2 += __shfl_xor(n2, 32);
            const float km = __uint_as_float(ctl[(b * 4 + h) * 2 + s]);
            negb[qb][s] = -sqrtf(n2 * km);
        }
    f32x4 O[2][2][4], Ls[2][2];
    const bf16x8 ones = (bf16x8){(short)0x3F80, (short)0x3F80, (short)0x3F80, (short)0x3F80, (short)0x3F80, (short)0x3F80, (short)0x3F80, (short)0x3F80};
#pragma unroll
    for (int qb = 0; qb < 2; ++qb)
#pragma unroll
        for (int s = 0; s < 2; ++s) { Ls[qb][s] = (f32x4){0.f, 0.f, 0.f, 0.f};
#pragma unroll
            for (int dvb = 0; dvb < 4; ++dvb) O[qb][s][dvb] = (f32x4){0.f, 0.f, 0.f, 0.f}; }
    const int sr = tid >> 3, pc = tid & 7;
    auto kaddr = [&](int t) -> const u16* { const int krow = (t < 4) ? (MX + b * CTXL + t * 64 + sr) : (b * SEQ + (t - 4) * 64 + sr); return P + (size_t)krow * DPROJ + C_DK + h * 64 + pc * 8; };
    auto vaddr = [&](int t) -> const u16* { return VTD + (size_t)sr * NKEY + t * 64 + pc * 8; };
    auto compute_tile = [&](const u16* Kb, const u16* Vb) {
        f32x4 S0[2][2], S1[2][2];
        bf16x8 pfr[2][2];
        bf16x8 vfr[4];
#define DIFF_QK(g) do { const int i_ = (g) >> 1, s_ = (g) & 1; \
            const bf16x8 kf0 = *(const bf16x8*)(Kb + ((2 * i_) * 16 + fr) * 64 + (((s_ * 4 + fq) ^ (fr >> 1)) * 8)), kf1 = *(const bf16x8*)(Kb + ((2 * i_ + 1) * 16 + fr) * 64 + (((s_ * 4 + fq) ^ (fr >> 1)) * 8)); \
            _Pragma("unroll") for (int qb = 0; qb < 2; ++qb) { const float nb = negb[qb][s_]; const f32x4 c0 = (f32x4){nb, nb, nb, nb}; \
                S0[(g) & 1][qb] = __builtin_amdgcn_mfma_f32_16x16x32_bf16(kf0, qf[qb][s_], c0, 0, 0, 0); \
                S1[(g) & 1][qb] = __builtin_amdgcn_mfma_f32_16x16x32_bf16(kf1, qf[qb][s_], c0, 0, 0, 0); } } while (0)
#define DIFF_EXP(g) do { _Pragma("unroll") for (int qb = 0; qb < 2; ++qb) { f32x4 e0, e1; \
                _Pragma("unroll") for (int j = 0; j < 4; ++j) { e0[j] = __builtin_amdgcn_exp2f(S0[(g) & 1][qb][j]); e1[j] = __builtin_amdgcn_exp2f(S1[(g) & 1][qb][j]); } \
                pfr[(g) & 1][qb] = pack8(e0, e1); } } while (0)
#define DIFF_VLOAD(i_) do { _Pragma("unroll") for (int dvb = 0; dvb < 4; ++dvb) { const u16* vp = Vb + (dvb * 16 + fr) * 72 + (2 * (i_)) * 16 + fq * 4; \
                const s16x4 lo = *(const s16x4*)vp, hi = *(const s16x4*)(vp + 16); vfr[dvb] = __builtin_shufflevector(lo, hi, 0, 1, 2, 3, 4, 5, 6, 7); } } while (0)
#define DIFF_PV(g) do { const int s_ = (g) & 1; \
            _Pragma("unroll") for (int qb = 0; qb < 2; ++qb) Ls[qb][s_] = __builtin_amdgcn_mfma_f32_16x16x32_bf16(ones, pfr[(g) & 1][qb], Ls[qb][s_], 0, 0, 0); \
            _Pragma("unroll") for (int dvb = 0; dvb < 4; ++dvb) _Pragma("unroll") for (int qb = 0; qb < 2; ++qb) \
                O[qb][s_][dvb] = __builtin_amdgcn_mfma_f32_16x16x32_bf16(vfr[dvb], pfr[(g) & 1][qb], O[qb][s_][dvb], 0, 0, 0); } while (0)
        DIFF_QK(0); DIFF_VLOAD(0);
        DIFF_QK(1); DIFF_EXP(0);
        DIFF_QK(2); DIFF_EXP(1); DIFF_PV(0);
        DIFF_QK(3); DIFF_EXP(2); DIFF_PV(1); DIFF_VLOAD(1);
        DIFF_EXP(3); DIFF_PV(2);
        DIFF_PV(3);
#undef DIFF_QK
#undef DIFF_EXP
#undef DIFF_VLOAD
#undef DIFF_PV
    };
    bf16x8 kA = *(const bf16x8*)kaddr(0), vA = *(const bf16x8*)vaddr(0), kB = *(const bf16x8*)kaddr(1), vB = *(const bf16x8*)vaddr(1);
    __syncthreads();
#pragma unroll 1
    for (int t = 0; t < ntiles; t += 2) {
        u16* K0 = Ks + ((t >> 1) & 1) * 2 * 64 * 64; u16* V0 = Vs + ((t >> 1) & 1) * 2 * 64 * 72;
        *(bf16x8*)(K0 + sr * 64 + ((pc ^ ((sr >> 1) & 7)) * 8)) = kA; *(bf16x8*)(V0 + sr * 72 + pc * 8) = vA;
        *(bf16x8*)(K0 + 64 * 64 + sr * 64 + ((pc ^ ((sr >> 1) & 7)) * 8)) = kB; *(bf16x8*)(V0 + 64 * 72 + sr * 72 + pc * 8) = vB;
        __syncthreads();
        if (t + 2 < ntiles) { kA = *(const bf16x8*)kaddr(t + 2); vA = *(const bf16x8*)vaddr(t + 2); kB = *(const bf16x8*)kaddr(t + 3); vB = *(const bf16x8*)vaddr(t + 3); }
        compute_tile(K0, V0);
        compute_tile(K0 + 64 * 64, V0 + 64 * 72);
    }
    const float lam_init = (layer == 0) ? 0.2f : (0.8f - 0.6f * 0.7408182206817179f);
    float d1 = 0.f, d2 = 0.f;
    if (lane < 32) { d1 = a.in[I_LQ1][layer * 32 + lane] * a.in[I_LK1][layer * 32 + lane]; d2 = a.in[I_LQ2][layer * 32 + lane] * a.in[I_LK2][layer * 32 + lane]; }
    const float lam = expf(wave_sum(d1)) - expf(wave_sum(d2)) + lam_init;
    const float* dnw = a.in[I_DNORM] + layer * 64;
    u16* MIX = (u16*)(a.ws + WS_A);
#pragma unroll
    for (int qb = 0; qb < 2; ++qb) {
        const float l1 = Ls[qb][0][0], l2 = Ls[qb][1][0];
        const float i1 = 1.0f / l1, i2 = lam / l2;
        f32x4 o[4]; float ss = 0.f;
#pragma unroll
        for (int dvb = 0; dvb < 4; ++dvb) { o[dvb] = O[qb][0][dvb] * i1 - O[qb][1][dvb] * i2; ss += (o[dvb][0] * o[dvb][0] + o[dvb][1] * o[dvb][1]) + (o[dvb][2] * o[dvb][2] + o[dvb][3] * o[dvb][3]); }
        ss += __shfl_xor(ss, 16); ss += __shfl_xor(ss, 32);
        const float r = rsqrtf(ss * (1.0f / 64.0f) + 1e-6f) * (1.0f - lam_init);
        const int row = q0row + wave * 32 + qb * 16 + fr;
#pragma unroll
        for (int dvb = 0; dvb < 4; ++dvb) {
            const int v0 = dvb * 16 + fq * 4; const f32x4 nw = *(const f32x4*)(dnw + v0);
            u32x2 w; w.x = pk2(o[dvb][0] * r * nw[0], o[dvb][1] * r * nw[1]); w.y = pk2(o[dvb][2] * r * nw[2], o[dvb][3] * r * nw[3]);
            *(u32x2*)(MIX + (size_t)row * D + 512 + h * 64 + v0) = w;
        }
    }
}

__device__ __forceinline__ void na_wave(const Args& a, int layer, bool ctxq, int wu, int lane) {
    asm volatile("" : "+v"(lane));
    const int fr = lane & 15, fq = lane >> 4;
    const u16* P = (const u16*)(a.ws + WS_X);
    int b, h, r, qblk, qrow;
    if (!ctxq) { qblk = wu & 3; h = (wu >> 2) & 3; r = (wu >> 4) & 255; b = wu >> 12; qrow = b * SEQ + r * 64 + qblk * 16 + fr; }
    else { qblk = wu & 15; h = (wu >> 4) & 3; b = wu >> 6; r = 0; qrow = MX + b * CTXL + qblk * 16 + fr; }
    const int c = qblk * 16 + fr;
    const u16* VTN = (const u16*)(a.ws + WS_VTN) + (size_t)(b * 4 + h) * 64 * NKEY;
    const float C2 = 0.125f * LOG2E;
    bf16x8 qf[2]; float n2 = 0.f;
#pragma unroll
    for (int ks = 0; ks < 2; ++ks) qf[ks] = load_scaled8(P + (size_t)qrow * DPROJ + C_NQ + h * 64 + ks * 32 + fq * 8, C2, n2);
    n2 += __shfl_xor(n2, 16); n2 += __shfl_xor(n2, 32);
    const float km = __uint_as_float(((const unsigned*)(a.ws + WS_CTL))[layer * 64 + 16 + b * 4 + h]);
    const float bmax = ((const float*)(a.ws + WS_MISC))[8192 + layer];
    const float negb = -(sqrtf(n2 * km) + bmax * LOG2E);
    const float* rpb = a.in[I_RPB] + (size_t)(layer * 4 + h) * 15 * 31;
    const int rs = min(max(r - 4, 0), 248), cs = min(max(c - 8, 0), 48);
    f32x4 O[4]; float ls = 0.f;
#pragma unroll
    for (int dvb = 0; dvb < 4; ++dvb) O[dvb] = (f32x4){0.f, 0.f, 0.f, 0.f};
    const int nwh = (qblk == 0 || qblk == 3) ? 1 : 2, nwin = ctxq ? 0 : 8 * nwh, nsteps = nwin + 8;
    struct NaStep { bf16x8 kf[2][2]; s16x4 vlo[4], vhi[4]; float iv[2][4]; };
    auto load_step = [&](int st, NaStep& S) {
        int t, i; bool win;
        if (st < nwin) { win = true; if (nwh == 2) { t = st >> 1; i = st & 1; } else { t = st; i = (qblk == 3) ? 1 : 0; } }
        else { win = false; const int s2 = st - nwin; t = s2 >> 1; i = s2 & 1; }
        const int kr = rs + t;
        const int krow0 = win ? (b * SEQ + kr * 64) : (MX + b * CTXL + t * 64);
        const int key0 = win ? (CTXL + kr * 64) : (t * 64);
#pragma unroll
        for (int kbb = 0; kbb < 2; ++kbb) {
            const int kb = 2 * i + kbb;
#pragma unroll
            for (int ks = 0; ks < 2; ++ks) S.kf[kbb][ks] = *(const bf16x8*)(P + (size_t)(krow0 + kb * 16 + fr) * DPROJ + C_NK + h * 64 + ks * 32 + fq * 8);
#pragma unroll
            for (int j = 0; j < 4; ++j) {
                float iv = negb;
                if (win) { const int kc = kb * 16 + fq * 4 + j; const bool inw = (kc >= cs) && (kc < cs + 16);
                    const int co = min(max(kc - c + 15, 0), 30);
                    const float bias = rpb[(kr - r + 7) * 31 + co];
                    iv = inw ? (bias * LOG2E + negb) : -1e30f; }
                S.iv[kbb][j] = iv;
            }
        }
#pragma unroll
        for (int dvb = 0; dvb < 4; ++dvb) {
            const u16* vp = VTN + (size_t)(dvb * 16 + fr) * NKEY + key0 + (2 * i) * 16 + fq * 4;
            S.vlo[dvb] = *(const s16x4*)vp; S.vhi[dvb] = *(const s16x4*)(vp + 16);
        }
    };
    auto compute_step = [&](const NaStep& S) {
        f32x4 acc[2];
#pragma unroll
        for (int kbb = 0; kbb < 2; ++kbb) {
            acc[kbb] = (f32x4){S.iv[kbb][0], S.iv[kbb][1], S.iv[kbb][2], S.iv[kbb][3]};
#pragma unroll
            for (int ks = 0; ks < 2; ++ks) acc[kbb] = __builtin_amdgcn_mfma_f32_16x16x32_bf16(S.kf[kbb][ks], qf[ks], acc[kbb], 0, 0, 0);
#pragma unroll
            for (int j = 0; j < 4; ++j) acc[kbb][j] = __builtin_amdgcn_exp2f(acc[kbb][j]);
            ls += (acc[kbb][0] + acc[kbb][1]) + (acc[kbb][2] + acc[kbb][3]);
        }
        const bf16x8 pf = pack8(acc[0], acc[1]);
#pragma unroll
        for (int dvb = 0; dvb < 4; ++dvb) {
            const bf16x8 vf = __builtin_shufflevector(S.vlo[dvb], S.vhi[dvb], 0, 1, 2, 3, 4, 5, 6, 7);
            O[dvb] = __builtin_amdgcn_mfma_f32_16x16x32_bf16(vf, pf, O[dvb], 0, 0, 0);
        }
    };
    {
        NaStep SA, SB;
        load_step(0, SA);
#pragma unroll 1
        for (int st = 0; st < nsteps; st += 2) {
            load_step(st + 1, SB);
            compute_step(SA);
            if (st + 2 < nsteps) load_step(st + 2, SA);
            compute_step(SB);
        }
    }
    ls += __shfl_xor(ls, 16); ls += __shfl_xor(ls, 32);
    const float il = 1.0f / ls;
    u16* MIX = (u16*)(a.ws + WS_A);
#pragma unroll
    for (int dvb = 0; dvb < 4; ++dvb) {
        u32x2 w; w.x = pk2(O[dvb][0] * il, O[dvb][1] * il); w.y = pk2(O[dvb][2] * il, O[dvb][3] * il);
        *(u32x2*)(MIX + (size_t)qrow * D + 256 + h * 64 + dvb * 16 + fq * 4) = w;
    }
}


template <int QH> __device__ __forceinline__ void na_unit(const Args& a, int layer, int b, int h, int g, uchar* lds) {
    int tid = threadIdx.x; asm volatile("" : "+v"(tid)); const int lane = tid & 63, wave = __builtin_amdgcn_readfirstlane(tid >> 6), fr = lane & 15, fq = lane >> 4;
    const u16* P = (const u16*)(a.ws + WS_X);
    const u16* VTN = (const u16*)(a.ws + WS_VTN) + (size_t)(b * 4 + h) * 64 * NKEY;
    u16* Ks = (u16*)lds;
    u16* Vs = (u16*)(lds + 2 * 64 * 64 * 2);
    const int r = 8 * g + wave, rsw = min(max(r - 4, 0), 248);
    const float C2 = 0.125f * LOG2E;
    const float km = __uint_as_float(((const unsigned*)(a.ws + WS_CTL))[layer * 64 + 16 + b * 4 + h]);
    const float bmax = ((const float*)(a.ws + WS_MISC))[8192 + layer];
    const float* rpb = a.in[I_RPB] + (size_t)(layer * 4 + h) * 15 * 31;
    float* rpbs = (float*)(lds + 36864);
    bf16x8 qf[2][2]; float negb[2], ls[2];
    unsigned mlo = 0u;
#pragma unroll
    for (int qq = 0; qq < 2; ++qq) {
        const int qblk = 2 * QH + qq;
        const int qrow = b * SEQ + r * 64 + qblk * 16 + fr; float n2 = 0.f;
#pragma unroll
        for (int ks = 0; ks < 2; ++ks) qf[qq][ks] = load_scaled8(P + (size_t)qrow * DPROJ + C_NQ + h * 64 + ks * 32 + fq * 8, C2, n2);
        n2 += __shfl_xor(n2, 16); n2 += __shfl_xor(n2, 32);
        negb[qq] = -(sqrtf(n2 * km) + bmax * LOG2E); ls[qq] = 0.f;
        const int c = qblk * 16 + fr, cs = min(max(c - 8, 0), 48);
#pragma unroll
        for (int kb = 0; kb < 4; ++kb)
#pragma unroll
            for (int j = 0; j < 4; ++j) { const int kc = kb * 16 + fq * 4 + j; const unsigned bit = (kc >= cs && kc < cs + 16) ? 1u : 0u; const int idx = (qq * 4 + kb) * 4 + j;
                mlo |= bit << idx; }
    }
    f32x4 O[2][4];
#pragma unroll
    for (int qq = 0; qq < 2; ++qq)
#pragma unroll
        for (int dvb = 0; dvb < 4; ++dvb) O[qq][dvb] = (f32x4){0.f, 0.f, 0.f, 0.f};
    const int lo = min(max(8 * g - 4, 0), 248), hi = min(max(8 * g + 3, 0), 248) + 7, nwin = hi - lo + 1, ntiles = nwin + 4;
    const int sr = tid >> 3, pc = tid & 7;
    auto kaddr = [&](int t) -> const u16* { const int krow = (t < nwin) ? (b * SEQ + (lo + t) * 64 + sr) : (MX + b * CTXL + (t - nwin) * 64 + sr); return P + (size_t)krow * DPROJ + C_NK + h * 64 + pc * 8; };
    auto vaddr = [&](int t) -> const u16* { const int key0 = (t < nwin) ? (CTXL + (lo + t) * 64) : ((t - nwin) * 64); return VTN + (size_t)sr * NKEY + key0 + pc * 8; };
    bf16x8 kreg = *(const bf16x8*)kaddr(0), vreg = *(const bf16x8*)vaddr(0);
    __syncthreads();
    if (tid < 15 * 31) rpbs[tid] = rpb[tid] * LOG2E;
#pragma unroll 1
    for (int t = 0; t < ntiles; ++t) {
        u16* Kb = Ks + (t & 1) * 64 * 64; u16* Vb = Vs + (t & 1) * 64 * 72;
        *(bf16x8*)(Kb + sr * 64 + ((pc ^ ((sr >> 1) & 7)) * 8)) = kreg; *(bf16x8*)(Vb + sr * 72 + pc * 8) = vreg;
        __syncthreads();
        if (t + 1 < ntiles) { kreg = *(const bf16x8*)kaddr(t + 1); vreg = *(const bf16x8*)vaddr(t + 1); }
        const bool win = t < nwin; const int kr = lo + t;
        if (win && (kr < rsw || kr > rsw + 7)) continue;
        float bl[3][4];
        if (win) {
#pragma unroll
            for (int dl = 0; dl < 3; ++dl)
#pragma unroll
                for (int j = 0; j < 4; ++j) { const int co = min(max(16 * (dl - 1) + fq * 4 + j - fr + 15, 0), 30); bl[dl][j] = rpbs[(kr - r + 7) * 31 + co]; }
        }
#pragma unroll
        for (int i = 0; i < 2; ++i) {
            bf16x8 kf[2][2], vf[4];
#pragma unroll
            for (int kbb = 0; kbb < 2; ++kbb)
#pragma unroll
                for (int ks = 0; ks < 2; ++ks) kf[kbb][ks] = *(const bf16x8*)(Kb + ((2 * i + kbb) * 16 + fr) * 64 + (((ks * 4 + fq) ^ (fr >> 1)) * 8));
#pragma unroll
            for (int dvb = 0; dvb < 4; ++dvb) { const u16* vp = Vb + (dvb * 16 + fr) * 72 + (2 * i) * 16 + fq * 4;
                const s16x4 vlo = *(const s16x4*)vp, vhi = *(const s16x4*)(vp + 16); vf[dvb] = __builtin_shufflevector(vlo, vhi, 0, 1, 2, 3, 4, 5, 6, 7); }
#pragma unroll
            for (int qq = 0; qq < 2; ++qq) {
                const int qblk = 2 * QH + qq;
                if (win && ((qblk == 0 && i == 1) || (qblk == 3 && i == 0))) continue;
                f32x4 p[2];
#pragma unroll
                for (int kbb = 0; kbb < 2; ++kbb) {
                    const int kb = 2 * i + kbb, dl = kb - qblk;
                    if (win && (dl < -1 || dl > 1)) { p[kbb] = (f32x4){0.f, 0.f, 0.f, 0.f}; continue; }
                    f32x4 acc;
#pragma unroll
                    for (int j = 0; j < 4; ++j) {
                        float iv = negb[qq];
                        if (win) { const int idx = (qq * 4 + kb) * 4 + j; const bool inw = (mlo >> idx) & 1u;
                            iv = inw ? (bl[(dl + 1) < 0 ? 0 : ((dl + 1) > 2 ? 2 : (dl + 1))][j] + negb[qq]) : -1e30f; }
                        acc[j] = iv;
                    }
#pragma unroll
                    for (int ks = 0; ks < 2; ++ks) acc = __builtin_amdgcn_mfma_f32_16x16x32_bf16(kf[kbb][ks], qf[qq][ks], acc, 0, 0, 0);
#pragma unroll
                    for (int j = 0; j < 4; ++j) acc[j] = __builtin_amdgcn_exp2f(acc[j]);
                    ls[qq] += (acc[0] + acc[1]) + (acc[2] + acc[3]);
                    p[kbb] = acc;
                }
                const bf16x8 pf = pack8(p[0], p[1]);
#pragma unroll
                for (int dvb = 0; dvb < 4; ++dvb) O[qq][dvb] = __builtin_amdgcn_mfma_f32_16x16x32_bf16(vf[dvb], pf, O[qq][dvb], 0, 0, 0);
            }
        }
    }
    u16* MIX = (u16*)(a.ws + WS_A);
#pragma unroll
    for (int qq = 0; qq < 2; ++qq) {
        const int qblk = 2 * QH + qq;
        float l = ls[qq]; l += __shfl_xor(l, 16); l += __shfl_xor(l, 32);
        const float il = 1.0f / l; const int qrow = b * SEQ + r * 64 + qblk * 16 + fr;
#pragma unroll
        for (int dvb = 0; dvb < 4; ++dvb) {
            u32x2 w; w.x = pk2(O[qq][dvb][0] * il, O[qq][dvb][1] * il); w.y = pk2(O[qq][dvb][2] * il, O[qq][dvb][3] * il);
            *(u32x2*)(MIX + (size_t)qrow * D + 256 + h * 64 + dvb * 16 + fq * 4) = w;
        }
    }
}


__device__ __forceinline__ void ctx_resid_gemm(const Args& a, const u16* A, const u16* Bt, int K, const float* gate, float coef, uchar* lds, const float* src) {
    int tid = threadIdx.x; asm volatile("" : "+v"(tid)); const int lane = tid & 63, wave = __builtin_amdgcn_readfirstlane(tid >> 6), fr = lane & 15, fq = lane >> 4;
    float* red = (float*)lds;
    float* Hc = (float*)(a.ws + WS_HC);
    const int nks = K >> 5;
    for (int tile = blockIdx.x; tile < 256; tile += gridDim.x) {
        const int row0 = (tile >> 4) * 32, col0 = (tile & 15) * 64;
        f32x4 acc[2][4];
#pragma unroll
        for (int rb = 0; rb < 2; ++rb)
#pragma unroll
            for (int cb = 0; cb < 4; ++cb) acc[rb][cb] = (f32x4){0.f, 0.f, 0.f, 0.f};
#pragma unroll 4
        for (int ks = wave; ks < nks; ks += 8) {
            bf16x8 af[2], bfr[4];
#pragma unroll
            for (int rb = 0; rb < 2; ++rb) af[rb] = *(const bf16x8*)(A + (size_t)(row0 + rb * 16 + fr) * K + ks * 32 + fq * 8);
#pragma unroll
            for (int cb = 0; cb < 4; ++cb) bfr[cb] = *(const bf16x8*)(Bt + (size_t)(col0 + cb * 16 + fr) * K + ks * 32 + fq * 8);
#pragma unroll
            for (int rb = 0; rb < 2; ++rb)
#pragma unroll
                for (int cb = 0; cb < 4; ++cb) acc[rb][cb] = __builtin_amdgcn_mfma_f32_16x16x32_bf16(bfr[cb], af[rb], acc[rb][cb], 0, 0, 0);
        }
        __syncthreads();
#pragma unroll
        for (int rb = 0; rb < 2; ++rb)
#pragma unroll
            for (int cb = 0; cb < 4; ++cb) *(f32x4*)(red + wave * 2048 + (rb * 16 + fr) * 64 + cb * 16 + fq * 4) = acc[rb][cb];
        __syncthreads();
        {
            const int idx = tid * 4, rr = idx >> 6, cc = idx & 63;
            f32x4 sum = (f32x4){0.f, 0.f, 0.f, 0.f};
#pragma unroll
            for (int w = 0; w < 8; ++w) sum = sum + *(const f32x4*)(red + w * 2048 + idx);
            const f32x4 gv = *(const f32x4*)(gate + col0 + cc) * coef;
            const size_t off = (size_t)(row0 + rr) * D + col0 + cc;
            *(f32x4*)(Hc + off) = *(const f32x4*)(src + off) + gv * sum;
        }
    }
    __syncthreads();
}


#ifndef PROBE_DIFF
#define PROBE_DIFF 1
#endif
#ifndef PROBE_NA
#define PROBE_NA 1
#endif
#ifndef PROBE_G13
#define PROBE_G13 1
#endif
#ifndef PROBE_G1
#define PROBE_G1 1
#endif
#ifndef PROBE_PREP
#define PROBE_PREP 1
#endif
#ifndef PROBE_SYNC
#define PROBE_SYNC 0
#endif
#ifndef PROBE_CONV
#define PROBE_CONV 1
#endif
#ifndef PROBE_G3
#define PROBE_G3 1
#endif
#ifndef PROBE_NORM
#define PROBE_NORM 1
#endif
template <int PHMASK, int PH> __device__ __forceinline__ void phase_body(const Args& a, unsigned char* lds) {
    int tid = threadIdx.x; asm volatile("" : "+v"(tid)); const int lane = tid & 63, wave = __builtin_amdgcn_readfirstlane(tid >> 6), G = gridDim.x, bid = blockIdx.x;
    u16* const Abuf = (u16*)(a.ws + WS_A);
    u16* const Xbuf = (u16*)(a.ws + WS_X);
    if constexpr (PH == 0) { if constexpr ((PHMASK & 1) != 0) for (int rep = 0; rep < PROBE_PREP; ++rep) { __syncthreads(); phase_prep(a, lds); } }
    else if constexpr (PH == NPHASE - 1) { if constexpr ((PHMASK & 2) != 0) phase_final(a); }
    else {
        constexpr int layer = (PH - 1) / 12, sp = (PH - 1) % 12;
        constexpr bool last = (layer == 1);
        constexpr int Mpost = last ? MX : MT;
        if constexpr (sp == 0) { if constexpr ((PHMASK & 2) != 0) for (int rep = 0; rep < PROBE_NORM; ++rep) phase_norm(a, layer, 0, MT, layer == 0); }
        if constexpr (sp == 3) { if constexpr ((PHMASK & 2) != 0) for (int rep = 0; rep < PROBE_NORM; ++rep) phase_norm(a, layer, 1, MT, false); }
        if constexpr (sp == 9) { if constexpr ((PHMASK & 2) != 0) for (int rep = 0; rep < PROBE_NORM; ++rep) phase_norm(a, layer, 2, Mpost, false); }
        if constexpr ((sp == 1 || sp == 10) && (PHMASK & 4)) {
            const int M = (sp == 1) ? MT : Mpost;
            pg8::Gemm g{Abuf, (const u16*)(a.ws + WS_W13) + (size_t)(layer * 2 + (sp == 1 ? 0 : 1)) * 2 * DFF * D, M, 2 * DFF, D};
            pg8::StaticOrder S; S.init(M, 2 * DFF, G, bid);
            EpiSwiglu E{Xbuf};
            for (int rep = 0; rep < PROBE_G13; ++rep) pg8::gemm_phase<EpiSwiglu, pg8::StaticOrder, true, true>((LAS unsigned char*)lds, g, S, E);
        }
        if constexpr ((sp == 2 || sp == 11) && (PHMASK & 4)) {
            constexpr bool with_ctx = (sp == 2) || !last;
            const u16* W2t = (const u16*)(a.ws + WS_W2) + (size_t)(layer * 2 + (sp == 2 ? 0 : 1)) * D * DFF;
            pg8::Gemm g{Xbuf, W2t, MX, D, DFF};
            pg8::StaticOrder S; S.init(MX, D, G, bid);
            constexpr bool from_inputs = (sp == 2 && layer == 0);
            float* const Hc = (float*)(a.ws + WS_HC);
            const float* sx = from_inputs ? a.in[I_X] : (const float*)a.out; const float* sc = from_inputs ? a.in[I_CTX] : (const float*)Hc;
            EpiResid E{a.out, Hc, sx, sc, modp(a, layer, 0, sp == 2 ? 2 : 8), 0.5f};
            pg8::gemm_phase<EpiResid, pg8::StaticOrder, true, true>((LAS unsigned char*)lds, g, S, E);
            if constexpr (with_ctx) ctx_resid_gemm(a, Xbuf + (size_t)MX * DFF, W2t, DFF, modp(a, layer, 2, sp == 2 ? 2 : 8), 0.5f, lds, sc);
        }
        if constexpr (sp == 4 && (PHMASK & 4)) {
            pg8::Gemm g{Abuf, (const u16*)(a.ws + WS_WIN) + (size_t)layer * NPROJ * D, MT, NPROJ, D};
            pg8::StaticOrder S; S.init(MT, NPROJ, G, bid);
            EpiProj E{Xbuf};
            pg8::gemm_phase<EpiProj, pg8::StaticOrder, true, true>((LAS unsigned char*)lds, g, S, E);
        }
        if constexpr (sp == 5) {
            if constexpr ((PHMASK & 8) != 0) for (int u = bid; u < 2 * NCH; u += G) prep_unit(a, layer, u, lds);
            __syncthreads();
            if constexpr ((PHMASK & 16) != 0) for (int rep = 0; rep < PROBE_G1; ++rep) {
                const int gw = bid * 8 + wave, NGW = G * 8;
                for (int wu = gw; wu < 4096; wu += NGW) {
                    const int dir = wu & 1, h = (wu >> 1) & 3, xc = (wu >> 3) & 255, b = wu >> 11;
                    if (dir) gla_g1_wave<1>(a, layer, b, xc + 4, h, lds + wave * 16384, lane); else gla_g1_wave<0>(a, layer, b, xc + 4, h, lds + wave * 16384, lane);
                }
                for (int j = 0; j < 64; ++j) if ((j * 32) % NGW == gw) {
                    const int dir = j & 1, h = (j >> 1) & 3, c = (j >> 3) & 3, b = j >> 5;
                    if (dir) gla_g1_wave<1>(a, layer, b, c, h, lds + wave * 16384, lane); else gla_g1_wave<0>(a, layer, b, c, h, lds + wave * 16384, lane);
                }
            }
            __syncthreads();
            const int ncu = last ? 1024 : 1040;
            if constexpr ((PHMASK & 32) != 0) {
                bf16x8 wf[2][8];
                { const u16* PWT = (const u16*)(a.ws + WS_PWT) + (size_t)layer * 256 * 256; const int fr = lane & 15, fq = lane >> 4;
#pragma unroll
                  for (int nbi = 0; nbi < 2; ++nbi)
#pragma unroll
                    for (int ks = 0; ks < 8; ++ks) wf[nbi][ks] = *(const bf16x8*)(PWT + (size_t)((wave * 2 + nbi) * 16 + fr) * 256 + ks * 32 + fq * 8); }
                for (int rep = 0; rep < PROBE_CONV; ++rep) for (int u = bid; u < ncu; u += G) conv_unit(a, layer, u, lds, wf);
            }
        }
        if constexpr (sp == 6) {
            if constexpr ((PHMASK & 64) != 0) gla_scan(a, lds);
            if constexpr ((PHMASK & 128) != 0) for (int rep = 0; rep < PROBE_NA; ++rep) for (int u = bid; u < 512; u += G) { const int uu = u >> 1; if (u & 1) na_unit<1>(a, layer, uu >> 7, (uu >> 5) & 3, uu & 31, lds); else na_unit<0>(a, layer, uu >> 7, (uu >> 5) & 3, uu & 31, lds); }
            if constexpr ((PHMASK & 128) != 0 && !last) for (int wu = bid * 8 + wave; wu < 2 * 4 * 16; wu += G * 8) na_wave(a, layer, true, wu, lane);
            if constexpr ((PHMASK & 256) != 0) for (int rep = 0; rep < PROBE_DIFF; ++rep) for (int u = bid; u < 512; u += G) { const int b = u >> 8, h = (u >> 6) & 3, qb = u & 63; diff_unit(a, layer, b, h, b * SEQ + qb * 256, NCH, lds); }
            if constexpr ((PHMASK & 256) != 0 && !last) for (int u = bid; u < 8; u += G) { const int b = u >> 2, h = u & 3; diff_unit(a, layer, b, h, MX + b * CTXL, 4, lds); }
        }
        if constexpr (sp == 7) {
            __syncthreads();
            if constexpr ((PHMASK & 512) != 0) for (int rep = 0; rep < PROBE_G3; ++rep) for (int wu = bid * 8 + wave; wu < 2 * NCH * 4; wu += G * 8) { const int c = (wu >> 2) % NCH; if (last && c < 4) continue; gla_g3_wave(a, layer, wu, lds + wave * 16384, lane); }
        }
        if constexpr (sp == 8 && (PHMASK & 4)) {
            const u16* Wot = (const u16*)(a.ws + WS_WOUT) + (size_t)layer * D * D;
            pg8::Gemm g{Abuf, Wot, MX, D, D};
            pg8::StaticOrder S; S.init(MX, D, G, bid);
            float* const Hc = (float*)(a.ws + WS_HC);
            EpiResid E{a.out, Hc, (const float*)a.out, (const float*)Hc, modp(a, layer, 0, 5), 1.0f};
            pg8::gemm_phase<EpiResid, pg8::StaticOrder, true, true>((LAS unsigned char*)lds, g, S, E);
            if constexpr (!last) ctx_resid_gemm(a, Abuf + (size_t)MX * D, Wot, D, modp(a, layer, 2, 5), 1.0f, lds, (const float*)Hc);
        }
    }
}
template <int PHMASK, int PH> __device__ __forceinline__ void run_phase(const Args& a, int lo, int hi, unsigned char* lds, cg::grid_group& grid, const XcdBarrier& bar) {
    if (lo <= PH && PH < hi) { if (PH > lo) { if (PH == lo + 1) grid.sync(); else xcd_barrier(bar); } phase_body<PHMASK, PH>(a, lds); }
}
template <int PHMASK> __device__ __forceinline__ void run_phases(const Args& a, unsigned char* lds) {
    cg::grid_group grid = cg::this_grid();
    const int lo = a.ph_lo, hi = a.ph_hi;
    volatile LAS unsigned* st = (volatile LAS unsigned*)((LAS unsigned char*)lds + 131072);
    if (threadIdx.x < 2) st[threadIdx.x] = 0u;
    __syncthreads();
    const XcdBarrier bar = xcd_barrier_post((unsigned*)(a.ws + WS_CTL) + 16384, st);
#define RP(k) run_phase<PHMASK, k>(a, lo, hi, lds, grid, bar);
    RP(0) RP(1) RP(2) RP(3) RP(4) RP(5) RP(6) RP(7) RP(8) RP(9) RP(10) RP(11) RP(12) RP(13) RP(14) RP(15) RP(16) RP(17) RP(18) RP(19) RP(20) RP(21) RP(22) RP(23) RP(24) RP(25)
#undef RP
}
extern __shared__ __attribute__((aligned(16))) unsigned char dyn_lds[];
template <int PM> __global__ void __launch_bounds__(512, 2) part_fwd(Args a) { run_phases<PM>(a, dyn_lds); }
#ifndef MK_PER_PHASE
#define MK_PER_PHASE 0
#endif
#if !MK_PER_PHASE
__global__ void __launch_bounds__(512, 2) mega_fwd(Args a) { run_phases<0xFFFF>(a, dyn_lds); }
#define MAIN_KERNEL mega_fwd
#else
#define MAIN_KERNEL part_fwd<4>
#endif
#ifndef MK_PER_PHASE
#define MK_PER_PHASE 0
#endif
extern "C" void kernel_launch(void* const* d_in, const int* in_sizes, int n_in, void* d_out, int out_size, void* d_ws, size_t ws_size, hipStream_t stream) {
    static int grid = 0;
    if (grid == 0) {
        if (n_in != 33 || ws_size < WS_END) { fprintf(stderr, "kernel_launch: unexpected n_in %d / ws_size %zu (need %zu)\n", n_in, ws_size, (size_t)WS_END); grid = -1; return; }
        int dev = 0, cus = 0, per_cu = 0;
        hipGetDevice(&dev); hipDeviceGetAttribute(&cus, hipDeviceAttributeMultiprocessorCount, dev);
        if (hipFuncSetAttribute((const void*)MAIN_KERNEL, hipFuncAttributeMaxDynamicSharedMemorySize, LDS_BYTES) != hipSuccess) { fprintf(stderr, "kernel_launch: hipFuncSetAttribute failed\n"); grid = -1; return; }
#if MK_PER_PHASE
        (void)hipFuncSetAttribute((const void*)part_fwd<1>, hipFuncAttributeMaxDynamicSharedMemorySize, LDS_BYTES); (void)hipFuncSetAttribute((const void*)part_fwd<2>, hipFuncAttributeMaxDynamicSharedMemorySize, LDS_BYTES);
        (void)hipFuncSetAttribute((const void*)part_fwd<4>, hipFuncAttributeMaxDynamicSharedMemorySize, LDS_BYTES); (void)hipFuncSetAttribute((const void*)part_fwd<56>, hipFuncAttributeMaxDynamicSharedMemorySize, LDS_BYTES);
        (void)hipFuncSetAttribute((const void*)part_fwd<448>, hipFuncAttributeMaxDynamicSharedMemorySize, LDS_BYTES); (void)hipFuncSetAttribute((const void*)part_fwd<512>, hipFuncAttributeMaxDynamicSharedMemorySize, LDS_BYTES);
#endif
        if (hipOccupancyMaxActiveBlocksPerMultiprocessor(&per_cu, (const void*)MAIN_KERNEL, 512, LDS_BYTES) != hipSuccess || per_cu < 1) { fprintf(stderr, "kernel_launch: occupancy query says %d\n", per_cu); per_cu = 1; }
        (void)hipGetLastError();
        grid = cus;
    }
    if (grid < 0) return;
    (void)hipMemsetAsync((char*)d_ws + WS_CTL, 0, 131072, stream);
    Args a{};
    for (int i = 0; i < 33; ++i) a.in[i] = (const float*)d_in[i];
    a.out = (float*)d_out; a.ws = (unsigned char*)d_ws;
#if MK_PER_PHASE
    for (int ph = 0; ph < NPHASE; ++ph) {
        a.ph_lo = ph; a.ph_hi = ph + 1;
        const int sp = (ph == 0 || ph == NPHASE - 1) ? -1 : (ph - 1) % 12;
        if (ph == 0) hipLaunchKernelGGL(part_fwd<1>, dim3(grid), dim3(512), LDS_BYTES, stream, a);
        else if (sp == -1 || sp == 0 || sp == 3 || sp == 9) hipLaunchKernelGGL(part_fwd<2>, dim3(grid), dim3(512), LDS_BYTES, stream, a);
        else if (sp == 5) hipLaunchKernelGGL(part_fwd<56>, dim3(grid), dim3(512), LDS_BYTES, stream, a);
        else if (sp == 6) hipLaunchKernelGGL(part_fwd<448>, dim3(grid), dim3(512), LDS_BYTES, stream, a);
        else if (sp == 7) hipLaunchKernelGGL(part_fwd<512>, dim3(grid), dim3(512), LDS_BYTES, stream, a);
        else hipLaunchKernelGGL(part_fwd<4>, dim3(grid), dim3(512), LDS_BYTES, stream, a);
    }
#else
    a.ph_lo = 0; a.ph_hi = NPHASE;
    void* args[] = {&a};
    hipError_t e = hipLaunchCooperativeKernel((const void*)mega_fwd, dim3(grid), dim3(512), args, LDS_BYTES, stream);
    if (e != hipSuccess) fprintf(stderr, "kernel_launch: cooperative launch failed: %s (grid %d)\n", hipGetErrorString(e), grid);
#endif
}
```
